# Optimizing an MI355X kernel written in HIP

```python
import jax
import jax.numpy as jnp
from jax import lax
import numpy as np

D_MODEL = 1024
BATCH = 8
SEQ = 4096
DEPTH = 2

GRID_W = 64
CTX_LEN = 256

F32 = jnp.float32

SG_WIDTH = D_MODEL // 4
SG_GROUPS = 4
SG_GDIM = SG_WIDTH // SG_GROUPS
SG_CHUNK = 128
MLA_HEADS = 8
MLA_NOPE = 64
MLA_ROPE = 32
MLA_VDIM = 64
MLA_WIDTH = MLA_HEADS * MLA_VDIM
Q_LORA = 384
KV_LORA = 256
ROPE_AXIS = MLA_ROPE // 2
ROPE_BASE = 10000.0
ATTN_BLOCK = 128
MLA_SCALE = (MLA_NOPE + MLA_ROPE) ** -0.5
ML_HEADS = 4
ML_DIM = 64
ML_WIDTH = ML_HEADS * ML_DIM
ML_CHUNK = 64
ML_CONV = 5
N_SG = 2 * SG_WIDTH
N_MLA = Q_LORA + KV_LORA + MLA_ROPE
N_ML = 4 * ML_WIDTH + 4 * ML_HEADS
N_IN = N_SG + N_MLA + N_ML
MIX_WIDTH = SG_WIDTH + MLA_WIDTH + ML_WIDTH
N_EXPERTS = 16
EXPERT_FF = 1024
EC_CAPACITY = 2
ALPHA = (2 * DEPTH) ** 0.25
BETA = (8 * DEPTH) ** -0.25
LN_EPS = 1e-6

kernel_name = 'hybrid_diffusion_ec_moe_trunk'


def plain_norm(x):
    x32 = x.astype(F32)
    mu = jnp.mean(x32, -1, keepdims=True)
    var = jnp.mean(jnp.square(x32 - mu), -1, keepdims=True)
    return ((x32 - mu) * lax.rsqrt(var + LN_EPS)).astype(x.dtype)


def layer_norm(x, g, b):
    return plain_norm(x) * g + b


def rms_norm(x, g):
    x32 = x.astype(F32)
    y = x32 * lax.rsqrt(jnp.mean(jnp.square(x32), -1, keepdims=True) + LN_EPS)
    return y.astype(x.dtype) * g


def modulate(x, shift, scale):
    return plain_norm(x) * (1 + scale) + shift


def axial_rope_tables(rows):
    row = jnp.repeat(jnp.arange(rows, dtype=F32), GRID_W)
    col = jnp.tile(jnp.arange(GRID_W, dtype=F32), rows)
    inv = ROPE_BASE ** (-jnp.arange(ROPE_AXIS // 2, dtype=F32) * 2.0 / ROPE_AXIS)
    ang = jnp.concatenate([row[:, None] * inv, col[:, None] * inv], axis=-1)
    return jnp.cos(ang), jnp.sin(ang)


def apply_axial_rope(x, cos, sin):
    half = ROPE_AXIS // 2
    parts = []
    for a in range(2):
        z = x[..., a * ROPE_AXIS:(a + 1) * ROPE_AXIS]
        cs = cos[:, a * half:(a + 1) * half].astype(x.dtype)
        sn = sin[:, a * half:(a + 1) * half].astype(x.dtype)
        z1, z2 = z[..., :half], z[..., half:]
        parts += [z1 * cs - z2 * sn, z2 * cs + z1 * sn]
    return jnp.concatenate(parts, axis=-1)


def chunk_spatial_gating(z, ln_g, ln_b, w_s, b_s):
    B, T, _ = z.shape
    z = jax.nn.gelu(z)
    u, v = z[..., :SG_WIDTH], z[..., SG_WIDTH:]
    v = layer_norm(v, ln_g, ln_b).reshape(B, T // SG_CHUNK, SG_CHUNK, SG_GROUPS, SG_GDIM)
    mixed = jnp.einsum('gts,bnsgc->bntgc', w_s, v) + b_s.T[:, :, None]
    return u * mixed.reshape(B, T, SG_WIDTH)


def mla_q(z, q_norm_g, w_uq, rope):
    B, T, _ = z.shape
    c_q = rms_norm(z[..., :Q_LORA], q_norm_g)
    q = (c_q @ w_uq).reshape(B, T, MLA_HEADS, MLA_NOPE + MLA_ROPE).transpose(0, 2, 1, 3)
    q_nope, q_rope = q[..., :MLA_NOPE], q[..., MLA_NOPE:]
    if rope is not None:
        q_rope = apply_axial_rope(q_rope, rope[0], rope[1])
    return q_nope, q_rope


def mla_kv(z, kv_norm_g, w_ukv, rope):
    B, T, _ = z.shape
    c_kv = rms_norm(z[..., Q_LORA:Q_LORA + KV_LORA], kv_norm_g)
    k_rope = z[..., Q_LORA + KV_LORA:]
    kv = (c_kv @ w_ukv).reshape(B, T, MLA_HEADS, MLA_NOPE + MLA_VDIM).transpose(0, 2, 1, 3)
    k_nope, v = kv[..., :MLA_NOPE], kv[..., MLA_NOPE:]
    if rope is not None:
        k_rope = apply_axial_rope(k_rope, rope[0], rope[1])
    return k_nope, k_rope, v


def attend(q_nope, q_rope, k_nope, k_rope, v):
    s = jnp.einsum('bhqd,bhkd->bhqk', q_nope, k_nope) + jnp.einsum('bhqd,bkd->bhqk', q_rope, k_rope)
    p = jax.nn.softmax(s.astype(F32) * MLA_SCALE, axis=-1).astype(v.dtype)
    return jnp.einsum('bhqk,bhkd->bhqd', p, v)


def blocked_attention(q_nope, q_rope, k_nope, k_rope, v):
    B, H, T, _ = q_nope.shape
    nb = T // ATTN_BLOCK
    qn = q_nope.reshape(B, H, nb, ATTN_BLOCK, MLA_NOPE).transpose(2, 0, 1, 3, 4)
    qr = q_rope.reshape(B, H, nb, ATTN_BLOCK, MLA_ROPE).transpose(2, 0, 1, 3, 4)
    out = lax.map(lambda qs: attend(qs[0], qs[1], k_nope, k_rope, v), (qn, qr))
    return out.transpose(1, 2, 0, 3, 4).reshape(B, H, T, MLA_VDIM)


def heads_to_width(h):
    B, H, T, d = h.shape
    return h.transpose(0, 2, 1, 3).reshape(B, T, H * d)


def depthwise_conv(x, w, b):
    pad = (ML_CONV - 1) // 2
    y = lax.conv_general_dilated(x, w[:, None, :], window_strides=(1,), padding=[(pad, pad)],
                                 dimension_numbers=('NWC', 'WIO', 'NWC'),
                                 feature_group_count=x.shape[-1])
    return y + b


def mlstm_inputs(z, conv_w, conv_b, f_bias):
    B, T, _ = z.shape
    W = ML_WIDTH
    qk = jax.nn.silu(depthwise_conv(z[..., :2 * W], conv_w, conv_b))
    heads = lambda a: a.reshape(B, T, ML_HEADS, ML_DIM).transpose(0, 2, 1, 3).astype(F32)
    q = heads(qk[..., :W])
    k = heads(qk[..., W:]) * (ML_DIM ** -0.5)
    v = heads(z[..., 2 * W:3 * W])
    o = z[..., 3 * W:4 * W]
    gates = z[..., 4 * W:].astype(F32).reshape(B, T, 2, 2, ML_HEADS)
    log_i = gates[:, :, :, 0].transpose(2, 0, 3, 1)
    log_f = jax.nn.log_sigmoid(gates[:, :, :, 1] + f_bias.astype(F32)).transpose(2, 0, 3, 1)
    return q, k, v, o, log_i, log_f


def mlstm_chunkwise(q, k, v, log_i, log_f, state, with_output):
    B, H, T, d = k.shape
    L = ML_CHUNK
    nc = T // L
    k = k.reshape(B, H, nc, L, d)
    v = v.reshape(B, H, nc, L, d)
    li = log_i.reshape(B, H, nc, L)
    b = jnp.cumsum(log_f.reshape(B, H, nc, L), axis=-1)
    b_end = b[..., -1]
    g = b_end[..., None] - b + li
    m_loc = jnp.max(g, axis=-1)
    w = jnp.exp(g - m_loc[..., None])
    C_loc = jnp.einsum('bhnl,bhnli,bhnlj->bhnij', w, v, k)
    n_loc = jnp.einsum('bhnl,bhnlj->bhnj', w, k)

    def step(carry, inp):
        C, n, m = carry
        be, ml, Cl, nl = inp
        m_new = jnp.maximum(be + m, ml)
        a = jnp.exp(be + m - m_new)
        s = jnp.exp(ml - m_new)
        new = (a[..., None, None] * C + s[..., None, None] * Cl, a[..., None] * n + s[..., None] * nl, m_new)
        return new, (C, n, m)

    to_front = lambda a: jnp.moveaxis(a, 2, 0)
    final, starts = lax.scan(step, state, (to_front(b_end), to_front(m_loc), to_front(C_loc), to_front(n_loc)))
    if not with_output:
        return None, final
    C0, n0, m0 = [jnp.moveaxis(a, 0, 2) for a in starts]
    q = q.reshape(B, H, nc, L, d)
    lower = jnp.tril(jnp.ones((L, L), dtype=bool))
    dmat = jnp.where(lower, b[..., :, None] - b[..., None, :] + li[..., None, :], -jnp.inf)
    a_t = b + m0[..., None]
    m_t = jnp.maximum(a_t, jnp.max(dmat, axis=-1))
    p = jnp.exp(dmat - m_t[..., None]) * jnp.einsum('bhntd,bhnsd->bhnts', q, k)
    inter = jnp.exp(a_t - m_t)
    num = inter[..., None] * jnp.einsum('bhnij,bhntj->bhnti', C0, q) + jnp.einsum('bhnts,bhnsd->bhntd', p, v)
    den = inter * jnp.einsum('bhnj,bhntj->bhnt', n0, q) + jnp.sum(p, axis=-1)
    h = num / jnp.maximum(jnp.abs(den), jnp.exp(-m_t))[..., None]
    return h.reshape(B, H, T, d), final


def mlstm_out(h, o, norm_g):
    B, H, T, d = h.shape
    h = h.transpose(0, 2, 1, 3)
    mu = jnp.mean(h, -1, keepdims=True)
    var = jnp.mean(jnp.square(h - mu), -1, keepdims=True)
    hn = ((h - mu) * lax.rsqrt(var + LN_EPS)).reshape(B, T, H * d).astype(o.dtype) * norm_g
    return jax.nn.sigmoid(o) * hn


def _rev(a, flip):
    return jnp.flip(a, axis=2) if flip else a


def mlstm_bidirectional(zl, zc, conv_w, conv_b, f_bias, norm_g, ctx_output):
    ql, kl, vl, ol, lil, lfl = mlstm_inputs(zl, conv_w, conv_b, f_bias)
    qc, kc, vc, oc, lic, lfc = mlstm_inputs(zc, conv_w, conv_b, f_bias)
    B = kl.shape[0]
    zero = (jnp.zeros((B, ML_HEADS, ML_DIM, ML_DIM), F32), jnp.zeros((B, ML_HEADS, ML_DIM), F32),
            jnp.zeros((B, ML_HEADS), F32))
    hl_dirs, hc_dirs = [], []
    for d in range(2):
        fl = d == 1
        hc_d, st = mlstm_chunkwise(_rev(qc, fl), _rev(kc, fl), _rev(vc, fl), _rev(lic[d], fl),
                                   _rev(lfc[d], fl), zero, ctx_output)
        hl_d, _ = mlstm_chunkwise(_rev(ql, fl), _rev(kl, fl), _rev(vl, fl), _rev(lil[d], fl),
                                  _rev(lfl[d], fl), st, True)
        hl_dirs.append(_rev(hl_d, fl))
        if ctx_output:
            hc_dirs.append(_rev(hc_d, fl))
    yl = mlstm_out(hl_dirs[0] + hl_dirs[1], ol, norm_g)
    yc = mlstm_out(hc_dirs[0] + hc_dirs[1], oc, norm_g) if ctx_output else None
    return yl, yc


def expert_choice_moe(h, w_router, w_gate, w_up, w_down):
    B, T, D = h.shape
    cap = EC_CAPACITY * T // N_EXPERTS
    aff = jax.nn.softmax((h @ w_router).astype(F32), axis=-1)
    gate, idx = lax.top_k(aff.transpose(0, 2, 1), cap)
    xe = jax.vmap(lambda hb, ib: hb[ib])(h, idx)
    hid = jax.nn.silu(jnp.einsum('becd,edf->becf', xe, w_gate)) * jnp.einsum('becd,edf->becf', xe, w_up)
    ye = jnp.einsum('becf,efd->becd', hid, w_down) * gate[..., None].astype(h.dtype)
    flat = (idx + jnp.arange(B, dtype=idx.dtype)[:, None, None] * T).reshape(-1)
    out = jnp.zeros((B * T, D), h.dtype).at[flat].add(ye.reshape(-1, D))
    return out.reshape(B, T, D)


def token_mixers(zl, zc, p, rope, ctx_output):
    al, bl, ml = zl[..., :N_SG], zl[..., N_SG:N_SG + N_MLA], zl[..., N_SG + N_MLA:]
    ac, bc, mc = zc[..., :N_SG], zc[..., N_SG:N_SG + N_MLA], zc[..., N_SG + N_MLA:]
    ya_l = chunk_spatial_gating(al, p['sg_ln_g'], p['sg_ln_b'], p['sg_w'], p['sg_b'])
    kn_l, kr_l, v_l = mla_kv(bl, p['kv_norm_g'], p['w_ukv'], rope)
    kn_c, kr_c, v_c = mla_kv(bc, p['kv_norm_g'], p['w_ukv'], None)
    qn_l, qr_l = mla_q(bl, p['q_norm_g'], p['w_uq'], rope)
    yb_l = heads_to_width(blocked_attention(qn_l, qr_l, jnp.concatenate([kn_l, kn_c], axis=2),
                                            jnp.concatenate([kr_l, kr_c], axis=1),
                                            jnp.concatenate([v_l, v_c], axis=2)))
    yc_l, yc_c = mlstm_bidirectional(ml, mc, p['ml_conv_w'], p['ml_conv_b'], p['ml_f_bias'],
                                     p['ml_norm_g'], ctx_output)
    y_l = jnp.concatenate([ya_l, yb_l, yc_l], axis=-1) @ p['w_out']
    if not ctx_output:
        return y_l, None
    ya_c = chunk_spatial_gating(ac, p['sg_ln_g'], p['sg_ln_b'], p['sg_w'], p['sg_b'])
    qn_c, qr_c = mla_q(bc, p['q_norm_g'], p['w_uq'], None)
    yb_c = heads_to_width(attend(qn_c, qr_c, kn_c, kr_c, v_c))
    y_c = jnp.concatenate([ya_c, yb_c, yc_c], axis=-1) @ p['w_out']
    return y_l, y_c


def trunk_layer(xl, xc, c, c_ctx, rope, p, update_ctx):
    ada_l = jax.nn.silu(c) @ p['w_ada'] + p['b_ada']
    ada_c = jax.nn.silu(c_ctx) @ p['w_ada'] + p['b_ada']
    sh1_l, sc1_l, g1_l, sh2_l, sc2_l, g2_l = [a[:, None, :] for a in jnp.split(ada_l, 6, axis=-1)]
    sh1_c, sc1_c, g1_c, sh2_c, sc2_c, g2_c = jnp.split(ada_c, 6, axis=-1)
    zl = modulate(xl, sh1_l, sc1_l) @ p['w_in'] + p['b_in']
    zc = modulate(xc, sh1_c, sc1_c) @ p['w_in'] + p['b_in']
    y_l, y_c = token_mixers(zl, zc, p, rope, update_ctx)
    xl = layer_norm(ALPHA * xl + g1_l * y_l, p['ln1_g'], p['ln1_b'])
    f_l = expert_choice_moe(modulate(xl, sh2_l, sc2_l), p['w_router'], p['w_gate'], p['w_up'], p['w_down'])
    xl = layer_norm(ALPHA * xl + g2_l * f_l, p['ln2_g'], p['ln2_b'])
    if update_ctx:
        xc = layer_norm(ALPHA * xc + g1_c * y_c, p['ln1_g'], p['ln1_b'])
        f_c = expert_choice_moe(modulate(xc, sh2_c, sc2_c), p['w_router'], p['w_gate'], p['w_up'], p['w_down'])
        xc = layer_norm(ALPHA * xc + g2_c * f_c, p['ln2_g'], p['ln2_b'])
    return xl, xc


def setup_inputs(seed: int = 0) -> dict:
    key = jax.random.key(seed)
    ks = iter(jax.random.split(key, 40))
    nrm = lambda shape, s: jax.random.normal(next(ks), shape, F32) * s
    L, D = DEPTH, D_MODEL
    return {
        'x': nrm((BATCH, SEQ, D), 1.0),
        'c': nrm((BATCH, D), 1.0),
        'ctx': nrm((BATCH, CTX_LEN, D), 1.0),
        'c_ctx': nrm((D,), 1.0),
        'w_ada': nrm((L, D, 6 * D), 0.5 * D ** -0.5),
        'b_ada': nrm((L, 6 * D), 0.02),
        'w_in': nrm((L, D, N_IN), D ** -0.5),
        'b_in': nrm((L, N_IN), 0.02),
        'sg_ln_g': 1.0 + nrm((L, SG_WIDTH), 0.02),
        'sg_ln_b': nrm((L, SG_WIDTH), 0.02),
        'sg_w': nrm((L, SG_GROUPS, SG_CHUNK, SG_CHUNK), SG_CHUNK ** -0.5),
        'sg_b': 1.0 + nrm((L, SG_GROUPS, SG_CHUNK), 0.02),
        'q_norm_g': 1.0 + nrm((L, Q_LORA), 0.02),
        'kv_norm_g': 1.0 + nrm((L, KV_LORA), 0.02),
        'w_uq': nrm((L, Q_LORA, MLA_HEADS * (MLA_NOPE + MLA_ROPE)), Q_LORA ** -0.5),
        'w_ukv': nrm((L, KV_LORA, MLA_HEADS * (MLA_NOPE + MLA_VDIM)), KV_LORA ** -0.5),
        'ml_conv_w': nrm((L, ML_CONV, 2 * ML_WIDTH), ML_CONV ** -0.5),
        'ml_conv_b': nrm((L, 2 * ML_WIDTH), 0.02),
        'ml_f_bias': jax.random.uniform(next(ks), (L, 2, ML_HEADS), F32, 3.0, 6.0),
        'ml_norm_g': 1.0 + nrm((L, ML_WIDTH), 0.02),
        'w_out': nrm((L, MIX_WIDTH, D), BETA * MIX_WIDTH ** -0.5),
        'ln1_g': 1.0 + nrm((L, D), 0.02),
        'ln1_b': nrm((L, D), 0.02),
        'w_router': nrm((L, D, N_EXPERTS), D ** -0.5),
        'w_gate': nrm((L, N_EXPERTS, D, EXPERT_FF), D ** -0.5),
        'w_up': nrm((L, N_EXPERTS, D, EXPERT_FF), D ** -0.5),
        'w_down': nrm((L, N_EXPERTS, EXPERT_FF, D), BETA * EXPERT_FF ** -0.5),
        'ln2_g': 1.0 + nrm((L, D), 0.02),
        'ln2_b': nrm((L, D), 0.02),
    }


def reference(x, c, ctx, c_ctx, w_ada, b_ada, w_in, b_in, sg_ln_g, sg_ln_b, sg_w, sg_b,
              q_norm_g, kv_norm_g, w_uq, w_ukv, ml_conv_w, ml_conv_b, ml_f_bias, ml_norm_g,
              w_out, ln1_g, ln1_b, w_router, w_gate, w_up, w_down, ln2_g, ln2_b):
    rows = x.shape[1] // GRID_W
    rope = axial_rope_tables(rows)
    xl, xc = x, ctx
    for l in range(DEPTH):
        p = {
            'w_ada': w_ada[l], 'b_ada': b_ada[l], 'w_in': w_in[l], 'b_in': b_in[l],
            'sg_ln_g': sg_ln_g[l], 'sg_ln_b': sg_ln_b[l], 'sg_w': sg_w[l], 'sg_b': sg_b[l],
            'q_norm_g': q_norm_g[l], 'kv_norm_g': kv_norm_g[l], 'w_uq': w_uq[l], 'w_ukv': w_ukv[l],
            'ml_conv_w': ml_conv_w[l], 'ml_conv_b': ml_conv_b[l], 'ml_f_bias': ml_f_bias[l],
            'ml_norm_g': ml_norm_g[l], 'w_out': w_out[l], 'ln1_g': ln1_g[l], 'ln1_b': ln1_b[l],
            'w_router': w_router[l], 'w_gate': w_gate[l], 'w_up': w_up[l], 'w_down': w_down[l],
            'ln2_g': ln2_g[l], 'ln2_b': ln2_b[l],
        }
        xl, xc = trunk_layer(xl, xc, c, c_ctx, rope, p, l < DEPTH - 1)
    return xl
```

```cpp
#include <hip/hip_runtime.h>
#include <hip/hip_cooperative_groups.h>
#include <cstdio>
namespace cg = cooperative_groups;

#define DI __device__ __forceinline__
#define MEMBAR() asm volatile("" ::: "memory")
DI int opaque_tid() { int t = threadIdx.x; asm volatile("" : "+v"(t)); return t; }
typedef unsigned u32x2_t __attribute__((ext_vector_type(2)));
DI float shx(float v, int m) {
  if (m == 1) return __int_as_float(__builtin_amdgcn_update_dpp(0, __float_as_int(v), 0xB1, 0xF, 0xF, false));
  if (m == 2) return __int_as_float(__builtin_amdgcn_update_dpp(0, __float_as_int(v), 0x4E, 0xF, 0xF, false));
  if (m == 8) return __int_as_float(__builtin_amdgcn_update_dpp(0, __float_as_int(v), 0x128, 0xF, 0xF, false));
  if (m == 16) return __int_as_float(__builtin_amdgcn_ds_swizzle(__float_as_int(v), 0x401F));
  if (m == 32) {
    const u32x2_t r = __builtin_amdgcn_permlane32_swap(__float_as_uint(v), __float_as_uint(v), false, false);
    return __uint_as_float(((opaque_tid() & 32) != 0) ? r[0] : r[1]);
  }
  const int l = opaque_tid() & 63;
  return __int_as_float(__builtin_amdgcn_ds_bpermute((l ^ m) << 2, __float_as_int(v)));
}
DI float shup(float v, int o) { const int l = opaque_tid() & 63; return __int_as_float(__builtin_amdgcn_ds_bpermute((l >= o ? l - o : l) << 2, __float_as_int(v))); }
DI unsigned shup(unsigned v, int o) { const int l = opaque_tid() & 63; return (unsigned)__builtin_amdgcn_ds_bpermute((l >= o ? l - o : l) << 2, (int)v); }
typedef unsigned short bf16;
typedef __attribute__((ext_vector_type(8))) short bf16x8;
typedef __attribute__((ext_vector_type(16))) float f32x16;
typedef __attribute__((ext_vector_type(2))) __bf16 bfv2;
typedef __attribute__((ext_vector_type(2))) float fv2;
typedef __attribute__((ext_vector_type(4))) unsigned u32x4;

constexpr int NTHR = 256;
constexpr int NB = 8, SEQ = 4096, CTX = 256;
constexpr int NTL = NB * SEQ, NTC = NB * CTX, NT = NTL + NTC;
constexpr int ZS = 2224;
constexpr int KTOT = SEQ + CTX;
constexpr int MEMAX = 4352;
constexpr float LN_EPS = 1e-6f;
constexpr float ALPHA = 1.41421356237f;
constexpr float QSCALE = 0.10206207261596577f * 1.4426950408889634f;

enum { I_X = 0, I_C, I_CTX, I_CCTX, I_WADA, I_BADA, I_WIN, I_BIN, I_SGLNG, I_SGLNB, I_SGW, I_SGB, I_QNG, I_KVNG, I_WUQ, I_WUKV,
       I_CONVW, I_CONVB, I_FBIAS, I_MLNG, I_WOUT, I_LN1G, I_LN1B, I_WROUTER, I_WGATE, I_WUP, I_WDOWN, I_LN2G, I_LN2B };

struct Params {
  const float* in[29];
  float* out;
  char* ws;
};

DI void launder_params(Params& q) {
  char* w = q.ws; float* o = q.out;
  asm volatile("" : "+s"(w), "+s"(o));
  q.ws = w; q.out = o;
}
constexpr size_t al(size_t x) { return (x + 255) & ~size_t(255); }
constexpr size_t OFF_ADA = 0;
constexpr size_t OFF_ROPE = al(OFF_ADA + 2ull * 9 * 6144 * 4);
constexpr size_t OFF_WIN = al(OFF_ROPE + 64 * 8 * 8);
constexpr size_t SZ_WIN1 = 2304ull * 1024 * 2;
constexpr size_t OFF_WUQ = al(OFF_WIN + 2 * SZ_WIN1);
constexpr size_t SZ_WUQ1 = 768ull * 384 * 2;
constexpr size_t OFF_WUKV = al(OFF_WUQ + 2 * SZ_WUQ1);
constexpr size_t SZ_WUKV1 = 1024ull * 256 * 2;
constexpr size_t OFF_WOUT = al(OFF_WUKV + 2 * SZ_WUKV1);
constexpr size_t SZ_WOUT1 = 1024ull * 1024 * 2;
constexpr size_t OFF_SGW = al(OFF_WOUT + 2 * SZ_WOUT1);
constexpr size_t SZ_SGW1 = 4ull * 128 * 128 * 2;
constexpr size_t OFF_WGU = al(OFF_SGW + 2 * SZ_SGW1);
constexpr size_t OFF_WD = al(OFF_WGU + 16ull * 2048 * 1024 * 2);
constexpr size_t OFF_X2 = al(OFF_WD + 16ull * 1024 * 1024 * 2);
constexpr size_t OFF_Z = al(OFF_X2 + (size_t)NT * 1024 * 4);
constexpr size_t OFF_KN = al(OFF_Z + (size_t)NT * ZS * 2);
constexpr size_t OFF_VT = al(OFF_KN + (size_t)NB * 8 * KTOT * 64 * 2);
constexpr size_t OFF_KR = al(OFF_VT + (size_t)NB * 8 * KTOT * 64 * 2);
constexpr size_t OFF_Y = al(OFF_KR + (size_t)NB * KTOT * 32 * 2);
constexpr size_t OFF_GATES = al(OFF_Y + (size_t)NT * 1024 * 2);
constexpr size_t OFF_AFFL = al(OFF_GATES + (size_t)NT * 16 * 4);
constexpr size_t OFF_AFFC = al(OFF_AFFL + 128ull * 4096 * 4);
constexpr size_t OFF_ROWTOK = al(OFF_AFFC + 128ull * 256 * 4);
constexpr size_t OFF_ROWGATE = al(OFF_ROWTOK + 16ull * MEMAX * 4);
constexpr size_t OFF_SM = al(OFF_ROWGATE + 16ull * MEMAX * 4);
constexpr size_t OFF_BAR = al(OFF_SM + 32ull * 2 * 68 * 4 * 4);
constexpr size_t OFF_TOKCNT = al(OFF_BAR + 3456 * 4);
constexpr size_t OFF_TOKLIST = al(OFF_TOKCNT + (size_t)NT * 4);
constexpr size_t WS_END = al(OFF_TOKLIST + (size_t)NT * 16 * 4);
constexpr size_t OOFF_SC = 0;
constexpr size_t OOFF_SN = OOFF_SC + 32ull * 2 * 68 * 4096 * 4;
constexpr size_t OOFF_Q = al(OOFF_SN + 32ull * 2 * 68 * 64 * 4);
static_assert(OOFF_Q + (size_t)NB * 8 * KTOT * 96 * 2 <= (size_t)NTL * 1024 * 4, "d_out scratch overflow");

constexpr int SMEM_BYTES = 75776;
#ifndef PHMASK
#define PHMASK 0xFFFF
#endif
#define PH(n) if (launder_params(p), ((PHMASK >> (n)) & 1))
#ifndef P3MASK
#define P3MASK 31
#endif

DI unsigned pack2(float a, float b) { fv2 f = {a, b}; bfv2 r = __builtin_convertvector(f, bfv2); return __builtin_bit_cast(unsigned, r); }
DI bf16 f2bf(float a) { return (bf16)(pack2(a, 0.f) & 0xffffu); }
DI float bf2f(bf16 h) { return __uint_as_float(((unsigned)h) << 16); }
DI float bflo(unsigned u) { return __uint_as_float(u << 16); }
DI float bfhi(unsigned u) { return __uint_as_float(u & 0xffff0000u); }
DI f32x16 mfma(bf16x8 a, bf16x8 b, f32x16 c) { return __builtin_amdgcn_mfma_f32_32x32x16_bf16(a, b, c, 0, 0, 0); }
DI f32x16 fzero() { f32x16 z; _Pragma("unroll") for (int i = 0; i < 16; ++i) z[i] = 0.f; return z; }
DI int crow(int r, int hh) { return (r & 3) + 8 * (r >> 2) + 4 * hh; }
#define DPP_F(v, ctrl) __int_as_float(__builtin_amdgcn_update_dpp(0, __float_as_int(v), (ctrl), 0xF, 0xF, false))
DI float wave_sum(float v) {
  v += DPP_F(v, 0xB1); v += DPP_F(v, 0x4E); v += DPP_F(v, 0x141); v += DPP_F(v, 0x140);
  v += __int_as_float(__builtin_amdgcn_ds_swizzle(__float_as_int(v), 0x401F));
  return __int_as_float(__builtin_amdgcn_readlane(__float_as_int(v), 0)) + __int_as_float(__builtin_amdgcn_readlane(__float_as_int(v), 32));
}
#define DPP_O(old, v, ctrl, rmask) __builtin_amdgcn_update_dpp((old), (v), (ctrl), (rmask), 0xF, false)
DI float wave_scan_add(float v) {
  v += __int_as_float(DPP_O(0, __float_as_int(v), 0x111, 0xF));
  v += __int_as_float(DPP_O(0, __float_as_int(v), 0x112, 0xF));
  v += __int_as_float(DPP_O(0, __float_as_int(v), 0x114, 0xF));
  v += __int_as_float(DPP_O(0, __float_as_int(v), 0x118, 0xF));
  v += __int_as_float(DPP_O(0, __float_as_int(v), 0x142, 0xA));
  v += __int_as_float(DPP_O(0, __float_as_int(v), 0x143, 0xC));
  return v;
}
DI unsigned wave_scan_add_u(unsigned v) {
  v += (unsigned)DPP_O(0, (int)v, 0x111, 0xF);
  v += (unsigned)DPP_O(0, (int)v, 0x112, 0xF);
  v += (unsigned)DPP_O(0, (int)v, 0x114, 0xF);
  v += (unsigned)DPP_O(0, (int)v, 0x118, 0xF);
  v += (unsigned)DPP_O(0, (int)v, 0x142, 0xA);
  v += (unsigned)DPP_O(0, (int)v, 0x143, 0xC);
  return v;
}
DI float wave_scan_max(float v) {
  const int ninf = (int)0xff800000u;
  v = fmaxf(v, __int_as_float(DPP_O(ninf, __float_as_int(v), 0x111, 0xF)));
  v = fmaxf(v, __int_as_float(DPP_O(ninf, __float_as_int(v), 0x112, 0xF)));
  v = fmaxf(v, __int_as_float(DPP_O(ninf, __float_as_int(v), 0x114, 0xF)));
  v = fmaxf(v, __int_as_float(DPP_O(ninf, __float_as_int(v), 0x118, 0xF)));
  v = fmaxf(v, __int_as_float(DPP_O(ninf, __float_as_int(v), 0x142, 0xA)));
  v = fmaxf(v, __int_as_float(DPP_O(ninf, __float_as_int(v), 0x143, 0xC)));
  return v;
}
DI float wave_max(float v) {
  v = fmaxf(v, DPP_F(v, 0xB1)); v = fmaxf(v, DPP_F(v, 0x4E)); v = fmaxf(v, DPP_F(v, 0x141)); v = fmaxf(v, DPP_F(v, 0x140));
  v = fmaxf(v, __int_as_float(__builtin_amdgcn_ds_swizzle(__float_as_int(v), 0x401F)));
  return fmaxf(__int_as_float(__builtin_amdgcn_readlane(__float_as_int(v), 0)), __int_as_float(__builtin_amdgcn_readlane(__float_as_int(v), 32)));
}
DI float silu_f(float a) { return a / (1.f + __expf(-a)); }
DI float sigmoid_f(float a) { return 1.f / (1.f + __expf(-a)); }
DI float gelu_tanh(float x) {
  float y = 0.7978845608028654f * (x + 0.044715f * x * x * x);
  float t = 1.f - 2.f / (__expf(2.f * y) + 1.f);
  return 0.5f * x * (1.f + t);
}
struct Params;
DI int ada_row(int tok) { return tok < NTL ? (tok >> 12) : 8; }

DI void tr_tile(const float* s0, const float* s1, int ld, int nv0, int nv1, const float* ksc, bf16* dst, int ldd, float* t) {
  const int tid = opaque_tid();
  const int n4 = (tid & 15) * 4, kq = tid >> 4;
  const float* s = (n4 < 32) ? (s0 + n4) : (s1 + (n4 - 32));
  const int nv = (n4 < 32) ? (nv0 - n4) : (nv1 - (n4 - 32));
  __syncthreads();
#pragma unroll
  for (int i = 0; i < 4; ++i) {
    const int k = i * 16 + kq;
    float4 v = make_float4(0.f, 0.f, 0.f, 0.f);
    if (nv >= 4) v = *(const float4*)(s + (size_t)k * ld);
    if (ksc) { const float sc = ksc[k]; v.x *= sc; v.y *= sc; v.z *= sc; v.w *= sc; }
    t[k * 65 + n4] = v.x; t[k * 65 + n4 + 1] = v.y; t[k * 65 + n4 + 2] = v.z; t[k * 65 + n4 + 3] = v.w;
  }
  __syncthreads();
  const int kp = tid & 31, nn = tid >> 5;
#pragma unroll
  for (int i = 0; i < 8; ++i) {
    int n2 = i * 8 + nn;
    float a = t[(2 * kp) * 65 + n2], b = t[(2 * kp + 1) * 65 + n2];
    *(unsigned*)&dst[(size_t)n2 * ldd + 2 * kp] = pack2(a, b);
  }
}

constexpr int NE_TILES = 8192 + 4096;
DI void convert_expert_item(const Params& p, int l, int it, float* sm) {
  if (it < 8192) {
    int e = it >> 9, rem = it & 511, q = rem >> 4, kt = rem & 15;
    const float* g = p.in[I_WGATE] + ((size_t)(l * 16 + e) * 1024 + kt * 64) * 1024 + q * 32;
    const float* u = p.in[I_WUP] + ((size_t)(l * 16 + e) * 1024 + kt * 64) * 1024 + q * 32;
    bf16* dst = (bf16*)(p.ws + OFF_WGU) + ((size_t)e * 2048 + q * 64) * 1024 + kt * 64;
    tr_tile(g, u, 1024, 32, 32, nullptr, dst, 1024, sm);
  } else {
    it -= 8192;
    int e = it >> 8, rem = it & 255, nt = rem >> 4, kt = rem & 15;
    const float* s = p.in[I_WDOWN] + ((size_t)(l * 16 + e) * 1024 + kt * 64) * 1024 + nt * 64;
    bf16* dst = (bf16*)(p.ws + OFF_WD) + ((size_t)e * 1024 + nt * 64) * 1024 + kt * 64;
    tr_tile(s, s + 32, 1024, 32, 32, nullptr, dst, 1024, sm);
  }
}

constexpr int NW_TILES = 576 + 72 + 64 + 256 + 64;
DI void convert_weight_item(const Params& p, int l, int it, float* sm) {
  if (it < 576) {
    int nt = it >> 4, kt = it & 15;
    int n0 = nt * 64;
    int nv0 = min(32, max(0, 2224 - n0)), nv1 = min(32, max(0, 2224 - n0 - 32));
    const float* s = p.in[I_WIN] + ((size_t)l * 1024 + kt * 64) * 2224 + n0;
    bf16* dst = (bf16*)(p.ws + OFF_WIN + l * SZ_WIN1) + (size_t)n0 * 1024 + kt * 64;
    tr_tile(s, s + 32, 2224, nv0, nv1, nullptr, dst, 1024, sm);
    return;
  }
  it -= 576;
  if (it < 72) {
    int nt = it / 6, kt = it % 6;
    const float* s = p.in[I_WUQ] + ((size_t)l * 384 + kt * 64) * 768 + nt * 64;
    bf16* dst = (bf16*)(p.ws + OFF_WUQ + l * SZ_WUQ1) + (size_t)nt * 64 * 384 + kt * 64;
    tr_tile(s, s + 32, 768, 32, 32, p.in[I_QNG] + l * 384 + kt * 64, dst, 384, sm);
    return;
  }
  it -= 72;
  if (it < 64) {
    int nt = it >> 2, kt = it & 3;
    const float* s = p.in[I_WUKV] + ((size_t)l * 256 + kt * 64) * 1024 + nt * 64;
    bf16* dst = (bf16*)(p.ws + OFF_WUKV + l * SZ_WUKV1) + (size_t)nt * 64 * 256 + kt * 64;
    tr_tile(s, s + 32, 1024, 32, 32, p.in[I_KVNG] + l * 256 + kt * 64, dst, 256, sm);
    return;
  }
  it -= 64;
  if (it < 256) {
    int nt = it >> 4, kt = it & 15;
    const float* s = p.in[I_WOUT] + ((size_t)l * 1024 + kt * 64) * 1024 + nt * 64;
    bf16* dst = (bf16*)(p.ws + OFF_WOUT + l * SZ_WOUT1) + (size_t)nt * 64 * 1024 + kt * 64;
    tr_tile(s, s + 32, 1024, 32, 32, nullptr, dst, 1024, sm);
    return;
  }
  it -= 256;
  {
    const int t4 = opaque_tid() * 4;
    const float* s = p.in[I_SGW] + (size_t)l * 65536 + it * 1024 + t4;
    float4 v = *(const float4*)s;
    uint2 o; o.x = pack2(v.x, v.y); o.y = pack2(v.z, v.w);
    *(uint2*)((bf16*)(p.ws + OFF_SGW + l * SZ_SGW1) + it * 1024 + t4) = o;
  }
}

DI void ada_item(const Params& p, int it, float* sm) {
  const int tid = opaque_tid();
  int l = it / 192, cb = it % 192;
  float* sc = sm;
  float* red = sm + 9 * 1024;
  __syncthreads();
  for (int i = tid; i < 9 * 1024; i += NTHR) {
    int r = i >> 10, k = i & 1023;
    float c = r < 8 ? p.in[I_C][r * 1024 + k] : p.in[I_CCTX][k];
    sc[i] = c / (1.f + expf(-c));
  }
  __syncthreads();
  int kg = tid >> 5, cl = tid & 31;
  const float* W = p.in[I_WADA] + (size_t)l * 1024 * 6144 + cb * 32 + cl;
  float acc[9];
#pragma unroll
  for (int r = 0; r < 9; ++r) acc[r] = 0.f;
#pragma unroll 8
  for (int k = kg * 128; k < kg * 128 + 128; ++k) {
    float w = W[(size_t)k * 6144];
#pragma unroll
    for (int r = 0; r < 9; ++r) acc[r] += sc[r * 1024 + k] * w;
  }
#pragma unroll
  for (int r = 0; r < 9; ++r) red[(kg * 9 + r) * 32 + cl] = acc[r];
  __syncthreads();
  float* ada = (float*)(p.ws + OFF_ADA);
  for (int i = tid; i < 288; i += NTHR) {
    int r = i >> 5, c2 = i & 31;
    float s = 0.f;
#pragma unroll
    for (int g = 0; g < 8; ++g) s += red[(g * 9 + r) * 32 + c2];
    ada[(size_t)(l * 9 + r) * 6144 + cb * 32 + c2] = s + p.in[I_BADA][l * 6144 + cb * 32 + c2];
  }
}

DI void row_load(const float* row, float v[16]) {
  const int lane = opaque_tid() & 63;
#pragma unroll
  for (int i = 0; i < 4; ++i) {
    float4 t = *(const float4*)(row + 4 * lane + 256 * i);
    v[4 * i] = t.x; v[4 * i + 1] = t.y; v[4 * i + 2] = t.z; v[4 * i + 3] = t.w;
  }
}
DI void row_store(float* row, const float v[16]) {
  const int lane = opaque_tid() & 63;
#pragma unroll
  for (int i = 0; i < 4; ++i) *(float4*)(row + 4 * lane + 256 * i) = make_float4(v[4 * i], v[4 * i + 1], v[4 * i + 2], v[4 * i + 3]);
}
DI void row_store_bf(bf16* row, const float v[16]) {
  const int lane = opaque_tid() & 63;
#pragma unroll
  for (int i = 0; i < 4; ++i) {
    uint2 o; o.x = pack2(v[4 * i], v[4 * i + 1]); o.y = pack2(v[4 * i + 2], v[4 * i + 3]);
    *(uint2*)(row + 4 * lane + 256 * i) = o;
  }
}
DI void row_norm(float v[16]) {
  float s = 0.f;
#pragma unroll
  for (int i = 0; i < 16; ++i) s += v[i];
  float mean = wave_sum(s) * (1.f / 1024.f);
  float q = 0.f;
#pragma unroll
  for (int i = 0; i < 16; ++i) { v[i] -= mean; q += v[i] * v[i]; }
  float rstd = rsqrtf(wave_sum(q) * (1.f / 1024.f) + LN_EPS);
#pragma unroll
  for (int i = 0; i < 16; ++i) v[i] *= rstd;
}
template <int ONE>
DI void row_affine(float v[16], const float* a, const float* b) {
  const int lane = opaque_tid() & 63;
#pragma unroll
  for (int i = 0; i < 4; ++i) {
    float4 fa = *(const float4*)(a + 4 * lane + 256 * i);
    float4 fb = *(const float4*)(b + 4 * lane + 256 * i);
    v[4 * i] = v[4 * i] * (fa.x + ONE) + fb.x;
    v[4 * i + 1] = v[4 * i + 1] * (fa.y + ONE) + fb.y;
    v[4 * i + 2] = v[4 * i + 2] * (fa.z + ONE) + fb.z;
    v[4 * i + 3] = v[4 * i + 3] * (fa.w + ONE) + fb.w;
  }
}

constexpr int GEMM_STAGE = 128 * 128;
constexpr int GEMM_LDS = 4 * GEMM_STAGE;
template <bool SSQ, int VAR = 0>
DI void gemm_core(const bf16* (&a_row)[4], const bf16* (&b_row)[4], int K, char* smem, float ssq_div, f32x16 (&acc)[2][2]) {
  float* rowscale = (float*)(smem + GEMM_LDS);
  const int tid = opaque_tid(), lane = tid & 63, w = tid >> 6, wm = w >> 1, wn = w & 1, l31 = lane & 31, hh = lane >> 5;
#pragma unroll
  for (int i = 0; i < 2; ++i)
#pragma unroll
    for (int j = 0; j < 2; ++j) acc[i][j] = fzero();
  int srcoff[4];
#pragma unroll
  for (int j = 0; j < 4; ++j) {
    int row = 32 * w + 8 * j + (lane >> 3);
    srcoff[j] = ((lane & 7) ^ ((row >> 1) & 7)) * 8;
  }
  const int nk = K >> 6;
  auto issue = [&](int kt, int buf) {
    char* sa = smem + buf * 2 * GEMM_STAGE;
    char* sb = sa + GEMM_STAGE;
#pragma unroll
    for (int j = 0; j < 4; ++j) {
      const int ldsoff = (32 * __builtin_amdgcn_readfirstlane(w) + 8 * j) * 128;
      __builtin_amdgcn_global_load_lds((const unsigned*)(a_row[j] + kt * 64 + srcoff[j]), (__attribute__((address_space(3))) unsigned*)(sa + ldsoff), 16, 0, 0);
      __builtin_amdgcn_global_load_lds((const unsigned*)(b_row[j] + kt * 64 + srcoff[j]), (__attribute__((address_space(3))) unsigned*)(sb + ldsoff), 16, 0, 0);
    }
  };
  float ssq[2] = {0.f, 0.f};
  asm volatile("s_waitcnt vmcnt(0)" ::: "memory");
  __syncthreads();
  issue(0, 0);
  if (nk > 1) issue(1, 1);
  for (int kt = 0; kt < nk; ++kt) {
    if (kt + 1 < nk) asm volatile("s_waitcnt vmcnt(8)" ::: "memory");
    else asm volatile("s_waitcnt vmcnt(0)" ::: "memory");
    __builtin_amdgcn_s_barrier();
    const char* sa = smem + (kt & 1) * 2 * GEMM_STAGE;
    const char* sb = sa + GEMM_STAGE;
    bf16x8 af[4][2], bfr[4][2];
#pragma unroll
    for (int ks = 0; ks < 4; ++ks) {
#pragma unroll
      for (int i = 0; i < 2; ++i) {
        int row = wm * 64 + i * 32 + l31;
        af[ks][i] = *(const bf16x8*)(sa + row * 128 + (((ks * 2 + hh) ^ ((row >> 1) & 7)) << 4));
      }
#pragma unroll
      for (int j = 0; j < 2; ++j) {
        int row = wn * 64 + j * 32 + l31;
        bfr[ks][j] = *(const bf16x8*)(sb + row * 128 + (((ks * 2 + hh) ^ ((row >> 1) & 7)) << 4));
      }
    }
    __builtin_amdgcn_s_waitcnt(0xc07f);
    __builtin_amdgcn_s_barrier();
    if (kt + 2 < nk) issue(kt + 2, kt & 1);
#pragma unroll
    for (int ks = 0; ks < 4; ++ks) {
      if (SSQ) {
#pragma unroll
        for (int i = 0; i < 2; ++i)
#pragma unroll
          for (int e = 0; e < 8; ++e) { float x = bf2f((bf16)af[ks][i][e]); ssq[i] += x * x; }
      }
#pragma unroll
      for (int i = 0; i < 2; ++i)
#pragma unroll
        for (int j = 0; j < 2; ++j) acc[i][j] = mfma(af[ks][i], bfr[ks][j], acc[i][j]);
    }
  }
  __syncthreads();
  if (SSQ) {
#pragma unroll
    for (int i = 0; i < 2; ++i) {
      float s = ssq[i] + shx(ssq[i], 32);
      if (hh == 0 && wn == 0) rowscale[wm * 64 + i * 32 + l31] = rsqrtf(s * ssq_div + LN_EPS);
    }
    __syncthreads();
  }
}

DI void inproj_tile(const Params& p, int l, int tm, int tn, char* smem) {
  const int tid = opaque_tid(), lane = tid & 63, w = tid >> 6, wm = w >> 1, wn = w & 1, l31 = lane & 31, hh = lane >> 5;
  const bf16* A = (const bf16*)(p.ws + OFF_Y);
  const bf16* Bt = (const bf16*)(p.ws + OFF_WIN + l * SZ_WIN1);
  const bf16* ap[4]; const bf16* bp[4];
#pragma unroll
  for (int j = 0; j < 4; ++j) {
    int r = 32 * (tid >> 6) + 8 * j + ((tid & 63) >> 3);
    ap[j] = A + (size_t)(tm * 128 + r) * 1024;
    bp[j] = Bt + (size_t)(tn * 128 + r) * 1024;
  }
  f32x16 acc[2][2];
  gemm_core<false>(ap, bp, 1024, smem, 0.f, acc);
  bf16* T = (bf16*)smem;
  float* Gt = (float*)(p.ws + OFF_GATES) + (size_t)tm * 128 * 16;
  const int lrow = wm * 64 + 4 * hh;
  __syncthreads();
#pragma unroll
  for (int j = 0; j < 2; ++j) {
    const int cbase = tn * 128 + wn * 64 + j * 32;
    const int gn = cbase + l31;
    const float bias = gn < 2224 ? p.in[I_BIN][l * 2224 + gn] : 0.f;
    const int toff = lrow * 136 + wn * 64 + j * 32 + l31;
    const int goff = lrow * 16 + l31;
#pragma unroll
    for (int i = 0; i < 2; ++i)
#pragma unroll
      for (int r = 0; r < 16; ++r) {
        const int mo = i * 32 + 8 * (r >> 2) + (r & 3);
        float v = acc[i][j][r] + bias;
        if (cbase < 512) v = gelu_tanh(v);
        T[toff + mo * 136] = f2bf(v);
        if (cbase == 2208 && l31 < 16) Gt[goff + mo * 16] = v;
      }
  }
  __syncthreads();
  {
    bf16* Zt = (bf16*)(p.ws + OFF_Z) + (size_t)tm * 128 * ZS + tn * 128;
    const int cmax = (2208 - tn * 128) >> 3;
#pragma unroll
    for (int i = 0; i < 8; ++i) {
      const int id = tid + 256 * i, row = id >> 4, c = id & 15;
      if (c < cmax) *(u32x4*)(Zt + (size_t)row * ZS + c * 8) = *(const u32x4*)(T + row * 136 + c * 8);
    }
  }
}

DI void uq_tile(const Params& p, int l, int tm, int tn, char* smem) {
  const int tid = opaque_tid(), lane = tid & 63, w = tid >> 6, wm = w >> 1, wn = w & 1, l31 = lane & 31, hh = lane >> 5;
  const bf16* Z = (const bf16*)(p.ws + OFF_Z);
  const bf16* Bt = (const bf16*)(p.ws + OFF_WUQ + l * SZ_WUQ1);
  const bf16* ap[4]; const bf16* bp[4];
#pragma unroll
  for (int j = 0; j < 4; ++j) {
    int r = 32 * (tid >> 6) + 8 * j + ((tid & 63) >> 3);
    ap[j] = Z + (size_t)(tm * 128 + r) * ZS + 512;
    bp[j] = Bt + (size_t)(tn * 128 + r) * 384;
  }
  f32x16 acc[2][2];
  gemm_core<true>(ap, bp, 384, smem, 1.f / 384.f, acc);
  const float* rowscale = (const float*)(smem + GEMM_LDS);
  float2* ropes = (float2*)(smem + GEMM_LDS + 512);
  bf16* T = (bf16*)smem;
  const int tok0 = tm * 128;
  const bool lat = tok0 < NTL;
  const int b = lat ? (tok0 >> 12) : ((tok0 - NTL) >> 8);
  const int pos0 = lat ? (tok0 & 4095) : ((tok0 - NTL) & 255);
  const int qbase = lat ? pos0 : 4096 + pos0;
  const int lrow = wm * 64 + 4 * hh;
  ropes[tid] = ((const float2*)(p.ws + OFF_ROPE))[tid];
  ropes[256 + tid] = ((const float2*)(p.ws + OFF_ROPE))[256 + tid];
  __syncthreads();
#pragma unroll
  for (int j = 0; j < 2; ++j) {
    const int cb = tn * 4 + wn * 2 + j;
    const int seg = cb % 3;
#pragma unroll
    for (int i = 0; i < 2; ++i)
#pragma unroll
      for (int r = 0; r < 16; ++r) {
        const int m = lrow + i * 32 + 8 * (r >> 2) + (r & 3);
        float v = acc[i][j][r] * rowscale[m] * QSCALE;
        if (seg == 2) {
          float pr = shx(v, 8);
          if (lat) {
            const int pos = pos0 + m;
            const int ap2 = (l31 & 16) ? (pos & 63) : (pos >> 6);
            const float2 cs = ropes[ap2 * 8 + (l31 & 7)];
            v = (l31 & 8) ? (v * cs.x + pr * cs.y) : (v * cs.x - pr * cs.y);
          }
        }
        T[m * 136 + wn * 64 + j * 32 + l31] = f2bf(v);
      }
  }
  __syncthreads();
  {
    bf16* Qb = (bf16*)((char*)p.out + OOFF_Q);
#pragma unroll
    for (int i = 0; i < 8; ++i) {
      const int id = tid + 256 * i, row = id >> 4, c = id & 15;
      const int col = tn * 128 + c * 8, hq = col / 96, d = col - hq * 96;
      *(u32x4*)(Qb + ((size_t)(b * 8 + hq) * KTOT + qbase + row) * 96 + d) = *(const u32x4*)(T + row * 136 + c * 8);
    }
  }
}

DI void ukv_tile(const Params& p, int l, int tm, int tn, char* smem) {
  const int tid = opaque_tid(), lane = tid & 63, w = tid >> 6, wm = w >> 1, wn = w & 1, l31 = lane & 31, hh = lane >> 5;
  const bf16* Z = (const bf16*)(p.ws + OFF_Z);
  const bf16* Bt = (const bf16*)(p.ws + OFF_WUKV + l * SZ_WUKV1);
  const bf16* ap[4]; const bf16* bp[4];
#pragma unroll
  for (int j = 0; j < 4; ++j) {
    int r = 32 * (tid >> 6) + 8 * j + ((tid & 63) >> 3);
    ap[j] = Z + (size_t)(tm * 128 + r) * ZS + 896;
    bp[j] = Bt + (size_t)(tn * 128 + r) * 256;
  }
  f32x16 acc[2][2];
  gemm_core<true>(ap, bp, 256, smem, 1.f / 256.f, acc);
  const float* rowscale = (const float*)(smem + GEMM_LDS);
  const int tok0 = tm * 128;
  const bool lat = tok0 < NTL;
  const int b = lat ? (tok0 >> 12) : ((tok0 - NTL) >> 8);
  const int kbase = lat ? (tok0 & 4095) : 4096 + ((tok0 - NTL) & 255);
  const int bh = b * 8 + tn;
  bf16* TK = (bf16*)smem;
  bf16* TV = TK + 128 * 72;
  const int lrow = wm * 64 + 4 * hh;
  __syncthreads();
#pragma unroll
  for (int j = 0; j < 2; ++j)
#pragma unroll
    for (int i = 0; i < 2; ++i)
#pragma unroll
      for (int r = 0; r < 16; ++r) {
        const int m = lrow + i * 32 + 8 * (r >> 2) + (r & 3);
        const bf16 v = f2bf(acc[i][j][r] * rowscale[m]);
        if (wn == 0) TK[m * 72 + j * 32 + l31] = v;
        else TV[(j * 32 + l31) * 136 + m] = v;
      }
  __syncthreads();
  {
    bf16* KNt = (bf16*)(p.ws + OFF_KN) + ((size_t)bh * KTOT + kbase) * 64;
    bf16* VTt = (bf16*)(p.ws + OFF_VT) + (size_t)bh * 64 * KTOT + kbase;
#pragma unroll
    for (int i = 0; i < 4; ++i) {
      const int id = tid + 256 * i;
      { const int row = id >> 3, c = id & 7; *(u32x4*)(KNt + (size_t)row * 64 + c * 8) = *(const u32x4*)(TK + row * 72 + c * 8); }
      { const int dv = id >> 4, c = id & 15; *(u32x4*)(VTt + (size_t)dv * KTOT + c * 8) = *(const u32x4*)(TV + dv * 136 + c * 8); }
    }
  }
}

DI void krope_item(const Params& p, int tm) {
  const int tid = opaque_tid();
  const bf16* Z = (const bf16*)(p.ws + OFF_Z);
  bf16* KR = (bf16*)(p.ws + OFF_KR);
  const float2* rope = (const float2*)(p.ws + OFF_ROPE);
  int tok = tm * 128 + (tid >> 1), half = tid & 1;
  const bool lat = tok < NTL;
  int b = lat ? (tok >> 12) : ((tok - NTL) >> 8);
  int pos = lat ? (tok & 4095) : ((tok - NTL) & 255);
  int kpos = lat ? pos : 4096 + pos;
  const uint4* src = (const uint4*)(Z + (size_t)tok * ZS + 1152 + half * 16);
  uint4 u0 = src[0], u1 = src[1];
  float z[16];
  z[0] = bflo(u0.x); z[1] = bfhi(u0.x); z[2] = bflo(u0.y); z[3] = bfhi(u0.y);
  z[4] = bflo(u0.z); z[5] = bfhi(u0.z); z[6] = bflo(u0.w); z[7] = bfhi(u0.w);
  z[8] = bflo(u1.x); z[9] = bfhi(u1.x); z[10] = bflo(u1.y); z[11] = bfhi(u1.y);
  z[12] = bflo(u1.z); z[13] = bfhi(u1.z); z[14] = bflo(u1.w); z[15] = bfhi(u1.w);
  float o[16];
  if (lat) {
    int ap2 = half ? (pos & 63) : (pos >> 6);
#pragma unroll
    for (int jj = 0; jj < 8; ++jj) {
      float2 cs = rope[ap2 * 8 + jj];
      o[jj] = z[jj] * cs.x - z[8 + jj] * cs.y;
      o[8 + jj] = z[8 + jj] * cs.x + z[jj] * cs.y;
    }
  } else {
#pragma unroll
    for (int jj = 0; jj < 16; ++jj) o[jj] = z[jj];
  }
  uint4 w0, w1;
  w0.x = pack2(o[0], o[1]); w0.y = pack2(o[2], o[3]); w0.z = pack2(o[4], o[5]); w0.w = pack2(o[6], o[7]);
  w1.x = pack2(o[8], o[9]); w1.y = pack2(o[10], o[11]); w1.z = pack2(o[12], o[13]); w1.w = pack2(o[14], o[15]);
  uint4* dst = (uint4*)(KR + ((size_t)b * KTOT + kpos) * 32 + half * 16);
  dst[0] = w0; dst[1] = w1;
}

DI void gmlp_item(const Params& p, int l, int c, char* smem) {
  const int tid = opaque_tid(), lane = tid & 63, w = tid >> 6, l31 = lane & 31, hh = lane >> 5;
  bf16* vT = (bf16*)smem;
  float* st = (float*)(smem + 128 * 136 * 2);
  float* lng = st + 256;
  float* lnb = lng + 256;
  float* sgbs = lnb + 256;
  const bf16* Z = (const bf16*)(p.ws + OFF_Z);
  bf16* Y = (bf16*)(p.ws + OFF_Y);
  const bf16* SGW = (const bf16*)(p.ws + OFF_SGW + l * SZ_SGW1);
  const int tok0 = c * 128;
  __syncthreads();
  lng[tid] = p.in[I_SGLNG][l * 256 + tid]; lnb[tid] = p.in[I_SGLNB][l * 256 + tid];
  sgbs[tid] = p.in[I_SGB][l * 512 + tid]; sgbs[256 + tid] = p.in[I_SGB][l * 512 + 256 + tid];
  {
    int t = tid >> 1, half = tid & 1;
    const uint4* src = (const uint4*)(Z + (size_t)(tok0 + t) * ZS + 256 + half * 128);
    float s = 0.f, q = 0.f;
#pragma unroll 4
    for (int i = 0; i < 16; ++i) {
      uint4 u = src[i];
      float a0 = bflo(u.x), a1 = bfhi(u.x), a2 = bflo(u.y), a3 = bfhi(u.y), a4 = bflo(u.z), a5 = bfhi(u.z), a6 = bflo(u.w), a7 = bfhi(u.w);
      s += a0 + a1 + a2 + a3 + a4 + a5 + a6 + a7;
      q += a0 * a0 + a1 * a1 + a2 * a2 + a3 * a3 + a4 * a4 + a5 * a5 + a6 * a6 + a7 * a7;
    }
    s += shx(s, 1); q += shx(q, 1);
    float mean = s * (1.f / 256.f);
    float var = fmaxf(q * (1.f / 256.f) - mean * mean, 0.f);
    if (half == 0) { st[2 * t] = mean; st[2 * t + 1] = rsqrtf(var + LN_EPS); }
  }
  for (int rd = 0; rd < 2; ++rd) {
    __syncthreads();
#pragma unroll 2
    for (int i = 0; i < 8; ++i) {
      int id = tid + 256 * i;
      int t = id & 127, cc = id >> 7;
      int ch0 = rd * 128 + cc * 8;
      uint4 u = *(const uint4*)(Z + (size_t)(tok0 + t) * ZS + 256 + ch0);
      float mean = st[2 * t], rstd = st[2 * t + 1];
      float a[8] = {bflo(u.x), bfhi(u.x), bflo(u.y), bfhi(u.y), bflo(u.z), bfhi(u.z), bflo(u.w), bfhi(u.w)};
#pragma unroll
      for (int e = 0; e < 8; ++e) {
        float g = lng[ch0 + e], bb = lnb[ch0 + e];
        vT[(cc * 8 + e) * 136 + t] = f2bf((a[e] - mean) * rstd * g + bb);
      }
    }
    __syncthreads();
    const int g = 2 * rd + (w >> 1), tb2 = w & 1;
    f32x16 acc[2][2];
#pragma unroll
    for (int i = 0; i < 2; ++i)
#pragma unroll
      for (int j = 0; j < 2; ++j) acc[i][j] = fzero();
#pragma unroll 2
    for (int ks = 0; ks < 8; ++ks) {
      bf16x8 af[2], bfr[2];
#pragma unroll
      for (int i = 0; i < 2; ++i) af[i] = *(const bf16x8*)(SGW + ((size_t)g * 128 + tb2 * 64 + i * 32 + l31) * 128 + ks * 16 + hh * 8);
#pragma unroll
      for (int j = 0; j < 2; ++j) bfr[j] = *(const bf16x8*)&vT[((w >> 1) * 64 + j * 32 + l31) * 136 + ks * 16 + hh * 8];
#pragma unroll
      for (int i = 0; i < 2; ++i)
#pragma unroll
        for (int j = 0; j < 2; ++j) acc[i][j] = mfma(af[i], bfr[j], acc[i][j]);
    }
    __syncthreads();
    {
      const float* sgb = sgbs + g * 128;
      const int lrow = tb2 * 64 + 4 * hh;
#pragma unroll
      for (int i = 0; i < 2; ++i)
#pragma unroll
        for (int j = 0; j < 2; ++j) {
          const int to = lrow * 136 + (w >> 1) * 64 + j * 32 + l31;
#pragma unroll
          for (int r = 0; r < 16; ++r) {
            const int mo = i * 32 + 8 * (r >> 2) + (r & 3);
            vT[to + mo * 136] = f2bf(acc[i][j][r] + sgb[lrow + mo]);
          }
        }
    }
    __syncthreads();
#pragma unroll 2
    for (int i = 0; i < 8; ++i) {
      const int id = tid + 256 * i, row = id >> 4, cc = id & 15;
      const u32x4 uu = *(const u32x4*)(Z + (size_t)(tok0 + row) * ZS + rd * 128 + cc * 8);
      const u32x4 mm = *(const u32x4*)(vT + row * 136 + cc * 8);
      u32x4 o;
      o.x = pack2(bflo(uu.x) * bflo(mm.x), bfhi(uu.x) * bfhi(mm.x));
      o.y = pack2(bflo(uu.y) * bflo(mm.y), bfhi(uu.y) * bfhi(mm.y));
      o.z = pack2(bflo(uu.z) * bflo(mm.z), bfhi(uu.z) * bfhi(mm.z));
      o.w = pack2(bflo(uu.w) * bflo(mm.w), bfhi(uu.w) * bfhi(mm.w));
      *(u32x4*)(Y + (size_t)(tok0 + row) * 1024 + rd * 128 + cc * 8) = o;
    }
  }
}

DI float conv_silu(const Params& p, int l, const bf16* Z, int seq0, int slen, int pos, int zcol, int ch) {
  float a = p.in[I_CONVB][l * 512 + ch];
#pragma unroll
  for (int tap = 0; tap < 5; ++tap) {
    int pp = pos + tap - 2;
    if (pp >= 0 && pp < slen) a += p.in[I_CONVW][(l * 5 + tap) * 512 + ch] * bf2f(Z[(size_t)(seq0 + pp) * ZS + zcol]);
  }
  return silu_f(a);
}
DI void conv16(const Params& p, int l, const bf16* Zcol, int slen, int pos_start, int ch, float (&out)[16]) {
  float wgt[5];
#pragma unroll
  for (int tap = 0; tap < 5; ++tap) wgt[tap] = p.in[I_CONVW][(l * 5 + tap) * 512 + ch];
  const float bias = p.in[I_CONVB][l * 512 + ch];
  float x[20];
#pragma unroll
  for (int i = 0; i < 20; ++i) {
    int pp = pos_start - 2 + i;
    x[i] = (pp >= 0 && pp < slen) ? bf2f(Zcol[(size_t)pp * ZS]) : 0.f;
  }
#pragma unroll
  for (int i = 0; i < 16; ++i) {
    float a = bias;
#pragma unroll
    for (int tap = 0; tap < 5; ++tap) a += wgt[tap] * x[i + tap];
    out[i] = silu_f(a);
  }
}
DI void stage_rows68(const bf16* Zseq  , int slen, int pos_start, bf16* raw) {
  const int tid = opaque_tid();
#pragma unroll
  for (int i = 0; i < 3; ++i) {
    const int id = tid + 256 * i;
    if (id < 68 * 8) {
      const int row = id >> 3, c = id & 7, pp = pos_start - 2 + row;
      u32x4 u = {0u, 0u, 0u, 0u};
      if (pp >= 0 && pp < slen) u = *(const u32x4*)(Zseq + (size_t)pp * ZS + c * 8);
      *(u32x4*)(raw + row * 64 + c * 8) = u;
    }
  }
}
DI void conv16_lds(const Params& p, int l, const bf16* rawcol  , int row0, int ch, float (&out)[16]) {
  float wgt[5];
#pragma unroll
  for (int tap = 0; tap < 5; ++tap) wgt[tap] = p.in[I_CONVW][(l * 5 + tap) * 512 + ch];
  const float bias = p.in[I_CONVB][l * 512 + ch];
  float x[20];
#pragma unroll
  for (int i = 0; i < 20; ++i) x[i] = bf2f(rawcol[(row0 + i) * 64]);
#pragma unroll
  for (int i = 0; i < 16; ++i) {
    float a = bias;
#pragma unroll
    for (int tap = 0; tap < 5; ++tap) a += wgt[tap] * x[i + tap];
    out[i] = silu_f(a);
  }
}
DI float log_sigmoid_f(float x) { return fminf(x, 0.f) - __logf(1.f + __expf(-fabsf(x))); }

DI void ml1_item(const Params& p, int l, int b, int h, int c, char* smem) {
  const int tid = opaque_tid(), lane = tid & 63, w = tid >> 6, l31 = lane & 31, hh = lane >> 5;
  bf16* kT = (bf16*)smem;
  bf16* wvT = kT + 64 * 72;
  float* lf = (float*)(wvT + 2 * 64 * 72);
  float* li = lf + 128;
  float* wv = li + 128;
  float* misc = wv + 128;
  bf16* kraw = (bf16*)(misc + 4);
  bf16* vraw = kraw + 68 * 64;
  const bf16* Z = (const bf16*)(p.ws + OFF_Z);
  const float* G = (const float*)(p.ws + OFF_GATES);
  int seq0, slen, pos0;
  if (c < 64) { seq0 = b * 4096; slen = 4096; pos0 = c * 64; } else { seq0 = NTL + b * 256; slen = 256; pos0 = (c - 64) * 64; }
  const int bh = b * 4 + h;
  __syncthreads();
  if (tid < 128) {
    int dir = tid >> 6, s = tid & 63;
    const float* g = G + (size_t)(seq0 + pos0 + s) * 16 + dir * 8 + h;
    li[tid] = g[0];
    lf[tid] = log_sigmoid_f(g[4] + p.in[I_FBIAS][l * 8 + dir * 4 + h]);
  }
  stage_rows68(Z + (size_t)seq0 * ZS + 1440 + h * 64, slen, pos0, kraw);
#pragma unroll
  for (int i = 0; i < 2; ++i) {
    const int id = tid + 256 * i, row = id >> 3, cc = id & 7;
    *(u32x4*)(vraw + row * 64 + cc * 8) = *(const u32x4*)(Z + (size_t)(seq0 + pos0 + row) * ZS + 1696 + h * 64 + cc * 8);
  }
  __syncthreads();
  {
    const int j = tid & 63, sg = tid >> 6;
    float kk[16];
    conv16_lds(p, l, kraw + j, sg * 16, 256 + h * 64 + j, kk);
#pragma unroll
    for (int i = 0; i < 16; i += 2) *(unsigned*)&kT[j * 72 + sg * 16 + i] = pack2(kk[i] * 0.125f, kk[i + 1] * 0.125f);
  }
  __syncthreads();
  if (w < 2) {
    const int dir = w, sidx = dir ? 63 - lane : lane;
    float cum = wave_scan_add(lf[dir * 64 + sidx]);
    float bend = __int_as_float(__builtin_amdgcn_readlane(__float_as_int(cum), 63));
    float g = bend - cum + li[dir * 64 + sidx];
    float mloc = wave_max(g);
    wv[dir * 64 + sidx] = __expf(g - mloc);
    if (lane == 0) { misc[dir * 2] = mloc; misc[dir * 2 + 1] = bend; }
  }
  __syncthreads();
  for (int e = tid; e < 4096; e += NTHR) {
    int s = e >> 6, i = e & 63;
    float v = bf2f(vraw[s * 64 + i]);
    wvT[i * 72 + s] = f2bf(v * wv[s]);
    wvT[(64 + i) * 72 + s] = f2bf(v * wv[64 + s]);
  }
  __syncthreads();
  float* SC = (float*)((char*)p.out + OOFF_SC);
  float* SN = (float*)((char*)p.out + OOFF_SN);
  float* SM = (float*)(p.ws + OFF_SM);
  {
    const int dir = w >> 1, ib = w & 1;
    f32x16 acc[2]; acc[0] = fzero(); acc[1] = fzero();
#pragma unroll
    for (int ks = 0; ks < 4; ++ks) {
      bf16x8 a = *(const bf16x8*)&wvT[(dir * 64 + ib * 32 + l31) * 72 + ks * 16 + hh * 8];
#pragma unroll
      for (int jb = 0; jb < 2; ++jb) {
        bf16x8 bb = *(const bf16x8*)&kT[(jb * 32 + l31) * 72 + ks * 16 + hh * 8];
        acc[jb] = mfma(a, bb, acc[jb]);
      }
    }
    float* dst = SC + ((size_t)(bh * 2 + dir) * 68 + c) * 4096;
#pragma unroll
    for (int jb = 0; jb < 2; ++jb)
#pragma unroll
      for (int r = 0; r < 16; ++r) dst[(ib * 32 + crow(r, hh)) * 64 + jb * 32 + l31] = acc[jb][r];
  }
  if (tid < 128) {
    int dir = tid >> 6, j = tid & 63;
    float a = 0.f;
    for (int s = 0; s < 64; ++s) a += wv[dir * 64 + s] * bf2f(kT[j * 72 + s]);
    SN[((size_t)(bh * 2 + dir) * 68 + c) * 64 + j] = a;
  }
  if (tid == 0 || tid == 64) {
    int dir = tid >> 6;
    float* sm = SM + ((size_t)(bh * 2 + dir) * 68 + c) * 4;
    sm[0] = misc[dir * 2]; sm[1] = misc[dir * 2 + 1];
  }
}

DI void ml2_item(const Params& p, int it, char* smem) {
  const int tid = opaque_tid();
  const int eb = it & 15, bd = it >> 4;
  const int dir = bd & 1;
  float* aa = (float*)smem;
  float* ss = aa + 68;
  float* SC = (float*)((char*)p.out + OOFF_SC) + (size_t)bd * 68 * 4096;
  float* SN = (float*)((char*)p.out + OOFF_SN) + (size_t)bd * 68 * 64;
  float* SM = (float*)(p.ws + OFF_SM) + (size_t)bd * 68 * 4;
  float* mls = ss + 68;
  float* bes = mls + 68;
  float* m0s = bes + 68;
  __syncthreads();
  if (tid < 68) { mls[tid] = SM[tid * 4]; bes[tid] = SM[tid * 4 + 1]; }
  __syncthreads();
  if (tid == 0) {
    float m = 0.f;
    for (int n = 0; n < 68; ++n) {
      int c = (n < 4) ? (dir ? 67 - n : 64 + n) : (dir ? 67 - n : n - 4);
      float ml = mls[c], be = bes[c];
      float mn = fmaxf(be + m, ml);
      aa[n] = __expf(be + m - mn);
      ss[n] = __expf(ml - mn);
      m0s[c] = m;
      m = mn;
    }
  }
  __syncthreads();
  if (eb == 0 && tid < 68) SM[tid * 4 + 2] = m0s[tid];
  {
    const int e = eb * 256 + tid;
    float cl[68];
#pragma unroll
    for (int n = 0; n < 68; ++n) {
      int c = (n < 4) ? (dir ? 67 - n : 64 + n) : (dir ? 67 - n : n - 4);
      cl[n] = SC[(size_t)c * 4096 + e];
    }
    float C = 0.f;
#pragma unroll
    for (int n = 0; n < 68; ++n) {
      int c = (n < 4) ? (dir ? 67 - n : 64 + n) : (dir ? 67 - n : n - 4);
      SC[(size_t)c * 4096 + e] = C;
      C = aa[n] * C + ss[n] * cl[n];
    }
  }
  if (eb == 0 && tid < 64) {
    float C = 0.f;
    for (int n = 0; n < 68; ++n) {
      int c = (n < 4) ? (dir ? 67 - n : 64 + n) : (dir ? 67 - n : n - 4);
      float cl = SN[c * 64 + tid];
      SN[c * 64 + tid] = C;
      C = aa[n] * C + ss[n] * cl;
    }
  }
}

DI void ml3_item(const Params& p, int l, int b, int h, int c, char* smem) {
  const int tid = opaque_tid(), lane = tid & 63, w = tid >> 6, l31 = lane & 31, hh = lane >> 5;
  bf16* qs = (bf16*)smem;
  bf16* ks_ = qs + 64 * 72;
  bf16* vT = ks_ + 64 * 72;
  float* hbuf = (float*)(vT + 64 * 72);
  float* lf = hbuf + 64 * 65;
  float* li = lf + 128;
  float* bc = li + 128;
  float* cv = bc + 128;
  float* mt = cv + 128;
  float* n0s = mt + 128;
  float* m0s = n0s + 128;
  bf16* qraw = (bf16*)(m0s + 4);
  bf16* kraw = qraw + 68 * 64;
  const bf16* Z = (const bf16*)(p.ws + OFF_Z);
  const float* G = (const float*)(p.ws + OFF_GATES);
  bf16* Y = (bf16*)(p.ws + OFF_Y);
  int seq0, slen, pos0;
  if (c < 64) { seq0 = b * 4096; slen = 4096; pos0 = c * 64; } else { seq0 = NTL + b * 256; slen = 256; pos0 = (c - 64) * 64; }
  const int bh = b * 4 + h;
  const float* SC = (const float*)((char*)p.out + OOFF_SC);
  const float* SN = (const float*)((char*)p.out + OOFF_SN);
  const float* SM = (const float*)(p.ws + OFF_SM);
  __syncthreads();
  if (tid < 128) {
    int dir = tid >> 6, s = tid & 63;
    const float* g = G + (size_t)(seq0 + pos0 + s) * 16 + dir * 8 + h;
    li[tid] = g[0];
    lf[tid] = log_sigmoid_f(g[4] + p.in[I_FBIAS][l * 8 + dir * 4 + h]);
    n0s[tid] = SN[((size_t)(bh * 2 + dir) * 68 + c) * 64 + s];
  }
  if (tid < 2) m0s[tid] = SM[((size_t)(bh * 2 + tid) * 68 + c) * 4 + 2];
  stage_rows68(Z + (size_t)seq0 * ZS + 1184 + h * 64, slen, pos0, qraw);
  stage_rows68(Z + (size_t)seq0 * ZS + 1440 + h * 64, slen, pos0, kraw);
#pragma unroll
  for (int i = 0; i < 2; ++i) {
    const int id = tid + 256 * i, row = id >> 3, cc = id & 7;
    u32x4 u = *(const u32x4*)(Z + (size_t)(seq0 + pos0 + row) * ZS + 1696 + h * 64 + cc * 8);
    bf16* d = vT + (cc * 8) * 72 + row;
    d[0 * 72] = (bf16)(u.x & 0xffffu); d[1 * 72] = (bf16)(u.x >> 16);
    d[2 * 72] = (bf16)(u.y & 0xffffu); d[3 * 72] = (bf16)(u.y >> 16);
    d[4 * 72] = (bf16)(u.z & 0xffffu); d[5 * 72] = (bf16)(u.z >> 16);
    d[6 * 72] = (bf16)(u.w & 0xffffu); d[7 * 72] = (bf16)(u.w >> 16);
  }
  __syncthreads();
  {
    const int j = tid & 63, sg = tid >> 6;
    float qq[16], kk[16];
    conv16_lds(p, l, qraw + j, sg * 16, h * 64 + j, qq);
    conv16_lds(p, l, kraw + j, sg * 16, 256 + h * 64 + j, kk);
#pragma unroll
    for (int i = 0; i < 16; ++i) {
      qs[(sg * 16 + i) * 72 + j] = f2bf(qq[i]);
      ks_[(sg * 16 + i) * 72 + j] = f2bf(kk[i] * 0.125f);
    }
  }
  __syncthreads();
  if (w < 2) {
    const int dr = w, sidx = dr ? 63 - lane : lane;
    float cum = wave_scan_add(lf[dr * 64 + sidx]);
    float x = li[dr * 64 + sidx] - cum;
    float pm = wave_scan_max(x);
    bc[dr * 64 + sidx] = cum; cv[dr * 64 + sidx] = x;
    mt[dr * 64 + sidx] = fmaxf(cum + m0s[dr], cum + pm);
  }
  __syncthreads();
  const int dir = w >> 1, tb = w & 1;
  const int t = tb * 32 + l31;
  bf16x8 qf[4];
#pragma unroll
  for (int ks = 0; ks < 4; ++ks) qf[ks] = *(const bf16x8*)&qs[t * 72 + ks * 16 + hh * 8];
  f32x16 sacc[2]; sacc[0] = fzero(); sacc[1] = fzero();
#pragma unroll
  for (int sb = 0; sb < 2; ++sb)
#pragma unroll
    for (int ks = 0; ks < 4; ++ks) {
      bf16x8 a = *(const bf16x8*)&ks_[(sb * 32 + l31) * 72 + ks * 16 + hh * 8];
      sacc[sb] = mfma(a, qf[ks], sacc[sb]);
    }
  const float bt = bc[dir * 64 + t], mtt = mt[dir * 64 + t], m0d = m0s[dir];
  const float base = bt - mtt;
  float psum = 0.f;
#pragma unroll
  for (int sb = 0; sb < 2; ++sb)
#pragma unroll
    for (int r = 0; r < 16; ++r) {
      int s = sb * 32 + crow(r, hh);
      bool valid = dir ? (s >= t) : (s <= t);
      float pv = valid ? __expf(base + cv[dir * 64 + s]) * sacc[sb][r] : 0.f;
      psum += pv;
      sacc[sb][r] = pv;
    }
  psum += shx(psum, 32);
  f32x16 num1[2], num2[2];
  num1[0] = fzero(); num1[1] = fzero(); num2[0] = fzero(); num2[1] = fzero();
#pragma unroll
  for (int slab = 0; slab < 4; ++slab) {
    const int sb = slab >> 1, s2 = slab & 1;
    uint4 pu;
    pu.x = pack2(sacc[sb][8 * s2 + 0], sacc[sb][8 * s2 + 1]);
    pu.y = pack2(sacc[sb][8 * s2 + 2], sacc[sb][8 * s2 + 3]);
    pu.z = pack2(sacc[sb][8 * s2 + 4], sacc[sb][8 * s2 + 5]);
    pu.w = pack2(sacc[sb][8 * s2 + 6], sacc[sb][8 * s2 + 7]);
    bf16x8 pf = __builtin_bit_cast(bf16x8, pu);
#pragma unroll
    for (int ib = 0; ib < 2; ++ib) {
      uint2 lo = *(const uint2*)&vT[(ib * 32 + l31) * 72 + slab * 16 + 4 * hh];
      uint2 hi = *(const uint2*)&vT[(ib * 32 + l31) * 72 + slab * 16 + 8 + 4 * hh];
      uint4 au; au.x = lo.x; au.y = lo.y; au.z = hi.x; au.w = hi.y;
      num2[ib] = mfma(__builtin_bit_cast(bf16x8, au), pf, num2[ib]);
    }
  }
  {
    const float* C0 = SC + ((size_t)(bh * 2 + dir) * 68 + c) * 4096;
#pragma unroll
    for (int ib = 0; ib < 2; ++ib)
#pragma unroll
      for (int ks = 0; ks < 4; ++ks) {
        const float4* src = (const float4*)(C0 + (ib * 32 + l31) * 64 + ks * 16 + hh * 8);
        float4 f0 = src[0], f1 = src[1];
        uint4 au; au.x = pack2(f0.x, f0.y); au.y = pack2(f0.z, f0.w); au.z = pack2(f1.x, f1.y); au.w = pack2(f1.z, f1.w);
        num1[ib] = mfma(__builtin_bit_cast(bf16x8, au), qf[ks], num1[ib]);
      }
  }
  float nq = 0.f;
#pragma unroll
  for (int ks = 0; ks < 4; ++ks)
#pragma unroll
    for (int e = 0; e < 8; ++e) nq += bf2f((bf16)qf[ks][e]) * n0s[dir * 64 + ks * 16 + hh * 8 + e];
  nq += shx(nq, 32);
  const float inter = __expf(bt + m0d - mtt);
  const float den = inter * nq + psum;
  const float inv = 1.f / fmaxf(fabsf(den), __expf(-mtt));
#pragma unroll
  for (int ib = 0; ib < 2; ++ib)
#pragma unroll
    for (int r = 0; r < 16; ++r) num2[ib][r] = (inter * num1[ib][r] + num2[ib][r]) * inv;
  if (dir == 1) {
#pragma unroll
    for (int ib = 0; ib < 2; ++ib)
#pragma unroll
      for (int r = 0; r < 16; ++r) hbuf[t * 65 + ib * 32 + crow(r, hh)] = num2[ib][r];
  }
  __syncthreads();
  if (dir == 0) {
    float s = 0.f;
#pragma unroll
    for (int ib = 0; ib < 2; ++ib)
#pragma unroll
      for (int r = 0; r < 16; ++r) { num2[ib][r] += hbuf[t * 65 + ib * 32 + crow(r, hh)]; s += num2[ib][r]; }
    s += shx(s, 32);
    float mean = s * (1.f / 64.f);
    float q = 0.f;
#pragma unroll
    for (int ib = 0; ib < 2; ++ib)
#pragma unroll
      for (int r = 0; r < 16; ++r) { num2[ib][r] -= mean; q += num2[ib][r] * num2[ib][r]; }
    q += shx(q, 32);
    float rstd = rsqrtf(q * (1.f / 64.f) + LN_EPS);
    const int tok = seq0 + pos0 + t;
#pragma unroll
    for (int ib = 0; ib < 2; ++ib)
#pragma unroll
      for (int rg = 0; rg < 4; ++rg) {
        int i0 = ib * 32 + 8 * rg + 4 * hh;
        uint2 ou = *(const uint2*)&Z[(size_t)tok * ZS + 1952 + h * 64 + i0];
        float og[4] = {bflo(ou.x), bfhi(ou.x), bflo(ou.y), bfhi(ou.y)};
        float y[4];
#pragma unroll
        for (int e = 0; e < 4; ++e) y[e] = num2[ib][4 * rg + e] * rstd * p.in[I_MLNG][l * 256 + h * 64 + i0 + e] * sigmoid_f(og[e]);
        uint2 o; o.x = pack2(y[0], y[1]); o.y = pack2(y[2], y[3]);
        *(uint2*)&Y[(size_t)tok * 1024 + 768 + h * 64 + i0] = o;
      }
  }
}

DI void attn_item(const Params& p, int b, int h, int q0, int key0, int nkt, int tok0, char* smem) {
  const int tid = opaque_tid(), lane = tid & 63, w = tid >> 6, l31 = lane & 31, hh = lane >> 5;
  bf16* Ks = (bf16*)smem;
  bf16* Vs = Ks + 64 * 104;
  bf16* Qs = Vs + 64 * 72;
  const bf16* Q = (const bf16*)((const char*)p.out + OOFF_Q);
  const bf16* KN = (const bf16*)(p.ws + OFF_KN);
  const bf16* VT = (const bf16*)(p.ws + OFF_VT);
  const bf16* KR = (const bf16*)(p.ws + OFF_KR);
  bf16* Y = (bf16*)(p.ws + OFF_Y);
  const int bh = b * 8 + h;
  __syncthreads();
  {
    const bf16* qsrc = Q + ((size_t)bh * KTOT + q0) * 96;
#pragma unroll 4
    for (int i = 0; i < 12; ++i) {
      const int id = tid + 256 * i, row = id / 12, c = id - row * 12;
      *(u32x4*)&Qs[row * 104 + c * 8] = *(const u32x4*)(qsrc + (size_t)row * 96 + c * 8);
    }
  }
  f32x16 o[2][2];
#pragma unroll
  for (int qb = 0; qb < 2; ++qb) { o[qb][0] = fzero(); o[qb][1] = fzero(); }
  float mrun[2] = {-INFINITY, -INFINITY}, lrun[2] = {0.f, 0.f};
  u32x4 pkA[2], pvA[2], prA, pkB[2], pvB[2], prB;
  const bf16* knp[2]; const bf16* vtp[2];
#pragma unroll
  for (int i = 0; i < 2; ++i) {
    int id = tid + 256 * i, row = id >> 3, ch = id & 7;
    knp[i] = KN + ((size_t)bh * KTOT + key0 + row) * 64 + ch * 8;
    vtp[i] = VT + ((size_t)bh * 64 + row) * KTOT + key0 + ch * 8;
  }
  const bf16* krp = KR + ((size_t)b * KTOT + key0 + (tid >> 2)) * 32 + (tid & 3) * 8;
#pragma unroll
  for (int i = 0; i < 2; ++i) { pkA[i] = *(const u32x4*)knp[i]; pvA[i] = *(const u32x4*)vtp[i]; }
  prA = *(const u32x4*)krp;
#pragma unroll
  for (int i = 0; i < 2; ++i) { pkB[i] = *(const u32x4*)(knp[i] + 64 * 64); pvB[i] = *(const u32x4*)(vtp[i] + 64); }
  prB = *(const u32x4*)(krp + 64 * 32);
  auto tstep = [&](u32x4 (&pk)[2], u32x4 (&pv)[2], u32x4& pr, int knext) {
    __syncthreads();
#pragma unroll
    for (int i = 0; i < 2; ++i) {
      int id = tid + 256 * i, row = id >> 3, ch = id & 7;
      *(u32x4*)&Ks[row * 104 + ch * 8] = pk[i];
      *(u32x4*)&Vs[row * 72 + ch * 8] = pv[i];
    }
    *(u32x4*)&Ks[(tid >> 2) * 104 + 64 + (tid & 3) * 8] = pr;
    __syncthreads();
    if (knext < nkt) {
#pragma unroll
      for (int i = 0; i < 2; ++i) {
        pk[i] = *(const u32x4*)(knp[i] + (size_t)knext * 64 * 64);
        pv[i] = *(const u32x4*)(vtp[i] + knext * 64);
      }
      pr = *(const u32x4*)(krp + (size_t)knext * 64 * 32);
    }
#pragma unroll
    for (int qb = 0; qb < 2; ++qb) {
      bf16x8 qf[6];
#pragma unroll
      for (int ks = 0; ks < 6; ++ks) qf[ks] = *(const bf16x8*)&Qs[(w * 64 + qb * 32 + l31) * 104 + ks * 16 + hh * 8];
      const float mref0 = mrun[qb] == -INFINITY ? 0.f : mrun[qb];
      f32x16 s[2];
#pragma unroll
      for (int r = 0; r < 16; ++r) { s[0][r] = -mref0; s[1][r] = -mref0; }
#pragma unroll
      for (int kb = 0; kb < 2; ++kb)
#pragma unroll
        for (int ks = 0; ks < 6; ++ks) {
          bf16x8 a = *(const bf16x8*)&Ks[(kb * 32 + l31) * 104 + ks * 16 + hh * 8];
          s[kb] = mfma(a, qf[ks], s[kb]);
        }
      float mx = fmaxf(s[0][0], s[1][0]);
#pragma unroll
      for (int r = 1; r < 16; ++r) mx = fmaxf(fmaxf(mx, s[0][r]), s[1][r]);
      mx = fmaxf(mx, shx(mx, 32));
      if (__builtin_amdgcn_ballot_w64(mrun[qb] == -INFINITY || mx > 8.f) != 0ull) {
        const float d = fmaxf(mx, 0.f);
        const float mnew = (mrun[qb] == -INFINITY) ? mx : mref0 + d;
        const float shift = mnew - mref0;
        const float alpha = (mrun[qb] == -INFINITY) ? 0.f : __builtin_amdgcn_exp2f(-shift);
        mrun[qb] = mnew;
        lrun[qb] *= alpha;
#pragma unroll
        for (int db = 0; db < 2; ++db)
#pragma unroll
          for (int r = 0; r < 16; ++r) o[qb][db][r] *= alpha;
#pragma unroll
        for (int kb = 0; kb < 2; ++kb)
#pragma unroll
          for (int r = 0; r < 16; ++r) s[kb][r] -= shift;
      }
      float rs = 0.f;
#pragma unroll
      for (int kb = 0; kb < 2; ++kb)
#pragma unroll
        for (int r = 0; r < 16; ++r) { float e = __builtin_amdgcn_exp2f(s[kb][r]); s[kb][r] = e; rs += e; }
      lrun[qb] += rs;
#pragma unroll
      for (int slab = 0; slab < 4; ++slab) {
        const int kb = slab >> 1, s2 = slab & 1;
        uint4 pu;
        pu.x = pack2(s[kb][8 * s2 + 0], s[kb][8 * s2 + 1]);
        pu.y = pack2(s[kb][8 * s2 + 2], s[kb][8 * s2 + 3]);
        pu.z = pack2(s[kb][8 * s2 + 4], s[kb][8 * s2 + 5]);
        pu.w = pack2(s[kb][8 * s2 + 6], s[kb][8 * s2 + 7]);
        bf16x8 pf = __builtin_bit_cast(bf16x8, pu);
#pragma unroll
        for (int db = 0; db < 2; ++db) {
          uint2 lo = *(const uint2*)&Vs[(db * 32 + l31) * 72 + slab * 16 + 4 * hh];
          uint2 hi = *(const uint2*)&Vs[(db * 32 + l31) * 72 + slab * 16 + 8 + 4 * hh];
          uint4 au; au.x = lo.x; au.y = lo.y; au.z = hi.x; au.w = hi.y;
          o[qb][db] = mfma(__builtin_bit_cast(bf16x8, au), pf, o[qb][db]);
        }
      }
    }
  };
  for (int kt = 0; kt < nkt; kt += 2) {
    tstep(pkA, pvA, prA, kt + 2);
    tstep(pkB, pvB, prB, kt + 3);
  }
#pragma unroll
  for (int qb = 0; qb < 2; ++qb) {
    const float lsum = lrun[qb] + shx(lrun[qb], 32);
    const float inv = 1.f / lsum;
    const int tok = tok0 + w * 64 + qb * 32 + l31;
#pragma unroll
    for (int db = 0; db < 2; ++db)
#pragma unroll
      for (int rg = 0; rg < 4; ++rg) {
        int dv = db * 32 + 8 * rg + 4 * hh;
        uint2 ou;
        ou.x = pack2(o[qb][db][4 * rg] * inv, o[qb][db][4 * rg + 1] * inv);
        ou.y = pack2(o[qb][db][4 * rg + 2] * inv, o[qb][db][4 * rg + 3] * inv);
        *(uint2*)&Y[(size_t)tok * 1024 + 256 + h * 64 + dv] = ou;
      }
  }
}

DI void outproj_tile(const Params& p, int l, int tm, int tn, char* smem, float* R, const float* XL, const float* XC) {
  const int tid = opaque_tid(), lane = tid & 63, w = tid >> 6, wm = w >> 1, wn = w & 1, l31 = lane & 31, hh = lane >> 5;
  const bf16* A = (const bf16*)(p.ws + OFF_Y);
  const bf16* Bt = (const bf16*)(p.ws + OFF_WOUT + l * SZ_WOUT1);
  const bf16* ap[4]; const bf16* bp[4];
#pragma unroll
  for (int j = 0; j < 4; ++j) {
    int r = 32 * (tid >> 6) + 8 * j + ((tid & 63) >> 3);
    ap[j] = A + (size_t)(tm * 128 + r) * 1024;
    bp[j] = Bt + (size_t)(tn * 128 + r) * 1024;
  }
  f32x16 acc[2][2];
  gemm_core<false>(ap, bp, 1024, smem, 0.f, acc);
  const int tok0 = tm * 128;
  const float* xres = (tok0 < NTL ? (XL + (size_t)tok0 * 1024) : (XC + (size_t)(tok0 - NTL) * 1024)) + tn * 128;
  float* Rt = R + (size_t)tok0 * 1024 + tn * 128;
  const float* g1 = (const float*)(p.ws + OFF_ADA) + (size_t)(l * 9 + ada_row(tok0)) * 6144 + 2 * 1024 + tn * 128;
  float* T = (float*)smem;
#pragma unroll
  for (int half = 0; half < 2; ++half) {
    __syncthreads();
    if (wm == half) {
#pragma unroll
      for (int i = 0; i < 2; ++i)
#pragma unroll
        for (int j = 0; j < 2; ++j)
#pragma unroll
          for (int r = 0; r < 16; ++r) T[(i * 32 + crow(r, hh)) * 132 + wn * 64 + j * 32 + l31] = acc[i][j][r];
    }
    __syncthreads();
#pragma unroll 2
    for (int i = 0; i < 8; ++i) {
      const int id = tid + 256 * i, row = id >> 5, c4 = (id & 31) * 4;
      const float4 a = *(const float4*)(T + row * 132 + c4);
      const float4 g = *(const float4*)(g1 + c4);
      const float4 x = *(const float4*)(xres + (size_t)(half * 64 + row) * 1024 + c4);
      float4 o;
      o.x = ALPHA * x.x + g.x * a.x; o.y = ALPHA * x.y + g.y * a.y; o.z = ALPHA * x.z + g.z * a.z; o.w = ALPHA * x.w + g.w * a.w;
      *(float4*)(Rt + (size_t)(half * 64 + row) * 1024 + c4) = o;
    }
  }
}

DI void ln1_router_item(const Params& p, int l, int it, char* smem, float* R, const float (&wr)[16][4]) {
  const int tid = opaque_tid(), lane = tid & 63, w = tid >> 6;
  float* hrow = (float*)smem;
  float* lg = hrow + 4 * 1024;
  const int tok = it * 4 + w;
  const float* ada = (const float*)(p.ws + OFF_ADA) + (size_t)(l * 9 + ada_row(tok)) * 6144;
  float v[16];
  float* row = R + (size_t)tok * 1024;
  row_load(row, v);
  row_norm(v);
  row_affine<0>(v, p.in[I_LN1G] + l * 1024, p.in[I_LN1B] + l * 1024);
  {
    float t[16];
#pragma unroll
    for (int i = 0; i < 16; ++i) t[i] = ALPHA * v[i];
    row_store(row, t);
  }
  row_norm(v);
  row_affine<1>(v, ada + 4 * 1024, ada + 3 * 1024);
  row_store_bf((bf16*)(p.ws + OFF_Y) + (size_t)tok * 1024, v);
  if (lane == 0) ((int*)(p.ws + OFF_TOKCNT))[tok] = 0;
  __syncthreads();
  row_store(hrow + w * 1024, v);
  __syncthreads();
  float part[4][4];
#pragma unroll
  for (int r = 0; r < 4; ++r) {
    float hv[16];
    row_load(hrow + r * 1024, hv);
#pragma unroll
    for (int e = 0; e < 4; ++e) {
      float s = 0.f;
#pragma unroll
      for (int i = 0; i < 16; ++i) s += hv[i] * wr[i][e];
      part[r][e] = s;
    }
  }
#pragma unroll
  for (int r = 0; r < 4; ++r)
#pragma unroll
    for (int e = 0; e < 4; ++e) {
      float s = wave_sum(part[r][e]);
      if (lane == 0) lg[r * 16 + w * 4 + e] = s;
    }
  __syncthreads();
  if (tid < 64) {
    int r = tid >> 4, e = tid & 15;
    float mx = -INFINITY;
#pragma unroll
    for (int i = 0; i < 16; ++i) mx = fmaxf(mx, lg[r * 16 + i]);
    float sum = 0.f;
#pragma unroll
    for (int i = 0; i < 16; ++i) sum += __expf(lg[r * 16 + i] - mx);
    float a = __expf(lg[r * 16 + e] - mx) / sum;
    int tk = it * 4 + r;
    if (tk < NTL) ((float*)(p.ws + OFF_AFFL))[((size_t)((tk >> 12) * 16 + e)) * 4096 + (tk & 4095)] = a;
    else { int tc = tk - NTL; ((float*)(p.ws + OFF_AFFC))[((size_t)((tc >> 8) * 16 + e)) * 256 + (tc & 255)] = a; }
  }
}

template <int NV>
DI void topk_item(const Params& p, int be, bool is_ctx, int me, char* smem) {
  const int tid = opaque_tid(), lane = tid & 63, w = tid >> 6;
  constexpr int N = NV * 256;
  constexpr int KSEL = N / 8;
  unsigned* hist = (unsigned*)smem;
  unsigned* ctl = hist + 256;
  unsigned* wtot = ctl + 4;
  const float* src = (const float*)(p.ws + (is_ctx ? OFF_AFFC : OFF_AFFL)) + (size_t)be * N + tid * NV;
  float v[NV]; unsigned u[NV];
  if (NV == 16) {
#pragma unroll
    for (int i = 0; i < NV / 4; ++i) { float4 t = ((const float4*)src)[i]; v[4 * i] = t.x; v[4 * i + 1] = t.y; v[4 * i + 2] = t.z; v[4 * i + 3] = t.w; }
  } else {
#pragma unroll
    for (int i = 0; i < NV; ++i) v[i] = src[i];
  }
#pragma unroll
  for (int i = 0; i < NV; ++i) u[i] = __float_as_uint(v[i]);
  unsigned prefix = 0, mask = 0, remaining = KSEL;
  for (int pass = 0; pass < 4; ++pass) {
    const int shift = 24 - 8 * pass;
    __syncthreads();
    hist[tid] = 0;
    __syncthreads();
#pragma unroll
    for (int i = 0; i < NV; ++i)
      if ((u[i] & mask) == prefix) atomicAdd(&hist[(u[i] >> shift) & 255], 1u);
    __syncthreads();
    if (w == 0) {
      const unsigned h0 = hist[255 - 4 * lane], h1 = hist[254 - 4 * lane], h2 = hist[253 - 4 * lane], h3 = hist[252 - 4 * lane];
      const unsigned s4 = h0 + h1 + h2 + h3;
      const unsigned inc = wave_scan_add_u(s4);
      const unsigned exc = inc - s4;
      if ((exc < remaining && inc >= remaining) || (lane == 63 && inc < remaining)) {
        unsigned cum = exc; int d = 255 - 4 * lane;
        if (cum + h0 < remaining) { cum += h0; --d; if (cum + h1 < remaining) { cum += h1; --d; if (cum + h2 < remaining) { cum += h2; --d; } } }
        ctl[0] = prefix | ((unsigned)d << shift);
        ctl[1] = remaining - cum;
      }
    }
    __syncthreads();
    prefix = ctl[0]; remaining = ctl[1];
    mask |= 255u << shift;
  }
  const unsigned thresh = prefix;
  unsigned cgt = 0, ceq = 0;
#pragma unroll
  for (int i = 0; i < NV; ++i) { cgt += (u[i] > thresh); ceq += (u[i] == thresh); }
  unsigned sg = wave_scan_add_u(cgt), se = wave_scan_add_u(ceq);
  __syncthreads();
  if (lane == 63) { wtot[w] = sg; wtot[4 + w] = se; }
  __syncthreads();
  unsigned og = 0, oe = 0, totg = 0;
#pragma unroll
  for (int i = 0; i < 4; ++i) { if (i < w) { og += wtot[i]; oe += wtot[4 + i]; } totg += wtot[i]; }
  unsigned pg = og + sg - cgt, pe = oe + se - ceq;
  const int b = be >> 4, e = be & 15;
  int* rowtok = (int*)(p.ws + OFF_ROWTOK) + (size_t)e * MEMAX + (is_ctx ? 4096 + b * 32 : b * 512);
  float* rowgate = (float*)(p.ws + OFF_ROWGATE) + (size_t)e * MEMAX + (is_ctx ? 4096 + b * 32 : b * 512);
  const int tokbase = is_ctx ? NTL + b * 256 : b * 4096;
#pragma unroll
  for (int i = 0; i < NV; ++i) {
    int slot = -1;
    if (u[i] > thresh) slot = (int)pg++;
    else if (u[i] == thresh) { if (pe < remaining) slot = (int)(totg + pe); pe++; }
    if (slot >= 0 && slot < KSEL) {
      const int tk = tokbase + tid * NV + i;
      rowtok[slot] = tk; rowgate[slot] = v[i];
      const int c = atomicAdd((int*)(p.ws + OFF_TOKCNT) + tk, 1);
      ((int*)(p.ws + OFF_TOKLIST))[tk * 16 + c] = e * 4096 * 0 + (is_ctx ? -(e * 256 + b * 32 + slot) - 1 : e * 4096 + b * 512 + slot);
    }
  }
}

DI void moe1_tile(const Params& p, int e, int tm, int tn, char* smem) {
  const int tid = opaque_tid(), lane = tid & 63, w = tid >> 6, wm = w >> 1, wn = w & 1, l31 = lane & 31, hh = lane >> 5;
  const bf16* XM = (const bf16*)(p.ws + OFF_Y);
  const bf16* Bt = (const bf16*)(p.ws + OFF_WGU) + (size_t)e * 2048 * 1024;
  const int* rowtok = (const int*)(p.ws + OFF_ROWTOK) + (size_t)e * MEMAX;
  const bf16* ap[4]; const bf16* bp[4];
#pragma unroll
  for (int j = 0; j < 4; ++j) {
    int r = 32 * (tid >> 6) + 8 * j + ((tid & 63) >> 3);
    ap[j] = XM + (size_t)rowtok[tm * 128 + r] * 1024;
    bp[j] = Bt + (size_t)(tn * 128 + r) * 1024;
  }
  f32x16 acc[2][2];
  gemm_core<false>(ap, bp, 1024, smem, 0.f, acc);
  bf16* T = (bf16*)smem;
  __syncthreads();
  {
    const int toff = (wm * 64 + 4 * hh) * 72 + wn * 32 + l31;
#pragma unroll
    for (int i = 0; i < 2; ++i)
#pragma unroll
      for (int r = 0; r < 16; ++r) {
        const int mo = i * 32 + 8 * (r >> 2) + (r & 3);
        float g = acc[i][0][r], u = acc[i][1][r];
        T[toff + mo * 72] = f2bf(silu_f(g) * u);
      }
  }
  __syncthreads();
  {
    bf16* hid = (bf16*)(p.ws + OFF_Z) + ((size_t)e * MEMAX + tm * 128) * 1024 + 64 * tn;
#pragma unroll
    for (int i = 0; i < 4; ++i) {
      const int id = tid + 256 * i, row = id >> 3, c = id & 7;
      *(u32x4*)(hid + (size_t)row * 1024 + c * 8) = *(const u32x4*)(T + row * 72 + c * 8);
    }
  }
}

DI void moe2_tile(const Params& p, int l, int e, int tm, int tn, char* smem, bf16* YEL, bf16* YEC) {
  const int tid = opaque_tid(), lane = tid & 63, w = tid >> 6, wm = w >> 1, wn = w & 1, l31 = lane & 31, hh = lane >> 5;
  const bf16* A = (const bf16*)(p.ws + OFF_Z) + (size_t)e * MEMAX * 1024;
  const bf16* Bt = (const bf16*)(p.ws + OFF_WD) + (size_t)e * 1024 * 1024;
  const int* rowtok = (const int*)(p.ws + OFF_ROWTOK) + (size_t)e * MEMAX;
  const float* rowgate = (const float*)(p.ws + OFF_ROWGATE) + (size_t)e * MEMAX;
  const bf16* ap[4]; const bf16* bp[4];
#pragma unroll
  for (int j = 0; j < 4; ++j) {
    int r = 32 * (tid >> 6) + 8 * j + ((tid & 63) >> 3);
    ap[j] = A + (size_t)(tm * 128 + r) * 1024;
    bp[j] = Bt + (size_t)(tn * 128 + r) * 1024;
  }
  f32x16 acc[2][2];
  gemm_core<false>(ap, bp, 1024, smem, 0.f, acc);
  const int arow = tm * 128 < 4096 ? (tm * 128) >> 9 : 8;
  const float* g2 = (const float*)(p.ws + OFF_ADA) + (size_t)(l * 9 + arow) * 6144 + 5 * 1024 + tn * 128 + wn * 64 + l31;
  const float g2v0 = g2[0], g2v1 = g2[32];
  bf16* T = (bf16*)smem;
  float* gs = (float*)(smem + GEMM_LDS);
  if (tid < 128) gs[tid] = rowgate[tm * 128 + tid];
  __syncthreads();
#pragma unroll
  for (int i = 0; i < 2; ++i)
#pragma unroll
    for (int r = 0; r < 16; ++r) {
      const int ml = wm * 64 + i * 32 + crow(r, hh);
      const float gt = gs[ml];
      T[ml * 136 + wn * 64 + l31] = f2bf(g2v0 * gt * acc[i][0][r]);
      T[ml * 136 + wn * 64 + 32 + l31] = f2bf(g2v1 * gt * acc[i][1][r]);
    }
  __syncthreads();
  {
    const int m0 = tm * 128;
    bf16* dst = (m0 < 4096 ? YEL + ((size_t)e * 4096 + m0) * 1024 : YEC + ((size_t)e * 256 + (m0 - 4096)) * 1024) + tn * 128;
#pragma unroll
    for (int i = 0; i < 8; ++i) {
      const int id = tid + 256 * i, row = id >> 4, c = id & 15;
      *(u32x4*)(dst + (size_t)row * 1024 + c * 8) = *(const u32x4*)(T + row * 136 + c * 8);
    }
  }
}

#define XB_TMO      128
#define XB_XCNT(j)  (256  + 64 * (j))
#define XB_XSUB(j)  (1280 + 64 * (j))
#define XB_XGEN(j)  (2304 + 64 * (j))
#define XB_TOP      3328
#define XB_TOPGEN   3392
#define XCD_BAR_WORDS 3456
#define XB_SPIN_CAP (1u << 22)
#define LAS __attribute__((address_space(3)))
DI unsigned xb_ld(unsigned* p) { return __hip_atomic_load(p, __ATOMIC_RELAXED, __HIP_MEMORY_SCOPE_AGENT); }
DI unsigned xb_add(unsigned* p, unsigned v) { return __hip_atomic_fetch_add(p, v, __ATOMIC_RELAXED, __HIP_MEMORY_SCOPE_AGENT); }
DI unsigned xb_xcc_id() { return (unsigned)__builtin_amdgcn_s_getreg((3 << 11) | 20) & 0xFu; }
#define XB_SPIN(cond, bar) do { unsigned _sp = 0; while (cond) { __builtin_amdgcn_s_sleep(1); \
    if ((++_sp & 255u) == 0u) { if (xb_ld(&(bar)[XB_TMO])) break; if (_sp > XB_SPIN_CAP) { atomicAdd(&(bar)[XB_TMO], 1u); break; } } } } while (0)
struct XcdBarrier { unsigned* bar; unsigned x; volatile LAS unsigned* st; };
DI XcdBarrier xcd_barrier_post(unsigned* bar, volatile LAS unsigned* st) {
  XcdBarrier b; b.bar = bar; b.x = (unsigned)__builtin_amdgcn_readfirstlane((int)xb_xcc_id()); b.st = st;
  if (threadIdx.x == 0) (void)xb_add(&bar[XB_XCNT(b.x)], 1u);
  return b;
}
DI void xcd_barrier_complete(unsigned* bar, unsigned x, unsigned& nloc, unsigned& nx) {
  const unsigned G = gridDim.x * gridDim.y * gridDim.z;
  unsigned sum, cnt, mine, sp = 0u;
  for (;;) {
    sum = 0u; cnt = 0u; mine = 0u;
#pragma unroll
    for (unsigned j = 0; j < 16; ++j) { const unsigned c = xb_ld(&bar[XB_XCNT(j)]); sum += c; cnt += (c > 0u) ? 1u : 0u; mine = (j == x) ? c : mine; }
    if (sum == G) break;
    __builtin_amdgcn_s_sleep(1);
    if ((++sp & 255u) == 0u) { if (xb_ld(&bar[XB_TMO])) break; if (sp > XB_SPIN_CAP) { atomicAdd(&bar[XB_TMO], 1u); break; } }
  }
  nloc = mine > 0u ? mine : 1u; nx = cnt > 0u ? cnt : 1u;
}
DI void xcd_barrier(const XcdBarrier& b) {
  asm volatile("s_waitcnt vmcnt(0)" ::: "memory");
  __syncthreads();
  if (threadIdx.x == 0) {
    unsigned* bar = b.bar;
    unsigned bx = b.x;
    asm volatile("" : "+s"(bx), "+s"(bar));
    __builtin_amdgcn_s_waitcnt(0);
    unsigned nloc = b.st[0], nx = b.st[1];
    if (nloc == 0u) { xcd_barrier_complete(bar, bx, nloc, nx); b.st[0] = nloc; b.st[1] = nx; }
    const unsigned old = xb_add(&bar[XB_XSUB(bx)], 1u);
    const unsigned gen = old / nloc;
    if (old + 1u == (gen + 1u) * nloc) {
      __builtin_amdgcn_fence(__ATOMIC_RELEASE, "agent");
      asm volatile("s_waitcnt vmcnt(0)" ::: "memory");
      const unsigned og = xb_add(&bar[XB_TOP], 1u);
      const unsigned tg = og / nx;
      if (og + 1u == (tg + 1u) * nx) xb_add(&bar[XB_TOPGEN], 1u);
      else XB_SPIN(xb_ld(&bar[XB_TOPGEN]) == tg, bar);
      __builtin_amdgcn_fence(__ATOMIC_ACQUIRE, "agent");
      xb_add(&bar[XB_XGEN(bx)], 1u);
      asm volatile("s_waitcnt vmcnt(0)" ::: "memory");
    } else {
      XB_SPIN(xb_ld(&bar[XB_XGEN(bx)]) == gen, bar);
      __builtin_amdgcn_fence(__ATOMIC_ACQUIRE, "agent");
      asm volatile("s_waitcnt vmcnt(0)" ::: "memory");
    }
  }
  __syncthreads();
}

__global__ void __launch_bounds__(NTHR, 2) hybrid_mega(Params p_in) {
  Params p = p_in;
  cg::grid_group grid = cg::this_grid();
  extern __shared__ __attribute__((aligned(16))) char smem[];
  const int tid = opaque_tid(), lane = tid & 63, w = tid >> 6;
  const int G = gridDim.x, bid = blockIdx.x;
  int nlb = G >> 3, vx = bid & 7, lb = (bid < 8 * nlb) ? (bid >> 3) : (1 << 28);
  __shared__ uint4 xb_words;
  __shared__ int xmap[2];
  if (tid == 0) xb_words = make_uint4(0u, 0u, 0u, 0u);
  __syncthreads();
  XcdBarrier xb = xcd_barrier_post((unsigned*)(p.ws + OFF_BAR), (volatile LAS unsigned*)&xb_words);
  if (p.ws == nullptr) grid.sync();
  if (tid == 0) xmap[0] = (int)xb_add((unsigned*)(p.ws + OFF_BAR) + 8 * xb.x, 1u);
  float* X2 = (float*)(p.ws + OFF_X2);
  bf16* XM = (bf16*)(p.ws + OFF_Y);
  const float* ADA = (const float*)(p.ws + OFF_ADA);

  PH(0) {
    const int n_ada = 384, n_w = 2 * NW_TILES, n_e = NE_TILES;
    const int total = n_ada + 1 + n_w + n_e;
    for (int it = bid; it < total; it += G) {
      if (it < n_ada) ada_item(p, it, (float*)smem);
      else if (it == n_ada) {
        for (int i = opaque_tid(); i < 512; i += NTHR) {
          int ap2 = i >> 3, j = i & 7;
          float inv = powf(10000.f, -(float)j * 2.0f / 16.0f);
          float ang = (float)ap2 * inv;
          ((float2*)(p.ws + OFF_ROPE))[i] = make_float2(cosf(ang), sinf(ang));
        }
      } else if (it < n_ada + 1 + n_w) {
        int k = it - n_ada - 1;
        convert_weight_item(p, k / NW_TILES, k % NW_TILES, (float*)smem);
      } else convert_expert_item(p, 0, it - n_ada - 1 - n_w, (float*)smem);
    }
  }
  xcd_barrier(xb);
  {
    if (tid == 0) {
      unsigned* bar = (unsigned*)(p.ws + OFF_BAR);
      int ok = (G & 7) == 0;
      for (int j = 0; j < 16; ++j) { unsigned c = xb_ld(&bar[XB_XCNT(j)]); if (c != (j < 8 ? (unsigned)(G >> 3) : 0u)) ok = 0; }
      xmap[1] = ok;
    }
    __syncthreads();
    if (__builtin_amdgcn_readfirstlane(xmap[1])) { vx = (int)xb.x; lb = __builtin_amdgcn_readfirstlane(xmap[0]); }
  }
  PH(1) for (int it = bid; it < NT / 4; it += G) {
    const int w = opaque_tid() >> 6;
    int tok = it * 4 + w;
    const float* row = tok < NTL ? p.in[I_X] + (size_t)tok * 1024 : p.in[I_CTX] + (size_t)(tok - NTL) * 1024;
    const float* ada = ADA + (size_t)ada_row(tok) * 6144;
    float v[16];
    row_load(row, v);
    row_norm(v);
    row_affine<1>(v, ada + 1024, ada);
    row_store_bf(XM + (size_t)tok * 1024, v);
  }
  xcd_barrier(xb);

  for (int l = 0; l < 2; ++l) {
    const bool upd = (l == 0);
    const int mt_q = upd ? 272 : 256;
    float* R = upd ? X2 : p.out;
    bf16* YEL = upd ? (bf16*)p.out : (bf16*)(p.ws + OFF_X2);
    bf16* YEC = (bf16*)(p.ws + OFF_KN);
    PH(2) for (int li = lb; li < 68 * 9; li += nlb) {
      int mi = li / 9, ntl = li - mi * 9;
      inproj_tile(p, l, (vx & 3) + 4 * mi, (vx >> 2) * 9 + ntl, smem);
    }
    xcd_barrier(xb);
    PH(3) {
      const int n_ml1 = 32 * 68, n_g = mt_q, n_kr = 272;
      if (P3MASK & 1) for (int li = lb; li < (mt_q / 8) * 6; li += nlb) { int mi = li / 6; uq_tile(p, l, vx + 8 * mi, li - mi * 6, smem); }
      if (P3MASK & 2) for (int li = lb; li < 34 * 8; li += nlb) ukv_tile(p, l, vx + 8 * (li >> 3), li & 7, smem);
      const int total = n_ml1 + n_g + n_kr;
      for (int it = bid; it < total; it += G) {
        int k = it;
        if (k < n_ml1) { int c = k % 68, bh = k / 68; if (P3MASK & 4) ml1_item(p, l, bh >> 2, bh & 3, c, smem); continue; }
        k -= n_ml1;
        if (k < n_g) { if (P3MASK & 8) gmlp_item(p, l, k, smem); continue; }
        k -= n_g;
        if (P3MASK & 16) krope_item(p, k);
      }
    }
    xcd_barrier(xb);
    PH(4) {
      const int n_ml2 = 64 * 16, n_ac = upd ? 8 * 8 * 2 : 0;
      for (int it = bid; it < n_ml2; it += G) ml2_item(p, it, smem);
      for (int li = lb; li < 8 * 16; li += nlb) {
        int bh = vx + 8 * (li >> 4), qt = li & 15;
        int b = bh >> 3, h = bh & 7;
        attn_item(p, b, h, qt * 256, 0, 68, b * 4096 + qt * 256, smem);
      }
      if (upd) for (int k = bid; k < 64; k += G) {
        int b = k >> 3, h = k & 7;
        attn_item(p, b, h, 4096, 4096, 4, NTL + b * 256, smem);
      }
    }
    xcd_barrier(xb);
    PH(5) {
      const int ncl = 32 * 64, ncc = upd ? 32 * 4 : 0;
      for (int it = bid; it < ncl + ncc; it += G) {
        if (it < ncl) { int c = it & 63, bh = it >> 6; ml3_item(p, l, bh >> 2, bh & 3, c, smem); }
        else { int k = it - ncl; int c = 64 + (k & 3), bh = k >> 2; ml3_item(p, l, bh >> 2, bh & 3, c, smem); }
      }
    }
    xcd_barrier(xb);
    PH(6) {
      const float* XL = upd ? p.in[I_X] : X2;
      const float* XC = upd ? p.in[I_CTX] : (X2 + (size_t)NTL * 1024);
      for (int li = lb; li < (mt_q / 8) * 8; li += nlb) outproj_tile(p, l, vx + 8 * (li >> 3), li & 7, smem, R, XL, XC);
    }
    xcd_barrier(xb);
    PH(7) {
      float wr[16][4];
      {
        const int t2 = opaque_tid(); const int lane = t2 & 63, w = t2 >> 6;
        const float* W = p.in[I_WROUTER] + (size_t)l * 1024 * 16;
#pragma unroll
        for (int i = 0; i < 4; ++i)
#pragma unroll
          for (int c = 0; c < 4; ++c) {
            int k = 4 * lane + 256 * i + c;
            float4 t = *(const float4*)(W + (size_t)k * 16 + w * 4);
            wr[4 * i + c][0] = t.x; wr[4 * i + c][1] = t.y; wr[4 * i + c][2] = t.z; wr[4 * i + c][3] = t.w;
          }
      }
      const int nrows = upd ? NT : NTL;
      for (int it = bid; it < nrows / 4; it += G) ln1_router_item(p, l, it, smem, R, wr);
    }
    xcd_barrier(xb);
    PH(8) {
      const int me = upd ? 4352 : 4096;
      const int total = upd ? 256 : 128;
      for (int it = bid; it < total; it += G) {
        if (it < 128) topk_item<16>(p, it, false, me, smem);
        else topk_item<1>(p, it - 128, true, me, smem);
      }
    }
    xcd_barrier(xb);
    PH(9) {
      const int mtiles = upd ? 34 : 32;
      const int per_e = mtiles * 16, per_h = mtiles * 8;
      for (int li = lb; li < 2 * per_e; li += nlb) {
        int ei = li / per_e, rem = li - ei * per_e;
        int half = rem / per_h, rem2 = rem - half * per_h;
        moe1_tile(p, 2 * vx + ei, rem2 >> 3, half * 8 + (rem2 & 7), smem);
      }
    }
    xcd_barrier(xb);
    PH(10) {
      const int mtiles = upd ? 34 : 32;
      const int per_e = mtiles * 8;
      for (int li = lb; li < 2 * per_e; li += nlb) {
        int ei = li / per_e, rem = li - ei * per_e;
        moe2_tile(p, l, 2 * vx + ei, rem >> 3, rem & 7, smem, YEL, YEC);
      }
    }
    xcd_barrier(xb);
    PH(11) {
      const int nrows = upd ? NT : NTL;
      const int n_r = nrows / 4;
      const int total = n_r + (upd ? NE_TILES : 0);
      for (int it = bid; it < total; it += G) {
        if (it < n_r) {
          const int w = opaque_tid() >> 6;
          int tok = it * 4 + w;
          float v[16];
          float* row = R + (size_t)tok * 1024;
          row_load(row, v);
          {
            const int ln = opaque_tid() & 63;
            const int cnt = ((const int*)(p.ws + OFF_TOKCNT))[tok];
            const int* lst = (const int*)(p.ws + OFF_TOKLIST) + (size_t)tok * 16;
            for (int c = 0; c < cnt; ++c) {
              const int code = lst[c];
              const bf16* yr = code >= 0 ? YEL + (size_t)code * 1024 : YEC + (size_t)(-code - 1) * 1024;
#pragma unroll
              for (int i = 0; i < 4; ++i) {
                uint2 u = *(const uint2*)(yr + 4 * ln + 256 * i);
                v[4 * i] += bflo(u.x); v[4 * i + 1] += bfhi(u.x); v[4 * i + 2] += bflo(u.y); v[4 * i + 3] += bfhi(u.y);
              }
            }
          }
          row_norm(v);
          row_affine<0>(v, p.in[I_LN2G] + l * 1024, p.in[I_LN2B] + l * 1024);
          row_store(row, v);
          if (upd) {
            const float* ada = ADA + (size_t)(9 + ada_row(tok)) * 6144;
            row_norm(v);
            row_affine<1>(v, ada + 1024, ada);
            row_store_bf(XM + (size_t)tok * 1024, v);
          }
        } else convert_expert_item(p, 1, it - n_r, (float*)smem);
      }
    }
    if (l == 0) xcd_barrier(xb);
  }
}

extern "C" void kernel_launch(void* const* d_in, const int* in_sizes, int n_in, void* d_out, int out_size, void* d_ws, size_t ws_size,
                              hipStream_t stream) {
  static int grid_blocks = 0;
  if (!grid_blocks) {
    int dev = 0, cus = 0, per_cu = 0;
    hipGetDevice(&dev);
    hipDeviceGetAttribute(&cus, hipDeviceAttributeMultiprocessorCount, dev);
    hipFuncSetAttribute((const void*)hybrid_mega, hipFuncAttributeMaxDynamicSharedMemorySize, SMEM_BYTES);
    hipOccupancyMaxActiveBlocksPerMultiprocessor(&per_cu, hybrid_mega, NTHR, SMEM_BYTES);
    if (per_cu > 2) per_cu = 2;
    if (per_cu < 1) per_cu = 1;
    grid_blocks = cus * per_cu;
  }
  if (ws_size < WS_END) fprintf(stderr, "workspace too small: %zu < %zu\n", ws_size, (size_t)WS_END);
  hipMemsetAsync((char*)d_ws + OFF_BAR, 0, XCD_BAR_WORDS * 4, stream);
  Params p{};
  for (int i = 0; i < 29; ++i) p.in[i] = (const float*)d_in[i];
  p.out = (float*)d_out;
  p.ws = (char*)d_ws;
  void* args[] = {&p};
  hipError_t e = hipLaunchCooperativeKernel((void*)hybrid_mega, dim3(grid_blocks), dim3(NTHR), args, SMEM_BYTES, stream);
  if (e != hipSuccess) fprintf(stderr, "cooperative launch failed: %s (grid %d)\n", hipGetErrorString(e), grid_blocks);
}
```

```cpp
#include <hip/hip_runtime.h>
#include <hip/hip_cooperative_groups.h>
#include <cstdio>
namespace cg = cooperative_groups;

#define DI __device__ __forceinline__
#define MEMBAR() asm volatile("" ::: "memory")
DI int opaque_tid() { int t = threadIdx.x; asm volatile("" : "+v"(t)); return t; }
typedef unsigned u32x2_t __attribute__((ext_vector_type(2)));
DI float shx(float v, int m) {
  if (m == 1) return __int_as_float(__builtin_amdgcn_update_dpp(0, __float_as_int(v), 0xB1, 0xF, 0xF, false));
  if (m == 2) return __int_as_float(__builtin_amdgcn_update_dpp(0, __float_as_int(v), 0x4E, 0xF, 0xF, false));
  if (m == 8) return __int_as_float(__builtin_amdgcn_update_dpp(0, __float_as_int(v), 0x128, 0xF, 0xF, false));
  if (m == 16) return __int_as_float(__builtin_amdgcn_ds_swizzle(__float_as_int(v), 0x401F));
  if (m == 32) {
    const u32x2_t r = __builtin_amdgcn_permlane32_swap(__float_as_uint(v), __float_as_uint(v), false, false);
    return __uint_as_float(((opaque_tid() & 32) != 0) ? r[0] : r[1]);
  }
  const int l = opaque_tid() & 63;
  return __int_as_float(__builtin_amdgcn_ds_bpermute((l ^ m) << 2, __float_as_int(v)));
}
DI float shup(float v, int o) { const int l = opaque_tid() & 63; return __int_as_float(__builtin_amdgcn_ds_bpermute((l >= o ? l - o : l) << 2, __float_as_int(v))); }
DI unsigned shup(unsigned v, int o) { const int l = opaque_tid() & 63; return (unsigned)__builtin_amdgcn_ds_bpermute((l >= o ? l - o : l) << 2, (int)v); }
typedef unsigned short bf16;
typedef __attribute__((ext_vector_type(8))) short bf16x8;
typedef __attribute__((ext_vector_type(16))) float f32x16;
typedef __attribute__((ext_vector_type(2))) __bf16 bfv2;
typedef __attribute__((ext_vector_type(2))) float fv2;
typedef __attribute__((ext_vector_type(4))) unsigned u32x4;

constexpr int NTHR = 256;
constexpr int NB = 8, SEQ = 4096, CTX = 256;
constexpr int NTL = NB * SEQ, NTC = NB * CTX, NT = NTL + NTC;
constexpr int ZS = 2224;
constexpr int KTOT = SEQ + CTX;
constexpr int MEMAX = 4352;
constexpr float LN_EPS = 1e-6f;
constexpr float ALPHA = 1.41421356237f;
constexpr float QSCALE = 0.10206207261596577f * 1.4426950408889634f;

enum { I_X = 0, I_C, I_CTX, I_CCTX, I_WADA, I_BADA, I_WIN, I_BIN, I_SGLNG, I_SGLNB, I_SGW, I_SGB, I_QNG, I_KVNG, I_WUQ, I_WUKV,
       I_CONVW, I_CONVB, I_FBIAS, I_MLNG, I_WOUT, I_LN1G, I_LN1B, I_WROUTER, I_WGATE, I_WUP, I_WDOWN, I_LN2G, I_LN2B };

struct Params {
  const float* in[29];
  float* out;
  char* ws;
};

DI void launder_params(Params& q) {
  char* w = q.ws; float* o = q.out;
  asm volatile("" : "+s"(w), "+s"(o));
  q.ws = w; q.out = o;
}
constexpr size_t al(size_t x) { return (x + 255) & ~size_t(255); }
constexpr size_t OFF_ADA = 0;
constexpr size_t OFF_ROPE = al(OFF_ADA + 2ull * 9 * 6144 * 4);
constexpr size_t OFF_WIN = al(OFF_ROPE + 64 * 8 * 8);
constexpr size_t SZ_WIN1 = 2304ull * 1024 * 2;
constexpr size_t OFF_WUQ = al(OFF_WIN + 2 * SZ_WIN1);
constexpr size_t SZ_WUQ1 = 768ull * 384 * 2;
constexpr size_t OFF_WUKV = al(OFF_WUQ + 2 * SZ_WUQ1);
constexpr size_t SZ_WUKV1 = 1024ull * 256 * 2;
constexpr size_t OFF_WOUT = al(OFF_WUKV + 2 * SZ_WUKV1);
constexpr size_t SZ_WOUT1 = 1024ull * 1024 * 2;
constexpr size_t OFF_SGW = al(OFF_WOUT + 2 * SZ_WOUT1);
constexpr size_t SZ_SGW1 = 4ull * 128 * 128 * 2;
constexpr size_t OFF_WGU = al(OFF_SGW + 2 * SZ_SGW1);
constexpr size_t OFF_WD = al(OFF_WGU + 16ull * 2048 * 1024 * 2);
constexpr size_t OFF_X2 = al(OFF_WD + 16ull * 1024 * 1024 * 2);
constexpr size_t OFF_Z = al(OFF_X2 + (size_t)NT * 1024 * 4);
constexpr size_t OFF_KN = al(OFF_Z + (size_t)NT * ZS * 2);
constexpr size_t OFF_VT = al(OFF_KN + (size_t)NB * 8 * KTOT * 64 * 2);
constexpr size_t OFF_KR = al(OFF_VT + (size_t)NB * 8 * KTOT * 64 * 2);
constexpr size_t OFF_Y = al(OFF_KR + (size_t)NB * KTOT * 32 * 2);
constexpr size_t OFF_GATES = al(OFF_Y + (size_t)NT * 1024 * 2);
constexpr size_t OFF_AFFL = al(OFF_GATES + (size_t)NT * 16 * 4);
constexpr size_t OFF_AFFC = al(OFF_AFFL + 128ull * 4096 * 4);
constexpr size_t OFF_ROWTOK = al(OFF_AFFC + 128ull * 256 * 4);
constexpr size_t OFF_ROWGATE = al(OFF_ROWTOK + 16ull * MEMAX * 4);
constexpr size_t OFF_SM = al(OFF_ROWGATE + 16ull * MEMAX * 4);
constexpr size_t OFF_BAR = al(OFF_SM + 32ull * 2 * 68 * 4 * 4);
constexpr size_t OFF_TOKCNT = al(OFF_BAR + 3456 * 4);
constexpr size_t OFF_TOKLIST = al(OFF_TOKCNT + (size_t)NT * 4);
constexpr size_t WS_END = al(OFF_TOKLIST + (size_t)NT * 16 * 4);
constexpr size_t OOFF_SC = 0;
constexpr size_t OOFF_SN = OOFF_SC + 32ull * 2 * 68 * 4096 * 4;
constexpr size_t OOFF_Q = al(OOFF_SN + 32ull * 2 * 68 * 64 * 4);
static_assert(OOFF_Q + (size_t)NB * 8 * KTOT * 96 * 2 <= (size_t)NTL * 1024 * 4, "d_out scratch overflow");

constexpr int SMEM_BYTES = 75776;
#ifndef PHMASK
#define PHMASK 0xFFFF
#endif
#define PH(n) if (launder_params(p), ((PHMASK >> (n)) & 1))
#ifndef P3MASK
#define P3MASK 31
#endif

DI unsigned pack2(float a, float b) { fv2 f = {a, b}; bfv2 r = __builtin_convertvector(f, bfv2); return __builtin_bit_cast(unsigned, r); }
DI bf16 f2bf(float a) { return (bf16)(pack2(a, 0.f) & 0xffffu); }
DI float bf2f(bf16 h) { return __uint_as_float(((unsigned)h) << 16); }
DI float bflo(unsigned u) { return __uint_as_float(u << 16); }
DI float bfhi(unsigned u) { return __uint_as_float(u & 0xffff0000u); }
DI f32x16 mfma(bf16x8 a, bf16x8 b, f32x16 c) { return __builtin_amdgcn_mfma_f32_32x32x16_bf16(a, b, c, 0, 0, 0); }
DI f32x16 fzero() { f32x16 z; _Pragma("unroll") for (int i = 0; i < 16; ++i) z[i] = 0.f; return z; }
DI int crow(int r, int hh) { return (r & 3) + 8 * (r >> 2) + 4 * hh; }
#define DPP_F(v, ctrl) __int_as_float(__builtin_amdgcn_update_dpp(0, __float_as_int(v), (ctrl), 0xF, 0xF, false))
DI float wave_sum(float v) {
  v += DPP_F(v, 0xB1); v += DPP_F(v, 0x4E); v += DPP_F(v, 0x141); v += DPP_F(v, 0x140);
  v += __int_as_float(__builtin_amdgcn_ds_swizzle(__float_as_int(v), 0x401F));
  return __int_as_float(__builtin_amdgcn_readlane(__float_as_int(v), 0)) + __int_as_float(__builtin_amdgcn_readlane(__float_as_int(v), 32));
}
#define DPP_O(old, v, ctrl, rmask) __builtin_amdgcn_update_dpp((old), (v), (ctrl), (rmask), 0xF, false)
DI float wave_scan_add(float v) {
  v += __int_as_float(DPP_O(0, __float_as_int(v), 0x111, 0xF));
  v += __int_as_float(DPP_O(0, __float_as_int(v), 0x112, 0xF));
  v += __int_as_float(DPP_O(0, __float_as_int(v), 0x114, 0xF));
  v += __int_as_float(DPP_O(0, __float_as_int(v), 0x118, 0xF));
  v += __int_as_float(DPP_O(0, __float_as_int(v), 0x142, 0xA));
  v += __int_as_float(DPP_O(0, __float_as_int(v), 0x143, 0xC));
  return v;
}
DI unsigned wave_scan_add_u(unsigned v) {
  v += (unsigned)DPP_O(0, (int)v, 0x111, 0xF);
  v += (unsigned)DPP_O(0, (int)v, 0x112, 0xF);
  v += (unsigned)DPP_O(0, (int)v, 0x114, 0xF);
  v += (unsigned)DPP_O(0, (int)v, 0x118, 0xF);
  v += (unsigned)DPP_O(0, (int)v, 0x142, 0xA);
  v += (unsigned)DPP_O(0, (int)v, 0x143, 0xC);
  return v;
}
DI float wave_scan_max(float v) {
  const int ninf = (int)0xff800000u;
  v = fmaxf(v, __int_as_float(DPP_O(ninf, __float_as_int(v), 0x111, 0xF)));
  v = fmaxf(v, __int_as_float(DPP_O(ninf, __float_as_int(v), 0x112, 0xF)));
  v = fmaxf(v, __int_as_float(DPP_O(ninf, __float_as_int(v), 0x114, 0xF)));
  v = fmaxf(v, __int_as_float(DPP_O(ninf, __float_as_int(v), 0x118, 0xF)));
  v = fmaxf(v, __int_as_float(DPP_O(ninf, __float_as_int(v), 0x142, 0xA)));
  v = fmaxf(v, __int_as_float(DPP_O(ninf, __float_as_int(v), 0x143, 0xC)));
  return v;
}
DI float wave_max(float v) {
  v = fmaxf(v, DPP_F(v, 0xB1)); v = fmaxf(v, DPP_F(v, 0x4E)); v = fmaxf(v, DPP_F(v, 0x141)); v = fmaxf(v, DPP_F(v, 0x140));
  v = fmaxf(v, __int_as_float(__builtin_amdgcn_ds_swizzle(__float_as_int(v), 0x401F)));
  return fmaxf(__int_as_float(__builtin_amdgcn_readlane(__float_as_int(v), 0)), __int_as_float(__builtin_amdgcn_readlane(__float_as_int(v), 32)));
}
DI float silu_f(float a) { return a / (1.f + __expf(-a)); }
DI float sigmoid_f(float a) { return 1.f / (1.f + __expf(-a)); }
DI float gelu_tanh(float x) {
  float y = 0.7978845608028654f * (x + 0.044715f * x * x * x);
  float t = 1.f - 2.f / (__expf(2.f * y) + 1.f);
  return 0.5f * x * (1.f + t);
}
struct Params;
DI int ada_row(int tok) { return tok < NTL ? (tok >> 12) : 8; }

DI void tr_tile(const float* s0, const float* s1, int ld, int nv0, int nv1, const float* ksc, bf16* dst, int ldd, float* t) {
  const int tid = opaque_tid();
  const int n4 = (tid & 15) * 4, kq = tid >> 4;
  const float* s = (n4 < 32) ? (s0 + n4) : (s1 + (n4 - 32));
  const int nv = (n4 < 32) ? (nv0 - n4) : (nv1 - (n4 - 32));
  __syncthreads();
#pragma unroll
  for (int i = 0; i < 4; ++i) {
    const int k = i * 16 + kq;
    float4 v = make_float4(0.f, 0.f, 0.f, 0.f);
    if (nv >= 4) v = *(const float4*)(s + (size_t)k * ld);
    if (ksc) { const float sc = ksc[k]; v.x *= sc; v.y *= sc; v.z *= sc; v.w *= sc; }
    t[k * 65 + n4] = v.x; t[k * 65 + n4 + 1] = v.y; t[k * 65 + n4 + 2] = v.z; t[k * 65 + n4 + 3] = v.w;
  }
  __syncthreads();
  const int kp = tid & 31, nn = tid >> 5;
#pragma unroll
  for (int i = 0; i < 8; ++i) {
    int n2 = i * 8 + nn;
    float a = t[(2 * kp) * 65 + n2], b = t[(2 * kp + 1) * 65 + n2];
    *(unsigned*)&dst[(size_t)n2 * ldd + 2 * kp] = pack2(a, b);
  }
}

constexpr int NE_TILES = 8192 + 4096;
DI void convert_expert_item(const Params& p, int l, int it, float* sm) {
  if (it < 8192) {
    int e = it >> 9, rem = it & 511, q = rem >> 4, kt = rem & 15;
    const float* g = p.in[I_WGATE] + ((size_t)(l * 16 + e) * 1024 + kt * 64) * 1024 + q * 32;
    const float* u = p.in[I_WUP] + ((size_t)(l * 16 + e) * 1024 + kt * 64) * 1024 + q * 32;
    bf16* dst = (bf16*)(p.ws + OFF_WGU) + ((size_t)e * 2048 + q * 64) * 1024 + kt * 64;
    tr_tile(g, u, 1024, 32, 32, nullptr, dst, 1024, sm);
  } else {
    it -= 8192;
    int e = it >> 8, rem = it & 255, nt = rem >> 4, kt = rem & 15;
    const float* s = p.in[I_WDOWN] + ((size_t)(l * 16 + e) * 1024 + kt * 64) * 1024 + nt * 64;
    bf16* dst = (bf16*)(p.ws + OFF_WD) + ((size_t)e * 1024 + nt * 64) * 1024 + kt * 64;
    tr_tile(s, s + 32, 1024, 32, 32, nullptr, dst, 1024, sm);
  }
}

constexpr int NW_TILES = 576 + 72 + 64 + 256 + 64;
DI void convert_weight_item(const Params& p, int l, int it, float* sm) {
  if (it < 576) {
    int nt = it >> 4, kt = it & 15;
    int n0 = nt * 64;
    int nv0 = min(32, max(0, 2224 - n0)), nv1 = min(32, max(0, 2224 - n0 - 32));
    const float* s = p.in[I_WIN] + ((size_t)l * 1024 + kt * 64) * 2224 + n0;
    bf16* dst = (bf16*)(p.ws + OFF_WIN + l * SZ_WIN1) + (size_t)n0 * 1024 + kt * 64;
    tr_tile(s, s + 32, 2224, nv0, nv1, nullptr, dst, 1024, sm);
    return;
  }
  it -= 576;
  if (it < 72) {
    int nt = it / 6, kt = it % 6;
    const float* s = p.in[I_WUQ] + ((size_t)l * 384 + kt * 64) * 768 + nt * 64;
    bf16* dst = (bf16*)(p.ws + OFF_WUQ + l * SZ_WUQ1) + (size_t)nt * 64 * 384 + kt * 64;
    tr_tile(s, s + 32, 768, 32, 32, p.in[I_QNG] + l * 384 + kt * 64, dst, 384, sm);
    return;
  }
  it -= 72;
  if (it < 64) {
    int nt = it >> 2, kt = it & 3;
    const float* s = p.in[I_WUKV] + ((size_t)l * 256 + kt * 64) * 1024 + nt * 64;
    bf16* dst = (bf16*)(p.ws + OFF_WUKV + l * SZ_WUKV1) + (size_t)nt * 64 * 256 + kt * 64;
    tr_tile(s, s + 32, 1024, 32, 32, p.in[I_KVNG] + l * 256 + kt * 64, dst, 256, sm);
    return;
  }
  it -= 64;
  if (it < 256) {
    int nt = it >> 4, kt = it & 15;
    const float* s = p.in[I_WOUT] + ((size_t)l * 1024 + kt * 64) * 1024 + nt * 64;
    bf16* dst = (bf16*)(p.ws + OFF_WOUT + l * SZ_WOUT1) + (size_t)nt * 64 * 1024 + kt * 64;
    tr_tile(s, s + 32, 1024, 32, 32, nullptr, dst, 1024, sm);
    return;
  }
  it -= 256;
  {
    const int t4 = opaque_tid() * 4;
    const float* s = p.in[I_SGW] + (size_t)l * 65536 + it * 1024 + t4;
    float4 v = *(const float4*)s;
    uint2 o; o.x = pack2(v.x, v.y); o.y = pack2(v.z, v.w);
    *(uint2*)((bf16*)(p.ws + OFF_SGW + l * SZ_SGW1) + it * 1024 + t4) = o;
  }
}

DI void ada_item(const Params& p, int it, float* sm) {
  const int tid = opaque_tid();
  int l = it / 192, cb = it % 192;
  float* sc = sm;
  float* red = sm + 9 * 1024;
  __syncthreads();
  for (int i = tid; i < 9 * 1024; i += NTHR) {
    int r = i >> 10, k = i & 1023;
    float c = r < 8 ? p.in[I_C][r * 1024 + k] : p.in[I_CCTX][k];
    sc[i] = c / (1.f + expf(-c));
  }
  __syncthreads();
  int kg = tid >> 5, cl = tid & 31;
  const float* W = p.in[I_WADA] + (size_t)l * 1024 * 6144 + cb * 32 + cl;
  float acc[9];
#pragma unroll
  for (int r = 0; r < 9; ++r) acc[r] = 0.f;
#pragma unroll 8
  for (int k = kg * 128; k < kg * 128 + 128; ++k) {
    float w = W[(size_t)k * 6144];
#pragma unroll
    for (int r = 0; r < 9; ++r) acc[r] += sc[r * 1024 + k] * w;
  }
#pragma unroll
  for (int r = 0; r < 9; ++r) red[(kg * 9 + r) * 32 + cl] = acc[r];
  __syncthreads();
  float* ada = (float*)(p.ws + OFF_ADA);
  for (int i = tid; i < 288; i += NTHR) {
    int r = i >> 5, c2 = i & 31;
    float s = 0.f;
#pragma unroll
    for (int g = 0; g < 8; ++g) s += red[(g * 9 + r) * 32 + c2];
    ada[(size_t)(l * 9 + r) * 6144 + cb * 32 + c2] = s + p.in[I_BADA][l * 6144 + cb * 32 + c2];
  }
}

DI void row_load(const float* row, float v[16]) {
  const int lane = opaque_tid() & 63;
#pragma unroll
  for (int i = 0; i < 4; ++i) {
    float4 t = *(const float4*)(row + 4 * lane + 256 * i);
    v[4 * i] = t.x; v[4 * i + 1] = t.y; v[4 * i + 2] = t.z; v[4 * i + 3] = t.w;
  }
}
DI void row_store(float* row, const float v[16]) {
  const int lane = opaque_tid() & 63;
#pragma unroll
  for (int i = 0; i < 4; ++i) *(float4*)(row + 4 * lane + 256 * i) = make_float4(v[4 * i], v[4 * i + 1], v[4 * i + 2], v[4 * i + 3]);
}
DI void row_store_bf(bf16* row, const float v[16]) {
  const int lane = opaque_tid() & 63;
#pragma unroll
  for (int i = 0; i < 4; ++i) {
    uint2 o; o.x = pack2(v[4 * i], v[4 * i + 1]); o.y = pack2(v[4 * i + 2], v[4 * i + 3]);
    *(uint2*)(row + 4 * lane + 256 * i) = o;
  }
}
DI void row_norm(float v[16]) {
  float s = 0.f;
#pragma unroll
  for (int i = 0; i < 16; ++i) s += v[i];
  float mean = wave_sum(s) * (1.f / 1024.f);
  float q = 0.f;
#pragma unroll
  for (int i = 0; i < 16; ++i) { v[i] -= mean; q += v[i] * v[i]; }
  float rstd = rsqrtf(wave_sum(q) * (1.f / 1024.f) + LN_EPS);
#pragma unroll
  for (int i = 0; i < 16; ++i) v[i] *= rstd;
}
template <int ONE>
DI void row_affine(float v[16], const float* a, const float* b) {
  const int lane = opaque_tid() & 63;
#pragma unroll
  for (int i = 0; i < 4; ++i) {
    float4 fa = *(const float4*)(a + 4 * lane + 256 * i);
    float4 fb = *(const float4*)(b + 4 * lane + 256 * i);
    v[4 * i] = v[4 * i] * (fa.x + ONE) + fb.x;
    v[4 * i + 1] = v[4 * i + 1] * (fa.y + ONE) + fb.y;
    v[4 * i + 2] = v[4 * i + 2] * (fa.z + ONE) + fb.z;
    v[4 * i + 3] = v[4 * i + 3] * (fa.w + ONE) + fb.w;
  }
}

constexpr int GEMM_STAGE = 128 * 128;
constexpr int GEMM_LDS = 4 * GEMM_STAGE;
template <bool SSQ, int VAR = 0>
DI void gemm_core(const bf16* (&a_row)[4], const bf16* (&b_row)[4], int K, char* smem, float ssq_div, f32x16 (&acc)[2][2]) {
  float* rowscale = (float*)(smem + GEMM_LDS);
  const int tid = opaque_tid(), lane = tid & 63, w = tid >> 6, wm = w >> 1, wn = w & 1, l31 = lane & 31, hh = lane >> 5;
#pragma unroll
  for (int i = 0; i < 2; ++i)
#pragma unroll
    for (int j = 0; j < 2; ++j) acc[i][j] = fzero();
  int srcoff[4];
#pragma unroll
  for (int j = 0; j < 4; ++j) {
    int row = 32 * w + 8 * j + (lane >> 3);
    srcoff[j] = ((lane & 7) ^ ((row >> 1) & 7)) * 8;
  }
  const int nk = K >> 6;
  auto issue = [&](int kt, int buf) {
    char* sa = smem + buf * 2 * GEMM_STAGE;
    char* sb = sa + GEMM_STAGE;
#pragma unroll
    for (int j = 0; j < 4; ++j) {
      const int ldsoff = (32 * w + 8 * j) * 128 + lane * 16;
      __builtin_amdgcn_global_load_lds((const unsigned*)(a_row[j] + kt * 64 + srcoff[j]), (__attribute__((address_space(3))) unsigned*)(sa + ldsoff), 16, 0, 0);
      __builtin_amdgcn_global_load_lds((const unsigned*)(b_row[j] + kt * 64 + srcoff[j]), (__attribute__((address_space(3))) unsigned*)(sb + ldsoff), 16, 0, 0);
    }
  };
  float ssq[2] = {0.f, 0.f};
  asm volatile("s_waitcnt vmcnt(0)" ::: "memory");
  __syncthreads();
  issue(0, 0);
  if (nk > 1) issue(1, 1);
  for (int kt = 0; kt < nk; ++kt) {
    if (kt + 1 < nk) asm volatile("s_waitcnt vmcnt(8)" ::: "memory");
    else asm volatile("s_waitcnt vmcnt(0)" ::: "memory");
    __builtin_amdgcn_s_barrier();
    const char* sa = smem + (kt & 1) * 2 * GEMM_STAGE;
    const char* sb = sa + GEMM_STAGE;
    bf16x8 af[4][2], bfr[4][2];
#pragma unroll
    for (int ks = 0; ks < 4; ++ks) {
#pragma unroll
      for (int i = 0; i < 2; ++i) {
        int row = wm * 64 + i * 32 + l31;
        af[ks][i] = *(const bf16x8*)(sa + row * 128 + (((ks * 2 + hh) ^ ((row >> 1) & 7)) << 4));
      }
#pragma unroll
      for (int j = 0; j < 2; ++j) {
        int row = wn * 64 + j * 32 + l31;
        bfr[ks][j] = *(const bf16x8*)(sb + row * 128 + (((ks * 2 + hh) ^ ((row >> 1) & 7)) << 4));
      }
    }
    __builtin_amdgcn_s_waitcnt(0xc07f);
    __builtin_amdgcn_s_barrier();
    if (kt + 2 < nk) issue(kt + 2, kt & 1);
#pragma unroll
    for (int ks = 0; ks < 4; ++ks) {
      if (SSQ) {
#pragma unroll
        for (int i = 0; i < 2; ++i)
#pragma unroll
          for (int e = 0; e < 8; ++e) { float x = bf2f((bf16)af[ks][i][e]); ssq[i] += x * x; }
      }
#pragma unroll
      for (int i = 0; i < 2; ++i)
#pragma unroll
        for (int j = 0; j < 2; ++j) acc[i][j] = mfma(af[ks][i], bfr[ks][j], acc[i][j]);
    }
  }
  __syncthreads();
  if (SSQ) {
#pragma unroll
    for (int i = 0; i < 2; ++i) {
      float s = ssq[i] + shx(ssq[i], 32);
      if (hh == 0 && wn == 0) rowscale[wm * 64 + i * 32 + l31] = rsqrtf(s * ssq_div + LN_EPS);
    }
    __syncthreads();
  }
}

DI void inproj_tile(const Params& p, int l, int tm, int tn, char* smem) {
  const int tid = opaque_tid(), lane = tid & 63, w = tid >> 6, wm = w >> 1, wn = w & 1, l31 = lane & 31, hh = lane >> 5;
  const bf16* A = (const bf16*)(p.ws + OFF_Y);
  const bf16* Bt = (const bf16*)(p.ws + OFF_WIN + l * SZ_WIN1);
  const bf16* ap[4]; const bf16* bp[4];
#pragma unroll
  for (int j = 0; j < 4; ++j) {
    int r = 32 * (tid >> 6) + 8 * j + ((tid & 63) >> 3);
    ap[j] = A + (size_t)(tm * 128 + r) * 1024;
    bp[j] = Bt + (size_t)(tn * 128 + r) * 1024;
  }
  f32x16 acc[2][2];
  gemm_core<false>(ap, bp, 1024, smem, 0.f, acc);
  bf16* T = (bf16*)smem;
  float* Gt = (float*)(p.ws + OFF_GATES) + (size_t)tm * 128 * 16;
  const int lrow = wm * 64 + 4 * hh;
  __syncthreads();
#pragma unroll
  for (int j = 0; j < 2; ++j) {
    const int cbase = tn * 128 + wn * 64 + j * 32;
    const int gn = cbase + l31;
    const float bias = gn < 2224 ? p.in[I_BIN][l * 2224 + gn] : 0.f;
    const int toff = lrow * 136 + wn * 64 + j * 32 + l31;
    const int goff = lrow * 16 + l31;
#pragma unroll
    for (int i = 0; i < 2; ++i)
#pragma unroll
      for (int r = 0; r < 16; ++r) {
        const int mo = i * 32 + 8 * (r >> 2) + (r & 3);
        float v = acc[i][j][r] + bias;
        if (cbase < 512) v = gelu_tanh(v);
        T[toff + mo * 136] = f2bf(v);
        if (cbase == 2208 && l31 < 16) Gt[goff + mo * 16] = v;
      }
  }
  __syncthreads();
  {
    bf16* Zt = (bf16*)(p.ws + OFF_Z) + (size_t)tm * 128 * ZS + tn * 128;
    const int cmax = (2208 - tn * 128) >> 3;
#pragma unroll
    for (int i = 0; i < 8; ++i) {
      const int id = tid + 256 * i, row = id >> 4, c = id & 15;
      if (c < cmax) *(u32x4*)(Zt + (size_t)row * ZS + c * 8) = *(const u32x4*)(T + row * 136 + c * 8);
    }
  }
}

DI void uq_tile(const Params& p, int l, int tm, int tn, char* smem) {
  const int tid = opaque_tid(), lane = tid & 63, w = tid >> 6, wm = w >> 1, wn = w & 1, l31 = lane & 31, hh = lane >> 5;
  const bf16* Z = (const bf16*)(p.ws + OFF_Z);
  const bf16* Bt = (const bf16*)(p.ws + OFF_WUQ + l * SZ_WUQ1);
  const bf16* ap[4]; const bf16* bp[4];
#pragma unroll
  for (int j = 0; j < 4; ++j) {
    int r = 32 * (tid >> 6) + 8 * j + ((tid & 63) >> 3);
    ap[j] = Z + (size_t)(tm * 128 + r) * ZS + 512;
    bp[j] = Bt + (size_t)(tn * 128 + r) * 384;
  }
  f32x16 acc[2][2];
  gemm_core<true>(ap, bp, 384, smem, 1.f / 384.f, acc);
  const float* rowscale = (const float*)(smem + GEMM_LDS);
  float2* ropes = (float2*)(smem + GEMM_LDS + 512);
  bf16* T = (bf16*)smem;
  const int tok0 = tm * 128;
  const bool lat = tok0 < NTL;
  const int b = lat ? (tok0 >> 12) : ((tok0 - NTL) >> 8);
  const int pos0 = lat ? (tok0 & 4095) : ((tok0 - NTL) & 255);
  const int qbase = lat ? pos0 : 4096 + pos0;
  const int lrow = wm * 64 + 4 * hh;
  ropes[tid] = ((const float2*)(p.ws + OFF_ROPE))[tid];
  ropes[256 + tid] = ((const float2*)(p.ws + OFF_ROPE))[256 + tid];
  __syncthreads();
#pragma unroll
  for (int j = 0; j < 2; ++j) {
    const int cb = tn * 4 + wn * 2 + j;
    const int seg = cb % 3;
#pragma unroll
    for (int i = 0; i < 2; ++i)
#pragma unroll
      for (int r = 0; r < 16; ++r) {
        const int m = lrow + i * 32 + 8 * (r >> 2) + (r & 3);
        float v = acc[i][j][r] * rowscale[m] * QSCALE;
        if (seg == 2) {
          float pr = shx(v, 8);
          if (lat) {
            const int pos = pos0 + m;
            const int ap2 = (l31 & 16) ? (pos & 63) : (pos >> 6);
            const float2 cs = ropes[ap2 * 8 + (l31 & 7)];
            v = (l31 & 8) ? (v * cs.x + pr * cs.y) : (v * cs.x - pr * cs.y);
          }
        }
        T[m * 136 + wn * 64 + j * 32 + l31] = f2bf(v);
      }
  }
  __syncthreads();
  {
    bf16* Qb = (bf16*)((char*)p.out + OOFF_Q);
#pragma unroll
    for (int i = 0; i < 8; ++i) {
      const int id = tid + 256 * i, row = id >> 4, c = id & 15;
      const int col = tn * 128 + c * 8, hq = col / 96, d = col - hq * 96;
      *(u32x4*)(Qb + ((size_t)(b * 8 + hq) * KTOT + qbase + row) * 96 + d) = *(const u32x4*)(T + row * 136 + c * 8);
    }
  }
}

DI void ukv_tile(const Params& p, int l, int tm, int tn, char* smem) {
  const int tid = opaque_tid(), lane = tid & 63, w = tid >> 6, wm = w >> 1, wn = w & 1, l31 = lane & 31, hh = lane >> 5;
  const bf16* Z = (const bf16*)(p.ws + OFF_Z);
  const bf16* Bt = (const bf16*)(p.ws + OFF_WUKV + l * SZ_WUKV1);
  const bf16* ap[4]; const bf16* bp[4];
#pragma unroll
  for (int j = 0; j < 4; ++j) {
    int r = 32 * (tid >> 6) + 8 * j + ((tid & 63) >> 3);
    ap[j] = Z + (size_t)(tm * 128 + r) * ZS + 896;
    bp[j] = Bt + (size_t)(tn * 128 + r) * 256;
  }
  f32x16 acc[2][2];
  gemm_core<true>(ap, bp, 256, smem, 1.f / 256.f, acc);
  const float* rowscale = (const float*)(smem + GEMM_LDS);
  const int tok0 = tm * 128;
  const bool lat = tok0 < NTL;
  const int b = lat ? (tok0 >> 12) : ((tok0 - NTL) >> 8);
  const int kbase = lat ? (tok0 & 4095) : 4096 + ((tok0 - NTL) & 255);
  const int bh = b * 8 + tn;
  bf16* TK = (bf16*)smem;
  bf16* TV = TK + 128 * 72;
  const int lrow = wm * 64 + 4 * hh;
  __syncthreads();
#pragma unroll
  for (int j = 0; j < 2; ++j)
#pragma unroll
    for (int i = 0; i < 2; ++i)
#pragma unroll
      for (int r = 0; r < 16; ++r) {
        const int m = lrow + i * 32 + 8 * (r >> 2) + (r & 3);
        const bf16 v = f2bf(acc[i][j][r] * rowscale[m]);
        if (wn == 0) TK[m * 72 + j * 32 + l31] = v;
        else TV[(j * 32 + l31) * 136 + m] = v;
      }
  __syncthreads();
  {
    bf16* KNt = (bf16*)(p.ws + OFF_KN) + ((size_t)bh * KTOT + kbase) * 64;
    bf16* VTt = (bf16*)(p.ws + OFF_VT) + (size_t)bh * 64 * KTOT + kbase;
#pragma unroll
    for (int i = 0; i < 4; ++i) {
      const int id = tid + 256 * i;
      { const int row = id >> 3, c = id & 7; *(u32x4*)(KNt + (size_t)row * 64 + c * 8) = *(const u32x4*)(TK + row * 72 + c * 8); }
      { const int dv = id >> 4, c = id & 15; *(u32x4*)(VTt + (size_t)dv * KTOT + c * 8) = *(const u32x4*)(TV + dv * 136 + c * 8); }
    }
  }
}

DI void krope_item(const Params& p, int tm) {
  const int tid = opaque_tid();
  const bf16* Z = (const bf16*)(p.ws + OFF_Z);
  bf16* KR = (bf16*)(p.ws + OFF_KR);
  const float2* rope = (const float2*)(p.ws + OFF_ROPE);
  int tok = tm * 128 + (tid >> 1), half = tid & 1;
  const bool lat = tok < NTL;
  int b = lat ? (tok >> 12) : ((tok - NTL) >> 8);
  int pos = lat ? (tok & 4095) : ((tok - NTL) & 255);
  int kpos = lat ? pos : 4096 + pos;
  const uint4* src = (const uint4*)(Z + (size_t)tok * ZS + 1152 + half * 16);
  uint4 u0 = src[0], u1 = src[1];
  float z[16];
  z[0] = bflo(u0.x); z[1] = bfhi(u0.x); z[2] = bflo(u0.y); z[3] = bfhi(u0.y);
  z[4] = bflo(u0.z); z[5] = bfhi(u0.z); z[6] = bflo(u0.w); z[7] = bfhi(u0.w);
  z[8] = bflo(u1.x); z[9] = bfhi(u1.x); z[10] = bflo(u1.y); z[11] = bfhi(u1.y);
  z[12] = bflo(u1.z); z[13] = bfhi(u1.z); z[14] = bflo(u1.w); z[15] = bfhi(u1.w);
  float o[16];
  if (lat) {
    int ap2 = half ? (pos & 63) : (pos >> 6);
#pragma unroll
    for (int jj = 0; jj < 8; ++jj) {
      float2 cs = rope[ap2 * 8 + jj];
      o[jj] = z[jj] * cs.x - z[8 + jj] * cs.y;
      o[8 + jj] = z[8 + jj] * cs.x + z[jj] * cs.y;
    }
  } else {
#pragma unroll
    for (int jj = 0; jj < 16; ++jj) o[jj] = z[jj];
  }
  uint4 w0, w1;
  w0.x = pack2(o[0], o[1]); w0.y = pack2(o[2], o[3]); w0.z = pack2(o[4], o[5]); w0.w = pack2(o[6], o[7]);
  w1.x = pack2(o[8], o[9]); w1.y = pack2(o[10], o[11]); w1.z = pack2(o[12], o[13]); w1.w = pack2(o[14], o[15]);
  uint4* dst = (uint4*)(KR + ((size_t)b * KTOT + kpos) * 32 + half * 16);
  dst[0] = w0; dst[1] = w1;
}

DI void gmlp_item(const Params& p, int l, int c, char* smem) {
  const int tid = opaque_tid(), lane = tid & 63, w = tid >> 6, l31 = lane & 31, hh = lane >> 5;
  bf16* vT = (bf16*)smem;
  float* st = (float*)(smem + 128 * 136 * 2);
  float* lng = st + 256;
  float* lnb = lng + 256;
  float* sgbs = lnb + 256;
  const bf16* Z = (const bf16*)(p.ws + OFF_Z);
  bf16* Y = (bf16*)(p.ws + OFF_Y);
  const bf16* SGW = (const bf16*)(p.ws + OFF_SGW + l * SZ_SGW1);
  const int tok0 = c * 128;
  __syncthreads();
  lng[tid] = p.in[I_SGLNG][l * 256 + tid]; lnb[tid] = p.in[I_SGLNB][l * 256 + tid];
  sgbs[tid] = p.in[I_SGB][l * 512 + tid]; sgbs[256 + tid] = p.in[I_SGB][l * 512 + 256 + tid];
  {
    int t = tid >> 1, half = tid & 1;
    const uint4* src = (const uint4*)(Z + (size_t)(tok0 + t) * ZS + 256 + half * 128);
    float s = 0.f, q = 0.f;
#pragma unroll 4
    for (int i = 0; i < 16; ++i) {
      uint4 u = src[i];
      float a0 = bflo(u.x), a1 = bfhi(u.x), a2 = bflo(u.y), a3 = bfhi(u.y), a4 = bflo(u.z), a5 = bfhi(u.z), a6 = bflo(u.w), a7 = bfhi(u.w);
      s += a0 + a1 + a2 + a3 + a4 + a5 + a6 + a7;
      q += a0 * a0 + a1 * a1 + a2 * a2 + a3 * a3 + a4 * a4 + a5 * a5 + a6 * a6 + a7 * a7;
    }
    s += shx(s, 1); q += shx(q, 1);
    float mean = s * (1.f / 256.f);
    float var = fmaxf(q * (1.f / 256.f) - mean * mean, 0.f);
    if (half == 0) { st[2 * t] = mean; st[2 * t + 1] = rsqrtf(var + LN_EPS); }
  }
  for (int rd = 0; rd < 2; ++rd) {
    __syncthreads();
#pragma unroll 2
    for (int i = 0; i < 8; ++i) {
      int id = tid + 256 * i;
      int t = id & 127, cc = id >> 7;
      int ch0 = rd * 128 + cc * 8;
      uint4 u = *(const uint4*)(Z + (size_t)(tok0 + t) * ZS + 256 + ch0);
      float mean = st[2 * t], rstd = st[2 * t + 1];
      float a[8] = {bflo(u.x), bfhi(u.x), bflo(u.y), bfhi(u.y), bflo(u.z), bfhi(u.z), bflo(u.w), bfhi(u.w)};
#pragma unroll
      for (int e = 0; e < 8; ++e) {
        float g = lng[ch0 + e], bb = lnb[ch0 + e];
        vT[(cc * 8 + e) * 136 + t] = f2bf((a[e] - mean) * rstd * g + bb);
      }
    }
    __syncthreads();
    const int g = 2 * rd + (w >> 1), tb2 = w & 1;
    f32x16 acc[2][2];
#pragma unroll
    for (int i = 0; i < 2; ++i)
#pragma unroll
      for (int j = 0; j < 2; ++j) acc[i][j] = fzero();
#pragma unroll 2
    for (int ks = 0; ks < 8; ++ks) {
      bf16x8 af[2], bfr[2];
#pragma unroll
      for (int i = 0; i < 2; ++i) af[i] = *(const bf16x8*)(SGW + ((size_t)g * 128 + tb2 * 64 + i * 32 + l31) * 128 + ks * 16 + hh * 8);
#pragma unroll
      for (int j = 0; j < 2; ++j) bfr[j] = *(const bf16x8*)&vT[((w >> 1) * 64 + j * 32 + l31) * 136 + ks * 16 + hh * 8];
#pragma unroll
      for (int i = 0; i < 2; ++i)
#pragma unroll
        for (int j = 0; j < 2; ++j) acc[i][j] = mfma(af[i], bfr[j], acc[i][j]);
    }
    __syncthreads();
    {
      const float* sgb = sgbs + g * 128;
      const int lrow = tb2 * 64 + 4 * hh;
#pragma unroll
      for (int i = 0; i < 2; ++i)
#pragma unroll
        for (int j = 0; j < 2; ++j) {
          const int to = lrow * 136 + (w >> 1) * 64 + j * 32 + l31;
#pragma unroll
          for (int r = 0; r < 16; ++r) {
            const int mo = i * 32 + 8 * (r >> 2) + (r & 3);
            vT[to + mo * 136] = f2bf(acc[i][j][r] + sgb[lrow + mo]);
          }
        }
    }
    __syncthreads();
#pragma unroll 2
    for (int i = 0; i < 8; ++i) {
      const int id = tid + 256 * i, row = id >> 4, cc = id & 15;
      const u32x4 uu = *(const u32x4*)(Z + (size_t)(tok0 + row) * ZS + rd * 128 + cc * 8);
      const u32x4 mm = *(const u32x4*)(vT + row * 136 + cc * 8);
      u32x4 o;
      o.x = pack2(bflo(uu.x) * bflo(mm.x), bfhi(uu.x) * bfhi(mm.x));
      o.y = pack2(bflo(uu.y) * bflo(mm.y), bfhi(uu.y) * bfhi(mm.y));
      o.z = pack2(bflo(uu.z) * bflo(mm.z), bfhi(uu.z) * bfhi(mm.z));
      o.w = pack2(bflo(uu.w) * bflo(mm.w), bfhi(uu.w) * bfhi(mm.w));
      *(u32x4*)(Y + (size_t)(tok0 + row) * 1024 + rd * 128 + cc * 8) = o;
    }
  }
}

DI float conv_silu(const Params& p, int l, const bf16* Z, int seq0, int slen, int pos, int zcol, int ch) {
  float a = p.in[I_CONVB][l * 512 + ch];
#pragma unroll
  for (int tap = 0; tap < 5; ++tap) {
    int pp = pos + tap - 2;
    if (pp >= 0 && pp < slen) a += p.in[I_CONVW][(l * 5 + tap) * 512 + ch] * bf2f(Z[(size_t)(seq0 + pp) * ZS + zcol]);
  }
  return silu_f(a);
}
DI void conv16(const Params& p, int l, const bf16* Zcol, int slen, int pos_start, int ch, float (&out)[16]) {
  float wgt[5];
#pragma unroll
  for (int tap = 0; tap < 5; ++tap) wgt[tap] = p.in[I_CONVW][(l * 5 + tap) * 512 + ch];
  const float bias = p.in[I_CONVB][l * 512 + ch];
  float x[20];
#pragma unroll
  for (int i = 0; i < 20; ++i) {
    int pp = pos_start - 2 + i;
    x[i] = (pp >= 0 && pp < slen) ? bf2f(Zcol[(size_t)pp * ZS]) : 0.f;
  }
#pragma unroll
  for (int i = 0; i < 16; ++i) {
    float a = bias;
#pragma unroll
    for (int tap = 0; tap < 5; ++tap) a += wgt[tap] * x[i + tap];
    out[i] = silu_f(a);
  }
}
DI void stage_rows68(const bf16* Zseq  , int slen, int pos_start, bf16* raw) {
  const int tid = opaque_tid();
#pragma unroll
  for (int i = 0; i < 3; ++i) {
    const int id = tid + 256 * i;
    if (id < 68 * 8) {
      const int row = id >> 3, c = id & 7, pp = pos_start - 2 + row;
      u32x4 u = {0u, 0u, 0u, 0u};
      if (pp >= 0 && pp < slen) u = *(const u32x4*)(Zseq + (size_t)pp * ZS + c * 8);
      *(u32x4*)(raw + row * 64 + c * 8) = u;
    }
  }
}
DI void conv16_lds(const Params& p, int l, const bf16* rawcol  , int row0, int ch, float (&out)[16]) {
  float wgt[5];
#pragma unroll
  for (int tap = 0; tap < 5; ++tap) wgt[tap] = p.in[I_CONVW][(l * 5 + tap) * 512 + ch];
  const float bias = p.in[I_CONVB][l * 512 + ch];
  float x[20];
#pragma unroll
  for (int i = 0; i < 20; ++i) x[i] = bf2f(rawcol[(row0 + i) * 64]);
#pragma unroll
  for (int i = 0; i < 16; ++i) {
    float a = bias;
#pragma unroll
    for (int tap = 0; tap < 5; ++tap) a += wgt[tap] * x[i + tap];
    out[i] = silu_f(a);
  }
}
DI float log_sigmoid_f(float x) { return fminf(x, 0.f) - __logf(1.f + __expf(-fabsf(x))); }

DI void ml1_item(const Params& p, int l, int b, int h, int c, char* smem) {
  const int tid = opaque_tid(), lane = tid & 63, w = tid >> 6, l31 = lane & 31, hh = lane >> 5;
  bf16* kT = (bf16*)smem;
  bf16* wvT = kT + 64 * 72;
  float* lf = (float*)(wvT + 2 * 64 * 72);
  float* li = lf + 128;
  float* wv = li + 128;
  float* misc = wv + 128;
  bf16* kraw = (bf16*)(misc + 4);
  bf16* vraw = kraw + 68 * 64;
  const bf16* Z = (const bf16*)(p.ws + OFF_Z);
  const float* G = (const float*)(p.ws + OFF_GATES);
  int seq0, slen, pos0;
  if (c < 64) { seq0 = b * 4096; slen = 4096; pos0 = c * 64; } else { seq0 = NTL + b * 256; slen = 256; pos0 = (c - 64) * 64; }
  const int bh = b * 4 + h;
  __syncthreads();
  if (tid < 128) {
    int dir = tid >> 6, s = tid & 63;
    const float* g = G + (size_t)(seq0 + pos0 + s) * 16 + dir * 8 + h;
    li[tid] = g[0];
    lf[tid] = log_sigmoid_f(g[4] + p.in[I_FBIAS][l * 8 + dir * 4 + h]);
  }
  stage_rows68(Z + (size_t)seq0 * ZS + 1440 + h * 64, slen, pos0, kraw);
#pragma unroll
  for (int i = 0; i < 2; ++i) {
    const int id = tid + 256 * i, row = id >> 3, cc = id & 7;
    *(u32x4*)(vraw + row * 64 + cc * 8) = *(const u32x4*)(Z + (size_t)(seq0 + pos0 + row) * ZS + 1696 + h * 64 + cc * 8);
  }
  __syncthreads();
  {
    const int j = tid & 63, sg = tid >> 6;
    float kk[16];
    conv16_lds(p, l, kraw + j, sg * 16, 256 + h * 64 + j, kk);
#pragma unroll
    for (int i = 0; i < 16; i += 2) *(unsigned*)&kT[j * 72 + sg * 16 + i] = pack2(kk[i] * 0.125f, kk[i + 1] * 0.125f);
  }
  __syncthreads();
  if (w < 2) {
    const int dir = w, sidx = dir ? 63 - lane : lane;
    float cum = wave_scan_add(lf[dir * 64 + sidx]);
    float bend = __int_as_float(__builtin_amdgcn_readlane(__float_as_int(cum), 63));
    float g = bend - cum + li[dir * 64 + sidx];
    float mloc = wave_max(g);
    wv[dir * 64 + sidx] = __expf(g - mloc);
    if (lane == 0) { misc[dir * 2] = mloc; misc[dir * 2 + 1] = bend; }
  }
  __syncthreads();
  for (int e = tid; e < 4096; e += NTHR) {
    int s = e >> 6, i = e & 63;
    float v = bf2f(vraw[s * 64 + i]);
    wvT[i * 72 + s] = f2bf(v * wv[s]);
    wvT[(64 + i) * 72 + s] = f2bf(v * wv[64 + s]);
  }
  __syncthreads();
  float* SC = (float*)((char*)p.out + OOFF_SC);
  float* SN = (float*)((char*)p.out + OOFF_SN);
  float* SM = (float*)(p.ws + OFF_SM);
  {
    const int dir = w >> 1, ib = w & 1;
    f32x16 acc[2]; acc[0] = fzero(); acc[1] = fzero();
#pragma unroll
    for (int ks = 0; ks < 4; ++ks) {
      bf16x8 a = *(const bf16x8*)&wvT[(dir * 64 + ib * 32 + l31) * 72 + ks * 16 + hh * 8];
#pragma unroll
      for (int jb = 0; jb < 2; ++jb) {
        bf16x8 bb = *(const bf16x8*)&kT[(jb * 32 + l31) * 72 + ks * 16 + hh * 8];
        acc[jb] = mfma(a, bb, acc[jb]);
      }
    }
    float* dst = SC + ((size_t)(bh * 2 + dir) * 68 + c) * 4096;
#pragma unroll
    for (int jb = 0; jb < 2; ++jb)
#pragma unroll
      for (int r = 0; r < 16; ++r) dst[(ib * 32 + crow(r, hh)) * 64 + jb * 32 + l31] = acc[jb][r];
  }
  if (tid < 128) {
    int dir = tid >> 6, j = tid & 63;
    float a = 0.f;
    for (int s = 0; s < 64; ++s) a += wv[dir * 64 + s] * bf2f(kT[j * 72 + s]);
    SN[((size_t)(bh * 2 + dir) * 68 + c) * 64 + j] = a;
  }
  if (tid == 0 || tid == 64) {
    int dir = tid >> 6;
    float* sm = SM + ((size_t)(bh * 2 + dir) * 68 + c) * 4;
    sm[0] = misc[dir * 2]; sm[1] = misc[dir * 2 + 1];
  }
}

DI void ml2_item(const Params& p, int it, char* smem) {
  const int tid = opaque_tid();
  const int eb = it & 3, bd = it >> 2;
  const int dir = bd & 1;
  float* aa = (float*)smem;
  float* ss = aa + 68;
  float* SC = (float*)((char*)p.out + OOFF_SC) + (size_t)bd * 68 * 4096;
  float* SN = (float*)((char*)p.out + OOFF_SN) + (size_t)bd * 68 * 64;
  float* SM = (float*)(p.ws + OFF_SM) + (size_t)bd * 68 * 4;
  float* mls = ss + 68;
  float* bes = mls + 68;
  float* m0s = bes + 68;
  __syncthreads();
  if (tid < 68) { mls[tid] = SM[tid * 4]; bes[tid] = SM[tid * 4 + 1]; }
  __syncthreads();
  if (tid == 0) {
    float m = 0.f;
    for (int n = 0; n < 68; ++n) {
      int c = (n < 4) ? (dir ? 67 - n : 64 + n) : (dir ? 67 - n : n - 4);
      float ml = mls[c], be = bes[c];
      float mn = fmaxf(be + m, ml);
      aa[n] = __expf(be + m - mn);
      ss[n] = __expf(ml - mn);
      m0s[c] = m;
      m = mn;
    }
  }
  __syncthreads();
  if (eb == 0 && tid < 68) SM[tid * 4 + 2] = m0s[tid];
  {
    typedef __attribute__((ext_vector_type(4))) float f32x4v;
    const int e = (eb * 256 + tid) * 4;
    f32x4v C = {0.f, 0.f, 0.f, 0.f};
#pragma unroll 1
    for (int n0 = 0; n0 < 68; n0 += 17) {
      f32x4v cl[17];
#pragma unroll
      for (int u = 0; u < 17; ++u) {
        const int n = n0 + u;
        const int c = (n < 4) ? (dir ? 67 - n : 64 + n) : (dir ? 67 - n : n - 4);
        cl[u] = *(const f32x4v*)(SC + (size_t)c * 4096 + e);
      }
#pragma unroll
      for (int u = 0; u < 17; ++u) {
        const int n = n0 + u;
        const int c = (n < 4) ? (dir ? 67 - n : 64 + n) : (dir ? 67 - n : n - 4);
        *(f32x4v*)(SC + (size_t)c * 4096 + e) = C;
        C = aa[n] * C + ss[n] * cl[u];
      }
    }
  }
  if (eb == 0 && tid < 64) {
    float C = 0.f;
    for (int n = 0; n < 68; ++n) {
      int c = (n < 4) ? (dir ? 67 - n : 64 + n) : (dir ? 67 - n : n - 4);
      float cl = SN[c * 64 + tid];
      SN[c * 64 + tid] = C;
      C = aa[n] * C + ss[n] * cl;
    }
  }
}

DI void ml3_item(const Params& p, int l, int b, int h, int c, char* smem) {
  const int tid = opaque_tid(), lane = tid & 63, w = tid >> 6, l31 = lane & 31, hh = lane >> 5;
  bf16* qs = (bf16*)smem;
  bf16* ks_ = qs + 64 * 72;
  bf16* vT = ks_ + 64 * 72;
  float* hbuf = (float*)(vT + 64 * 72);
  float* lf = hbuf + 64 * 65;
  float* li = lf + 128;
  float* bc = li + 128;
  float* cv = bc + 128;
  float* mt = cv + 128;
  float* n0s = mt + 128;
  float* m0s = n0s + 128;
  bf16* qraw = (bf16*)(m0s + 4);
  bf16* kraw = qraw + 68 * 64;
  const bf16* Z = (const bf16*)(p.ws + OFF_Z);
  const float* G = (const float*)(p.ws + OFF_GATES);
  bf16* Y = (bf16*)(p.ws + OFF_Y);
  int seq0, slen, pos0;
  if (c < 64) { seq0 = b * 4096; slen = 4096; pos0 = c * 64; } else { seq0 = NTL + b * 256; slen = 256; pos0 = (c - 64) * 64; }
  const int bh = b * 4 + h;
  const float* SC = (const float*)((char*)p.out + OOFF_SC);
  const float* SN = (const float*)((char*)p.out + OOFF_SN);
  const float* SM = (const float*)(p.ws + OFF_SM);
  __syncthreads();
  if (tid < 128) {
    int dir = tid >> 6, s = tid & 63;
    const float* g = G + (size_t)(seq0 + pos0 + s) * 16 + dir * 8 + h;
    li[tid] = g[0];
    lf[tid] = log_sigmoid_f(g[4] + p.in[I_FBIAS][l * 8 + dir * 4 + h]);
    n0s[tid] = SN[((size_t)(bh * 2 + dir) * 68 + c) * 64 + s];
  }
  if (tid < 2) m0s[tid] = SM[((size_t)(bh * 2 + tid) * 68 + c) * 4 + 2];
  stage_rows68(Z + (size_t)seq0 * ZS + 1184 + h * 64, slen, pos0, qraw);
  stage_rows68(Z + (size_t)seq0 * ZS + 1440 + h * 64, slen, pos0, kraw);
#pragma unroll
  for (int i = 0; i < 2; ++i) {
    const int id = tid + 256 * i, row = id >> 3, cc = id & 7;
    u32x4 u = *(const u32x4*)(Z + (size_t)(seq0 + pos0 + row) * ZS + 1696 + h * 64 + cc * 8);
    bf16* d = vT + (cc * 8) * 72 + row;
    d[0 * 72] = (bf16)(u.x & 0xffffu); d[1 * 72] = (bf16)(u.x >> 16);
    d[2 * 72] = (bf16)(u.y & 0xffffu); d[3 * 72] = (bf16)(u.y >> 16);
    d[4 * 72] = (bf16)(u.z & 0xffffu); d[5 * 72] = (bf16)(u.z >> 16);
    d[6 * 72] = (bf16)(u.w & 0xffffu); d[7 * 72] = (bf16)(u.w >> 16);
  }
  __syncthreads();
  {
    const int j = tid & 63, sg = tid >> 6;
    float qq[16], kk[16];
    conv16_lds(p, l, qraw + j, sg * 16, h * 64 + j, qq);
    conv16_lds(p, l, kraw + j, sg * 16, 256 + h * 64 + j, kk);
#pragma unroll
    for (int i = 0; i < 16; ++i) {
      qs[(sg * 16 + i) * 72 + j] = f2bf(qq[i]);
      ks_[(sg * 16 + i) * 72 + j] = f2bf(kk[i] * 0.125f);
    }
  }
  __syncthreads();
  if (w < 2) {
    const int dr = w, sidx = dr ? 63 - lane : lane;
    float cum = wave_scan_add(lf[dr * 64 + sidx]);
    float x = li[dr * 64 + sidx] - cum;
    float pm = wave_scan_max(x);
    bc[dr * 64 + sidx] = cum; cv[dr * 64 + sidx] = x;
    mt[dr * 64 + sidx] = fmaxf(cum + m0s[dr], cum + pm);
  }
  __syncthreads();
  const int dir = w >> 1, tb = w & 1;
  const int t = tb * 32 + l31;
  bf16x8 qf[4];
#pragma unroll
  for (int ks = 0; ks < 4; ++ks) qf[ks] = *(const bf16x8*)&qs[t * 72 + ks * 16 + hh * 8];
  f32x16 sacc[2]; sacc[0] = fzero(); sacc[1] = fzero();
#pragma unroll
  for (int sb = 0; sb < 2; ++sb)
#pragma unroll
    for (int ks = 0; ks < 4; ++ks) {
      bf16x8 a = *(const bf16x8*)&ks_[(sb * 32 + l31) * 72 + ks * 16 + hh * 8];
      sacc[sb] = mfma(a, qf[ks], sacc[sb]);
    }
  const float bt = bc[dir * 64 + t], mtt = mt[dir * 64 + t], m0d = m0s[dir];
  const float base = bt - mtt;
  float psum = 0.f;
#pragma unroll
  for (int sb = 0; sb < 2; ++sb)
#pragma unroll
    for (int r = 0; r < 16; ++r) {
      int s = sb * 32 + crow(r, hh);
      bool valid = dir ? (s >= t) : (s <= t);
      float pv = valid ? __expf(base + cv[dir * 64 + s]) * sacc[sb][r] : 0.f;
      psum += pv;
      sacc[sb][r] = pv;
    }
  psum += shx(psum, 32);
  f32x16 num1[2], num2[2];
  num1[0] = fzero(); num1[1] = fzero(); num2[0] = fzero(); num2[1] = fzero();
#pragma unroll
  for (int slab = 0; slab < 4; ++slab) {
    const int sb = slab >> 1, s2 = slab & 1;
    uint4 pu;
    pu.x = pack2(sacc[sb][8 * s2 + 0], sacc[sb][8 * s2 + 1]);
    pu.y = pack2(sacc[sb][8 * s2 + 2], sacc[sb][8 * s2 + 3]);
    pu.z = pack2(sacc[sb][8 * s2 + 4], sacc[sb][8 * s2 + 5]);
    pu.w = pack2(sacc[sb][8 * s2 + 6], sacc[sb][8 * s2 + 7]);
    bf16x8 pf = __builtin_bit_cast(bf16x8, pu);
#pragma unroll
    for (int ib = 0; ib < 2; ++ib) {
      uint2 lo = *(const uint2*)&vT[(ib * 32 + l31) * 72 + slab * 16 + 4 * hh];
      uint2 hi = *(const uint2*)&vT[(ib * 32 + l31) * 72 + slab * 16 + 8 + 4 * hh];
      uint4 au; au.x = lo.x; au.y = lo.y; au.z = hi.x; au.w = hi.y;
      num2[ib] = mfma(__builtin_bit_cast(bf16x8, au), pf, num2[ib]);
    }
  }
  {
    const float* C0 = SC + ((size_t)(bh * 2 + dir) * 68 + c) * 4096;
#pragma unroll
    for (int ib = 0; ib < 2; ++ib)
#pragma unroll
      for (int ks = 0; ks < 4; ++ks) {
        const float4* src = (const float4*)(C0 + (ib * 32 + l31) * 64 + ks * 16 + hh * 8);
        float4 f0 = src[0], f1 = src[1];
        uint4 au; au.x = pack2(f0.x, f0.y); au.y = pack2(f0.z, f0.w); au.z = pack2(f1.x, f1.y); au.w = pack2(f1.z, f1.w);
        num1[ib] = mfma(__builtin_bit_cast(bf16x8, au), qf[ks], num1[ib]);
      }
  }
  float nq = 0.f;
#pragma unroll
  for (int ks = 0; ks < 4; ++ks)
#pragma unroll
    for (int e = 0; e < 8; ++e) nq += bf2f((bf16)qf[ks][e]) * n0s[dir * 64 + ks * 16 + hh * 8 + e];
  nq += shx(nq, 32);
  const float inter = __expf(bt + m0d - mtt);
  const float den = inter * nq + psum;
  const float inv = 1.f / fmaxf(fabsf(den), __expf(-mtt));
#pragma unroll
  for (int ib = 0; ib < 2; ++ib)
#pragma unroll
    for (int r = 0; r < 16; ++r) num2[ib][r] = (inter * num1[ib][r] + num2[ib][r]) * inv;
  if (dir == 1) {
#pragma unroll
    for (int ib = 0; ib < 2; ++ib)
#pragma unroll
      for (int r = 0; r < 16; ++r) hbuf[t * 65 + ib * 32 + crow(r, hh)] = num2[ib][r];
  }
  __syncthreads();
  if (dir == 0) {
    float s = 0.f;
#pragma unroll
    for (int ib = 0; ib < 2; ++ib)
#pragma unroll
      for (int r = 0; r < 16; ++r) { num2[ib][r] += hbuf[t * 65 + ib * 32 + crow(r, hh)]; s += num2[ib][r]; }
    s += shx(s, 32);
    float mean = s * (1.f / 64.f);
    float q = 0.f;
#pragma unroll
    for (int ib = 0; ib < 2; ++ib)
#pragma unroll
      for (int r = 0; r < 16; ++r) { num2[ib][r] -= mean; q += num2[ib][r] * num2[ib][r]; }
    q += shx(q, 32);
    float rstd = rsqrtf(q * (1.f / 64.f) + LN_EPS);
    const int tok = seq0 + pos0 + t;
#pragma unroll
    for (int ib = 0; ib < 2; ++ib)
#pragma unroll
      for (int rg = 0; rg < 4; ++rg) {
        int i0 = ib * 32 + 8 * rg + 4 * hh;
        uint2 ou = *(const uint2*)&Z[(size_t)tok * ZS + 1952 + h * 64 + i0];
        float og[4] = {bflo(ou.x), bfhi(ou.x), bflo(ou.y), bfhi(ou.y)};
        float y[4];
#pragma unroll
        for (int e = 0; e < 4; ++e) y[e] = num2[ib][4 * rg + e] * rstd * p.in[I_MLNG][l * 256 + h * 64 + i0 + e] * sigmoid_f(og[e]);
        uint2 o; o.x = pack2(y[0], y[1]); o.y = pack2(y[2], y[3]);
        *(uint2*)&Y[(size_t)tok * 1024 + 768 + h * 64 + i0] = o;
      }
  }
}

DI void attn_item(const Params& p, int b, int h, int q0, int key0, int nkt, int tok0, char* smem) {
  const int tid = opaque_tid(), lane = tid & 63, w = tid >> 6, l31 = lane & 31, hh = lane >> 5;
  bf16* Ks = (bf16*)smem;
  bf16* Vs = Ks + 64 * 104;
  bf16* Qs = Vs + 64 * 72;
  const bf16* Q = (const bf16*)((const char*)p.out + OOFF_Q);
  const bf16* KN = (const bf16*)(p.ws + OFF_KN);
  const bf16* VT = (const bf16*)(p.ws + OFF_VT);
  const bf16* KR = (const bf16*)(p.ws + OFF_KR);
  bf16* Y = (bf16*)(p.ws + OFF_Y);
  const int bh = b * 8 + h;
  __syncthreads();
  {
    const bf16* qsrc = Q + ((size_t)bh * KTOT + q0) * 96;
#pragma unroll 4
    for (int i = 0; i < 12; ++i) {
      const int id = tid + 256 * i, row = id / 12, c = id - row * 12;
      *(u32x4*)&Qs[row * 104 + c * 8] = *(const u32x4*)(qsrc + (size_t)row * 96 + c * 8);
    }
  }
  f32x16 o[2][2];
#pragma unroll
  for (int qb = 0; qb < 2; ++qb) { o[qb][0] = fzero(); o[qb][1] = fzero(); }
  float mrun[2] = {-INFINITY, -INFINITY}, lrun[2] = {0.f, 0.f};
  u32x4 pkA[2], pvA[2], prA, pkB[2], pvB[2], prB;
  const bf16* knp[2]; const bf16* vtp[2];
#pragma unroll
  for (int i = 0; i < 2; ++i) {
    int id = tid + 256 * i, row = id >> 3, ch = id & 7;
    knp[i] = KN + ((size_t)bh * KTOT + key0 + row) * 64 + ch * 8;
    vtp[i] = VT + ((size_t)bh * 64 + row) * KTOT + key0 + ch * 8;
  }
  const bf16* krp = KR + ((size_t)b * KTOT + key0 + (tid >> 2)) * 32 + (tid & 3) * 8;
#pragma unroll
  for (int i = 0; i < 2; ++i) { pkA[i] = *(const u32x4*)knp[i]; pvA[i] = *(const u32x4*)vtp[i]; }
  prA = *(const u32x4*)krp;
#pragma unroll
  for (int i = 0; i < 2; ++i) { pkB[i] = *(const u32x4*)(knp[i] + 64 * 64); pvB[i] = *(const u32x4*)(vtp[i] + 64); }
  prB = *(const u32x4*)(krp + 64 * 32);
  auto tstep = [&](u32x4 (&pk)[2], u32x4 (&pv)[2], u32x4& pr, int knext) {
    __syncthreads();
#pragma unroll
    for (int i = 0; i < 2; ++i) {
      int id = tid + 256 * i, row = id >> 3, ch = id & 7;
      *(u32x4*)&Ks[row * 104 + ch * 8] = pk[i];
      *(u32x4*)&Vs[row * 72 + ch * 8] = pv[i];
    }
    *(u32x4*)&Ks[(tid >> 2) * 104 + 64 + (tid & 3) * 8] = pr;
    __syncthreads();
    if (knext < nkt) {
#pragma unroll
      for (int i = 0; i < 2; ++i) {
        pk[i] = *(const u32x4*)(knp[i] + (size_t)knext * 64 * 64);
        pv[i] = *(const u32x4*)(vtp[i] + knext * 64);
      }
      pr = *(const u32x4*)(krp + (size_t)knext * 64 * 32);
    }
#pragma unroll
    for (int qb = 0; qb < 2; ++qb) {
      bf16x8 qf[6];
#pragma unroll
      for (int ks = 0; ks < 6; ++ks) qf[ks] = *(const bf16x8*)&Qs[(w * 64 + qb * 32 + l31) * 104 + ks * 16 + hh * 8];
      const float mref0 = mrun[qb] == -INFINITY ? 0.f : mrun[qb];
      f32x16 s[2];
#pragma unroll
      for (int r = 0; r < 16; ++r) { s[0][r] = -mref0; s[1][r] = -mref0; }
#pragma unroll
      for (int kb = 0; kb < 2; ++kb)
#pragma unroll
        for (int ks = 0; ks < 6; ++ks) {
          bf16x8 a = *(const bf16x8*)&Ks[(kb * 32 + l31) * 104 + ks * 16 + hh * 8];
          s[kb] = mfma(a, qf[ks], s[kb]);
        }
      float mx = fmaxf(s[0][0], s[1][0]);
#pragma unroll
      for (int r = 1; r < 16; ++r) mx = fmaxf(fmaxf(mx, s[0][r]), s[1][r]);
      mx = fmaxf(mx, shx(mx, 32));
      if (__builtin_amdgcn_ballot_w64(mrun[qb] == -INFINITY || mx > 8.f) != 0ull) {
        const float d = fmaxf(mx, 0.f);
        const float mnew = (mrun[qb] == -INFINITY) ? mx : mref0 + d;
        const float shift = mnew - mref0;
        const float alpha = (mrun[qb] == -INFINITY) ? 0.f : __builtin_amdgcn_exp2f(-shift);
        mrun[qb] = mnew;
        lrun[qb] *= alpha;
#pragma unroll
        for (int db = 0; db < 2; ++db)
#pragma unroll
          for (int r = 0; r < 16; ++r) o[qb][db][r] *= alpha;
#pragma unroll
        for (int kb = 0; kb < 2; ++kb)
#pragma unroll
          for (int r = 0; r < 16; ++r) s[kb][r] -= shift;
      }
      float rs = 0.f;
#pragma unroll
      for (int kb = 0; kb < 2; ++kb)
#pragma unroll
        for (int r = 0; r < 16; ++r) { float e = __builtin_amdgcn_exp2f(s[kb][r]); s[kb][r] = e; rs += e; }
      lrun[qb] += rs;
#pragma unroll
      for (int slab = 0; slab < 4; ++slab) {
        const int kb = slab >> 1, s2 = slab & 1;
        uint4 pu;
        pu.x = pack2(s[kb][8 * s2 + 0], s[kb][8 * s2 + 1]);
        pu.y = pack2(s[kb][8 * s2 + 2], s[kb][8 * s2 + 3]);
        pu.z = pack2(s[kb][8 * s2 + 4], s[kb][8 * s2 + 5]);
        pu.w = pack2(s[kb][8 * s2 + 6], s[kb][8 * s2 + 7]);
        bf16x8 pf = __builtin_bit_cast(bf16x8, pu);
#pragma unroll
        for (int db = 0; db < 2; ++db) {
          uint2 lo = *(const uint2*)&Vs[(db * 32 + l31) * 72 + slab * 16 + 4 * hh];
          uint2 hi = *(const uint2*)&Vs[(db * 32 + l31) * 72 + slab * 16 + 8 + 4 * hh];
          uint4 au; au.x = lo.x; au.y = lo.y; au.z = hi.x; au.w = hi.y;
          o[qb][db] = mfma(__builtin_bit_cast(bf16x8, au), pf, o[qb][db]);
        }
      }
    }
  };
  for (int kt = 0; kt < nkt; kt += 2) {
    tstep(pkA, pvA, prA, kt + 2);
    tstep(pkB, pvB, prB, kt + 3);
  }
#pragma unroll
  for (int qb = 0; qb < 2; ++qb) {
    const float lsum = lrun[qb] + shx(lrun[qb], 32);
    const float inv = 1.f / lsum;
    const int tok = tok0 + w * 64 + qb * 32 + l31;
#pragma unroll
    for (int db = 0; db < 2; ++db)
#pragma unroll
      for (int rg = 0; rg < 4; ++rg) {
        int dv = db * 32 + 8 * rg + 4 * hh;
        uint2 ou;
        ou.x = pack2(o[qb][db][4 * rg] * inv, o[qb][db][4 * rg + 1] * inv);
        ou.y = pack2(o[qb][db][4 * rg + 2] * inv, o[qb][db][4 * rg + 3] * inv);
        *(uint2*)&Y[(size_t)tok * 1024 + 256 + h * 64 + dv] = ou;
      }
  }
}

DI void outproj_tile(const Params& p, int l, int tm, int tn, char* smem, float* R, const float* XL, const float* XC) {
  const int tid = opaque_tid(), lane = tid & 63, w = tid >> 6, wm = w >> 1, wn = w & 1, l31 = lane & 31, hh = lane >> 5;
  const bf16* A = (const bf16*)(p.ws + OFF_Y);
  const bf16* Bt = (const bf16*)(p.ws + OFF_WOUT + l * SZ_WOUT1);
  const bf16* ap[4]; const bf16* bp[4];
#pragma unroll
  for (int j = 0; j < 4; ++j) {
    int r = 32 * (tid >> 6) + 8 * j + ((tid & 63) >> 3);
    ap[j] = A + (size_t)(tm * 128 + r) * 1024;
    bp[j] = Bt + (size_t)(tn * 128 + r) * 1024;
  }
  f32x16 acc[2][2];
  gemm_core<false>(ap, bp, 1024, smem, 0.f, acc);
  const int tok0 = tm * 128;
  const float* xres = (tok0 < NTL ? (XL + (size_t)tok0 * 1024) : (XC + (size_t)(tok0 - NTL) * 1024)) + tn * 128;
  float* Rt = R + (size_t)tok0 * 1024 + tn * 128;
  const float* g1 = (const float*)(p.ws + OFF_ADA) + (size_t)(l * 9 + ada_row(tok0)) * 6144 + 2 * 1024 + tn * 128;
  float* T = (float*)smem;
#pragma unroll
  for (int half = 0; half < 2; ++half) {
    __syncthreads();
    if (wm == half) {
#pragma unroll
      for (int i = 0; i < 2; ++i)
#pragma unroll
        for (int j = 0; j < 2; ++j)
#pragma unroll
          for (int r = 0; r < 16; ++r) T[(i * 32 + crow(r, hh)) * 132 + wn * 64 + j * 32 + l31] = acc[i][j][r];
    }
    __syncthreads();
#pragma unroll 2
    for (int i = 0; i < 8; ++i) {
      const int id = tid + 256 * i, row = id >> 5, c4 = (id & 31) * 4;
      const float4 a = *(const float4*)(T + row * 132 + c4);
      const float4 g = *(const float4*)(g1 + c4);
      const float4 x = *(const float4*)(xres + (size_t)(half * 64 + row) * 1024 + c4);
      float4 o;
      o.x = ALPHA * x.x + g.x * a.x; o.y = ALPHA * x.y + g.y * a.y; o.z = ALPHA * x.z + g.z * a.z; o.w = ALPHA * x.w + g.w * a.w;
      *(float4*)(Rt + (size_t)(half * 64 + row) * 1024 + c4) = o;
    }
  }
}

DI void ln1_router_item(const Params& p, int l, int it, char* smem, float* R, const float (&wr)[16][4]) {
  const int tid = opaque_tid(), lane = tid & 63, w = tid >> 6;
  float* hrow = (float*)smem;
  float* lg = hrow + 4 * 1024;
  const int tok = it * 4 + w;
  const float* ada = (const float*)(p.ws + OFF_ADA) + (size_t)(l * 9 + ada_row(tok)) * 6144;
  float v[16];
  float* row = R + (size_t)tok * 1024;
  row_load(row, v);
  row_norm(v);
  row_affine<0>(v, p.in[I_LN1G] + l * 1024, p.in[I_LN1B] + l * 1024);
  {
    float t[16];
#pragma unroll
    for (int i = 0; i < 16; ++i) t[i] = ALPHA * v[i];
    row_store(row, t);
  }
  row_norm(v);
  row_affine<1>(v, ada + 4 * 1024, ada + 3 * 1024);
  row_store_bf((bf16*)(p.ws + OFF_Y) + (size_t)tok * 1024, v);
  if (lane == 0) ((int*)(p.ws + OFF_TOKCNT))[tok] = 0;
  __syncthreads();
  row_store(hrow + w * 1024, v);
  __syncthreads();
  float part[4][4];
#pragma unroll
  for (int r = 0; r < 4; ++r) {
    float hv[16];
    row_load(hrow + r * 1024, hv);
#pragma unroll
    for (int e = 0; e < 4; ++e) {
      float s = 0.f;
#pragma unroll
      for (int i = 0; i < 16; ++i) s += hv[i] * wr[i][e];
      part[r][e] = s;
    }
  }
#pragma unroll
  for (int r = 0; r < 4; ++r)
#pragma unroll
    for (int e = 0; e < 4; ++e) {
      float s = wave_sum(part[r][e]);
      if (lane == 0) lg[r * 16 + w * 4 + e] = s;
    }
  __syncthreads();
  if (tid < 64) {
    int r = tid >> 4, e = tid & 15;
    float mx = -INFINITY;
#pragma unroll
    for (int i = 0; i < 16; ++i) mx = fmaxf(mx, lg[r * 16 + i]);
    float sum = 0.f;
#pragma unroll
    for (int i = 0; i < 16; ++i) sum += __expf(lg[r * 16 + i] - mx);
    float a = __expf(lg[r * 16 + e] - mx) / sum;
    int tk = it * 4 + r;
    if (tk < NTL) ((float*)(p.ws + OFF_AFFL))[((size_t)((tk >> 12) * 16 + e)) * 4096 + (tk & 4095)] = a;
    else { int tc = tk - NTL; ((float*)(p.ws + OFF_AFFC))[((size_t)((tc >> 8) * 16 + e)) * 256 + (tc & 255)] = a; }
  }
}

template <int NV>
DI void topk_item(const Params& p, int be, bool is_ctx, int me, char* smem) {
  const int tid = opaque_tid(), lane = tid & 63, w = tid >> 6;
  constexpr int N = NV * 256;
  constexpr int KSEL = N / 8;
  unsigned* hist = (unsigned*)smem;
  unsigned* ctl = hist + 256;
  unsigned* wtot = ctl + 4;
  const float* src = (const float*)(p.ws + (is_ctx ? OFF_AFFC : OFF_AFFL)) + (size_t)be * N + tid * NV;
  float v[NV]; unsigned u[NV];
  if (NV == 16) {
#pragma unroll
    for (int i = 0; i < NV / 4; ++i) { float4 t = ((const float4*)src)[i]; v[4 * i] = t.x; v[4 * i + 1] = t.y; v[4 * i + 2] = t.z; v[4 * i + 3] = t.w; }
  } else {
#pragma unroll
    for (int i = 0; i < NV; ++i) v[i] = src[i];
  }
#pragma unroll
  for (int i = 0; i < NV; ++i) u[i] = __float_as_uint(v[i]);
  unsigned prefix = 0, mask = 0, remaining = KSEL;
  for (int pass = 0; pass < 4; ++pass) {
    const int shift = 24 - 8 * pass;
    __syncthreads();
    hist[tid] = 0;
    __syncthreads();
#pragma unroll
    for (int i = 0; i < NV; ++i)
      if ((u[i] & mask) == prefix) atomicAdd(&hist[(u[i] >> shift) & 255], 1u);
    __syncthreads();
    if (w == 0) {
      const unsigned h0 = hist[255 - 4 * lane], h1 = hist[254 - 4 * lane], h2 = hist[253 - 4 * lane], h3 = hist[252 - 4 * lane];
      const unsigned s4 = h0 + h1 + h2 + h3;
      const unsigned inc = wave_scan_add_u(s4);
      const unsigned exc = inc - s4;
      if ((exc < remaining && inc >= remaining) || (lane == 63 && inc < remaining)) {
        unsigned cum = exc; int d = 255 - 4 * lane;
        if (cum + h0 < remaining) { cum += h0; --d; if (cum + h1 < remaining) { cum += h1; --d; if (cum + h2 < remaining) { cum += h2; --d; } } }
        ctl[0] = prefix | ((unsigned)d << shift);
        ctl[1] = remaining - cum;
      }
    }
    __syncthreads();
    prefix = ctl[0]; remaining = ctl[1];
    mask |= 255u << shift;
  }
  const unsigned thresh = prefix;
  unsigned cgt = 0, ceq = 0;
#pragma unroll
  for (int i = 0; i < NV; ++i) { cgt += (u[i] > thresh); ceq += (u[i] == thresh); }
  unsigned sg = wave_scan_add_u(cgt), se = wave_scan_add_u(ceq);
  __syncthreads();
  if (lane == 63) { wtot[w] = sg; wtot[4 + w] = se; }
  __syncthreads();
  unsigned og = 0, oe = 0, totg = 0;
#pragma unroll
  for (int i = 0; i < 4; ++i) { if (i < w) { og += wtot[i]; oe += wtot[4 + i]; } totg += wtot[i]; }
  unsigned pg = og + sg - cgt, pe = oe + se - ceq;
  const int b = be >> 4, e = be & 15;
  int* rowtok = (int*)(p.ws + OFF_ROWTOK) + (size_t)e * MEMAX + (is_ctx ? 4096 + b * 32 : b * 512);
  float* rowgate = (float*)(p.ws + OFF_ROWGATE) + (size_t)e * MEMAX + (is_ctx ? 4096 + b * 32 : b * 512);
  const int tokbase = is_ctx ? NTL + b * 256 : b * 4096;
#pragma unroll
  for (int i = 0; i < NV; ++i) {
    int slot = -1;
    if (u[i] > thresh) slot = (int)pg++;
    else if (u[i] == thresh) { if (pe < remaining) slot = (int)(totg + pe); pe++; }
    if (slot >= 0 && slot < KSEL) {
      const int tk = tokbase + tid * NV + i;
      rowtok[slot] = tk; rowgate[slot] = v[i];
      const int c = atomicAdd((int*)(p.ws + OFF_TOKCNT) + tk, 1);
      ((int*)(p.ws + OFF_TOKLIST))[tk * 16 + c] = e * 4096 * 0 + (is_ctx ? -(e * 256 + b * 32 + slot) - 1 : e * 4096 + b * 512 + slot);
    }
  }
}

DI void moe1_tile(const Params& p, int e, int tm, int tn, char* smem) {
  const int tid = opaque_tid(), lane = tid & 63, w = tid >> 6, wm = w >> 1, wn = w & 1, l31 = lane & 31, hh = lane >> 5;
  const bf16* XM = (const bf16*)(p.ws + OFF_Y);
  const bf16* Bt = (const bf16*)(p.ws + OFF_WGU) + (size_t)e * 2048 * 1024;
  const int* rowtok = (const int*)(p.ws + OFF_ROWTOK) + (size_t)e * MEMAX;
  const bf16* ap[4]; const bf16* bp[4];
#pragma unroll
  for (int j = 0; j < 4; ++j) {
    int r = 32 * (tid >> 6) + 8 * j + ((tid & 63) >> 3);
    ap[j] = XM + (size_t)rowtok[tm * 128 + r] * 1024;
    bp[j] = Bt + (size_t)(tn * 128 + r) * 1024;
  }
  f32x16 acc[2][2];
  gemm_core<false>(ap, bp, 1024, smem, 0.f, acc);
  bf16* T = (bf16*)smem;
  __syncthreads();
  {
    const int toff = (wm * 64 + 4 * hh) * 72 + wn * 32 + l31;
#pragma unroll
    for (int i = 0; i < 2; ++i)
#pragma unroll
      for (int r = 0; r < 16; ++r) {
        const int mo = i * 32 + 8 * (r >> 2) + (r & 3);
        float g = acc[i][0][r], u = acc[i][1][r];
        T[toff + mo * 72] = f2bf(silu_f(g) * u);
      }
  }
  __syncthreads();
  {
    bf16* hid = (bf16*)(p.ws + OFF_Z) + ((size_t)e * MEMAX + tm * 128) * 1024 + 64 * tn;
#pragma unroll
    for (int i = 0; i < 4; ++i) {
      const int id = tid + 256 * i, row = id >> 3, c = id & 7;
      *(u32x4*)(hid + (size_t)row * 1024 + c * 8) = *(const u32x4*)(T + row * 72 + c * 8);
    }
  }
}

DI void moe2_tile(const Params& p, int l, int e, int tm, int tn, char* smem, bf16* YEL, bf16* YEC) {
  const int tid = opaque_tid(), lane = tid & 63, w = tid >> 6, wm = w >> 1, wn = w & 1, l31 = lane & 31, hh = lane >> 5;
  const bf16* A = (const bf16*)(p.ws + OFF_Z) + (size_t)e * MEMAX * 1024;
  const bf16* Bt = (const bf16*)(p.ws + OFF_WD) + (size_t)e * 1024 * 1024;
  const int* rowtok = (const int*)(p.ws + OFF_ROWTOK) + (size_t)e * MEMAX;
  const float* rowgate = (const float*)(p.ws + OFF_ROWGATE) + (size_t)e * MEMAX;
  const bf16* ap[4]; const bf16* bp[4];
#pragma unroll
  for (int j = 0; j < 4; ++j) {
    int r = 32 * (tid >> 6) + 8 * j + ((tid & 63) >> 3);
    ap[j] = A + (size_t)(tm * 128 + r) * 1024;
    bp[j] = Bt + (size_t)(tn * 128 + r) * 1024;
  }
  f32x16 acc[2][2];
  gemm_core<false>(ap, bp, 1024, smem, 0.f, acc);
  const int arow = tm * 128 < 4096 ? (tm * 128) >> 9 : 8;
  const float* g2 = (const float*)(p.ws + OFF_ADA) + (size_t)(l * 9 + arow) * 6144 + 5 * 1024 + tn * 128 + wn * 64 + l31;
  const float g2v0 = g2[0], g2v1 = g2[32];
  bf16* T = (bf16*)smem;
  float* gs = (float*)(smem + GEMM_LDS);
  if (tid < 128) gs[tid] = rowgate[tm * 128 + tid];
  __syncthreads();
#pragma unroll
  for (int i = 0; i < 2; ++i)
#pragma unroll
    for (int r = 0; r < 16; ++r) {
      const int ml = wm * 64 + i * 32 + crow(r, hh);
      const float gt = gs[ml];
      T[ml * 136 + wn * 64 + l31] = f2bf(g2v0 * gt * acc[i][0][r]);
      T[ml * 136 + wn * 64 + 32 + l31] = f2bf(g2v1 * gt * acc[i][1][r]);
    }
  __syncthreads();
  {
    const int m0 = tm * 128;
    bf16* dst = (m0 < 4096 ? YEL + ((size_t)e * 4096 + m0) * 1024 : YEC + ((size_t)e * 256 + (m0 - 4096)) * 1024) + tn * 128;
#pragma unroll
    for (int i = 0; i < 8; ++i) {
      const int id = tid + 256 * i, row = id >> 4, c = id & 15;
      *(u32x4*)(dst + (size_t)row * 1024 + c * 8) = *(const u32x4*)(T + row * 136 + c * 8);
    }
  }
}

#define XB_TMO      128
#define XB_XCNT(j)  (256  + 64 * (j))
#define XB_XSUB(j)  (1280 + 64 * (j))
#define XB_XGEN(j)  (2304 + 64 * (j))
#define XB_TOP      3328
#define XB_TOPGEN   3392
#define XCD_BAR_WORDS 3456
#define XB_SPIN_CAP (1u << 22)
#define LAS __attribute__((address_space(3)))
DI unsigned xb_ld(unsigned* p) { return __hip_atomic_load(p, __ATOMIC_RELAXED, __HIP_MEMORY_SCOPE_AGENT); }
DI unsigned xb_add(unsigned* p, unsigned v) { return __hip_atomic_fetch_add(p, v, __ATOMIC_RELAXED, __HIP_MEMORY_SCOPE_AGENT); }
DI unsigned xb_xcc_id() { return (unsigned)__builtin_amdgcn_s_getreg((3 << 11) | 20) & 0xFu; }
#define XB_SPIN(cond, bar) do { unsigned _sp = 0; while (cond) { __builtin_amdgcn_s_sleep(1); \
    if ((++_sp & 255u) == 0u) { if (xb_ld(&(bar)[XB_TMO])) break; if (_sp > XB_SPIN_CAP) { atomicAdd(&(bar)[XB_TMO], 1u); break; } } } } while (0)
struct XcdBarrier { unsigned* bar; unsigned x; volatile LAS unsigned* st; };
DI XcdBarrier xcd_barrier_post(unsigned* bar, volatile LAS unsigned* st) {
  XcdBarrier b; b.bar = bar; b.x = (unsigned)__builtin_amdgcn_readfirstlane((int)xb_xcc_id()); b.st = st;
  if (threadIdx.x == 0) (void)xb_add(&bar[XB_XCNT(b.x)], 1u);
  return b;
}
DI void xcd_barrier_complete(unsigned* bar, unsigned x, unsigned& nloc, unsigned& nx) {
  const unsigned G = gridDim.x * gridDim.y * gridDim.z;
  unsigned sum, cnt, mine, sp = 0u;
  for (;;) {
    sum = 0u; cnt = 0u; mine = 0u;
#pragma unroll
    for (unsigned j = 0; j < 16; ++j) { const unsigned c = xb_ld(&bar[XB_XCNT(j)]); sum += c; cnt += (c > 0u) ? 1u : 0u; mine = (j == x) ? c : mine; }
    if (sum == G) break;
    __builtin_amdgcn_s_sleep(1);
    if ((++sp & 255u) == 0u) { if (xb_ld(&bar[XB_TMO])) break; if (sp > XB_SPIN_CAP) { atomicAdd(&bar[XB_TMO], 1u); break; } }
  }
  nloc = mine > 0u ? mine : 1u; nx = cnt > 0u ? cnt : 1u;
}
DI void xcd_barrier(const XcdBarrier& b) {
  asm volatile("s_waitcnt vmcnt(0)" ::: "memory");
  __syncthreads();
  if (threadIdx.x == 0) {
    unsigned* bar = b.bar;
    unsigned bx = b.x;
    asm volatile("" : "+s"(bx), "+s"(bar));
    __builtin_amdgcn_s_waitcnt(0);
    unsigned nloc = b.st[0], nx = b.st[1];
    if (nloc == 0u) { xcd_barrier_complete(bar, bx, nloc, nx); b.st[0] = nloc; b.st[1] = nx; }
    const unsigned old = xb_add(&bar[XB_XSUB(bx)], 1u);
    const unsigned gen = old / nloc;
    if (old + 1u == (gen + 1u) * nloc) {
      __builtin_amdgcn_fence(__ATOMIC_RELEASE, "agent");
      asm volatile("s_waitcnt vmcnt(0)" ::: "memory");
      const unsigned og = xb_add(&bar[XB_TOP], 1u);
      const unsigned tg = og / nx;
      if (og + 1u == (tg + 1u) * nx) xb_add(&bar[XB_TOPGEN], 1u);
      else XB_SPIN(xb_ld(&bar[XB_TOPGEN]) == tg, bar);
      __builtin_amdgcn_fence(__ATOMIC_ACQUIRE, "agent");
      xb_add(&bar[XB_XGEN(bx)], 1u);
      asm volatile("s_waitcnt vmcnt(0)" ::: "memory");
    } else {
      XB_SPIN(xb_ld(&bar[XB_XGEN(bx)]) == gen, bar);
      __builtin_amdgcn_fence(__ATOMIC_ACQUIRE, "agent");
      asm volatile("s_waitcnt vmcnt(0)" ::: "memory");
    }
  }
  __syncthreads();
}

__global__ void __launch_bounds__(NTHR, 2) hybrid_mega(Params p_in) {
  Params p = p_in;
  cg::grid_group grid = cg::this_grid();
  extern __shared__ __attribute__((aligned(16))) char smem[];
  const int tid = opaque_tid(), lane = tid & 63, w = tid >> 6;
  const int G = gridDim.x, bid = blockIdx.x;
  int nlb = G >> 3, vx = bid & 7, lb = (bid < 8 * nlb) ? (bid >> 3) : (1 << 28);
  __shared__ uint4 xb_words;
  __shared__ int xmap[2];
  if (tid == 0) xb_words = make_uint4(0u, 0u, 0u, 0u);
  __syncthreads();
  XcdBarrier xb = xcd_barrier_post((unsigned*)(p.ws + OFF_BAR), (volatile LAS unsigned*)&xb_words);
  if (p.ws == nullptr) grid.sync();
  if (tid == 0) xmap[0] = (int)xb_add((unsigned*)(p.ws + OFF_BAR) + 8 * xb.x, 1u);
  float* X2 = (float*)(p.ws + OFF_X2);
  bf16* XM = (bf16*)(p.ws + OFF_Y);
  const float* ADA = (const float*)(p.ws + OFF_ADA);

  PH(0) {
    const int n_ada = 384, n_w = 2 * NW_TILES, n_e = NE_TILES;
    const int total = n_ada + 1 + n_w + n_e;
    for (int it = bid; it < total; it += G) {
      if (it < n_ada) ada_item(p, it, (float*)smem);
      else if (it == n_ada) {
        for (int i = opaque_tid(); i < 512; i += NTHR) {
          int ap2 = i >> 3, j = i & 7;
          float inv = powf(10000.f, -(float)j * 2.0f / 16.0f);
          float ang = (float)ap2 * inv;
          ((float2*)(p.ws + OFF_ROPE))[i] = make_float2(cosf(ang), sinf(ang));
        }
      } else if (it < n_ada + 1 + n_w) {
        int k = it - n_ada - 1;
        convert_weight_item(p, k / NW_TILES, k % NW_TILES, (float*)smem);
      } else convert_expert_item(p, 0, it - n_ada - 1 - n_w, (float*)smem);
    }
  }
  xcd_barrier(xb);
  {
    if (tid == 0) {
      unsigned* bar = (unsigned*)(p.ws + OFF_BAR);
      int ok = (G & 7) == 0;
      for (int j = 0; j < 16; ++j) { unsigned c = xb_ld(&bar[XB_XCNT(j)]); if (c != (j < 8 ? (unsigned)(G >> 3) : 0u)) ok = 0; }
      xmap[1] = ok;
    }
    __syncthreads();
    if (__builtin_amdgcn_readfirstlane(xmap[1])) { vx = (int)xb.x; lb = __builtin_amdgcn_readfirstlane(xmap[0]); }
  }
  PH(1) for (int it = bid; it < NT / 4; it += G) {
    const int w = opaque_tid() >> 6;
    int tok = it * 4 + w;
    const float* row = tok < NTL ? p.in[I_X] + (size_t)tok * 1024 : p.in[I_CTX] + (size_t)(tok - NTL) * 1024;
    const float* ada = ADA + (size_t)ada_row(tok) * 6144;
    float v[16];
    row_load(row, v);
    row_norm(v);
    row_affine<1>(v, ada + 1024, ada);
    row_store_bf(XM + (size_t)tok * 1024, v);
  }
  xcd_barrier(xb);

  for (int l = 0; l < 2; ++l) {
    const bool upd = (l == 0);
    const int mt_q = upd ? 272 : 256;
    float* R = upd ? X2 : p.out;
    bf16* YEL = upd ? (bf16*)p.out : (bf16*)(p.ws + OFF_X2);
    bf16* YEC = (bf16*)(p.ws + OFF_KN);
    PH(2) for (int li = lb; li < 68 * 9; li += nlb) {
      int mi = li / 9, ntl = li - mi * 9;
      inproj_tile(p, l, (vx & 3) + 4 * mi, (vx >> 2) * 9 + ntl, smem);
    }
    xcd_barrier(xb);
    PH(3) {
      const int n_ml1 = 32 * 68, n_g = mt_q, n_kr = 272;
      if (P3MASK & 1) for (int li = lb; li < (mt_q / 8) * 6; li += nlb) { int mi = li / 6; uq_tile(p, l, vx + 8 * mi, li - mi * 6, smem); }
      if (P3MASK & 2) for (int li = lb; li < 34 * 8; li += nlb) ukv_tile(p, l, vx + 8 * (li >> 3), li & 7, smem);
      const int total = n_ml1 + n_g + n_kr;
      for (int it = bid; it < total; it += G) {
        int k = it;
        if (k < n_ml1) { int c = k % 68, bh = k / 68; if (P3MASK & 4) ml1_item(p, l, bh >> 2, bh & 3, c, smem); continue; }
        k -= n_ml1;
        if (k < n_g) { if (P3MASK & 8) gmlp_item(p, l, k, smem); continue; }
        k -= n_g;
        if (P3MASK & 16) krope_item(p, k);
      }
    }
    xcd_barrier(xb);
    PH(4) {
      const int n_ml2 = 64 * 4, n_ac = upd ? 8 * 8 * 2 : 0;
      for (int it = bid; it < n_ml2; it += G) ml2_item(p, it, smem);
      for (int li = lb; li < 8 * 16; li += nlb) {
        int bh = vx + 8 * (li >> 4), qt = li & 15;
        int b = bh >> 3, h = bh & 7;
        attn_item(p, b, h, qt * 256, 0, 68, b * 4096 + qt * 256, smem);
      }
      if (upd) for (int k = bid; k < 64; k += G) {
        int b = k >> 3, h = k & 7;
        attn_item(p, b, h, 4096, 4096, 4, NTL + b * 256, smem);
      }
    }
    xcd_barrier(xb);
    PH(5) {
      const int ncl = 32 * 64, ncc = upd ? 32 * 4 : 0;
      for (int it = bid; it < ncl + ncc; it += G) {
        if (it < ncl) { int c = it & 63, bh = it >> 6; ml3_item(p, l, bh >> 2, bh & 3, c, smem); }
        else { int k = it - ncl; int c = 64 + (k & 3), bh = k >> 2; ml3_item(p, l, bh >> 2, bh & 3, c, smem); }
      }
    }
    xcd_barrier(xb);
    PH(6) {
      const float* XL = upd ? p.in[I_X] : X2;
      const float* XC = upd ? p.in[I_CTX] : (X2 + (size_t)NTL * 1024);
      for (int li = lb; li < (mt_q / 8) * 8; li += nlb) outproj_tile(p, l, vx + 8 * (li >> 3), li & 7, smem, R, XL, XC);
    }
    xcd_barrier(xb);
    PH(7) {
      float wr[16][4];
      {
        const int t2 = opaque_tid(); const int lane = t2 & 63, w = t2 >> 6;
        const float* W = p.in[I_WROUTER] + (size_t)l * 1024 * 16;
#pragma unroll
        for (int i = 0; i < 4; ++i)
#pragma unroll
          for (int c = 0; c < 4; ++c) {
            int k = 4 * lane + 256 * i + c;
            float4 t = *(const float4*)(W + (size_t)k * 16 + w * 4);
            wr[4 * i + c][0] = t.x; wr[4 * i + c][1] = t.y; wr[4 * i + c][2] = t.z; wr[4 * i + c][3] = t.w;
          }
      }
      const int nrows = upd ? NT : NTL;
      for (int it = bid; it < nrows / 4; it += G) ln1_router_item(p, l, it, smem, R, wr);
    }
    xcd_barrier(xb);
    PH(8) {
      const int me = upd ? 4352 : 4096;
      const int total = upd ? 256 : 128;
      for (int it = bid; it < total; it += G) {
        if (it < 128) topk_item<16>(p, it, false, me, smem);
        else topk_item<1>(p, it - 128, true, me, smem);
      }
    }
    xcd_barrier(xb);
    PH(9) {
      const int mtiles = upd ? 34 : 32;
      const int per_e = mtiles * 16, per_h = mtiles * 8;
      for (int li = lb; li < 2 * per_e; li += nlb) {
        int ei = li / per_e, rem = li - ei * per_e;
        int half = rem / per_h, rem2 = rem - half * per_h;
        moe1_tile(p, 2 * vx + ei, rem2 >> 3, half * 8 + (rem2 & 7), smem);
      }
    }
    xcd_barrier(xb);
    PH(10) {
      const int mtiles = upd ? 34 : 32;
      const int per_e = mtiles * 8;
      for (int li = lb; li < 2 * per_e; li += nlb) {
        int ei = li / per_e, rem = li - ei * per_e;
        moe2_tile(p, l, 2 * vx + ei, rem >> 3, rem & 7, smem, YEL, YEC);
      }
    }
    xcd_barrier(xb);
    PH(11) {
      const int nrows = upd ? NT : NTL;
      const int n_r = nrows / 4;
      const int total = n_r + (upd ? NE_TILES : 0);
      for (int it = bid; it < total; it += G) {
        if (it < n_r) {
          const int w = opaque_tid() >> 6;
          int tok = it * 4 + w;
          float v[16];
          float* row = R + (size_t)tok * 1024;
          row_load(row, v);
          {
            const int ln = opaque_tid() & 63;
            const int cnt = ((const int*)(p.ws + OFF_TOKCNT))[tok];
            const int* lst = (const int*)(p.ws + OFF_TOKLIST) + (size_t)tok * 16;
            for (int c = 0; c < cnt; ++c) {
              const int code = lst[c];
              const bf16* yr = code >= 0 ? YEL + (size_t)code * 1024 : YEC + (size_t)(-code - 1) * 1024;
#pragma unroll
              for (int i = 0; i < 4; ++i) {
                uint2 u = *(const uint2*)(yr + 4 * ln + 256 * i);
                v[4 * i] += bflo(u.x); v[4 * i + 1] += bfhi(u.x); v[4 * i + 2] += bflo(u.y); v[4 * i + 3] += bfhi(u.y);
              }
            }
          }
          row_norm(v);
          row_affine<0>(v, p.in[I_LN2G] + l * 1024, p.in[I_LN2B] + l * 1024);
          row_store(row, v);
          if (upd) {
            const float* ada = ADA + (size_t)(9 + ada_row(tok)) * 6144;
            row_norm(v);
            row_affine<1>(v, ada + 1024, ada);
            row_store_bf(XM + (size_t)tok * 1024, v);
          }
        } else convert_expert_item(p, 1, it - n_r, (float*)smem);
      }
    }
    if (l == 0) xcd_barrier(xb);
  }
}

extern "C" void kernel_launch(void* const* d_in, const int* in_sizes, int n_in, void* d_out, int out_size, void* d_ws, size_t ws_size,
                              hipStream_t stream) {
  static int grid_blocks = 0;
  if (!grid_blocks) {
    int dev = 0, cus = 0, per_cu = 0;
    hipGetDevice(&dev);
    hipDeviceGetAttribute(&cus, hipDeviceAttributeMultiprocessorCount, dev);
    hipFuncSetAttribute((const void*)hybrid_mega, hipFuncAttributeMaxDynamicSharedMemorySize, SMEM_BYTES);
    hipOccupancyMaxActiveBlocksPerMultiprocessor(&per_cu, hybrid_mega, NTHR, SMEM_BYTES);
    if (per_cu > 2) per_cu = 2;
    if (per_cu < 1) per_cu = 1;
    grid_blocks = cus * per_cu;
  }
  if (ws_size < WS_END) fprintf(stderr, "workspace too small: %zu < %zu\n", ws_size, (size_t)WS_END);
  hipMemsetAsync((char*)d_ws + OFF_BAR, 0, XCD_BAR_WORDS * 4, stream);
  Params p{};
  for (int i = 0; i < 29; ++i) p.in[i] = (const float*)d_in[i];
  p.out = (float*)d_out;
  p.ws = (char*)d_ws;
  void* args[] = {&p};
  hipError_t e = hipLaunchCooperativeKernel((void*)hybrid_mega, dim3(grid_blocks), dim3(NTHR), args, SMEM_BYTES, stream);
  if (e != hipSuccess) fprintf(stderr, "cooperative launch failed: %s (grid %d)\n", hipGetErrorString(e), grid_blocks);
}
```

```cpp
#include <hip/hip_runtime.h>
#include <hip/hip_cooperative_groups.h>
#include <cstdio>
namespace cg = cooperative_groups;

#define DI __device__ __forceinline__
#define MEMBAR() asm volatile("" ::: "memory")
DI int opaque_tid() { int t = threadIdx.x; asm volatile("" : "+v"(t)); return t; }
typedef unsigned u32x2_t __attribute__((ext_vector_type(2)));
DI float shx(float v, int m) {
  if (m == 1) return __int_as_float(__builtin_amdgcn_update_dpp(0, __float_as_int(v), 0xB1, 0xF, 0xF, false));
  if (m == 2) return __int_as_float(__builtin_amdgcn_update_dpp(0, __float_as_int(v), 0x4E, 0xF, 0xF, false));
  if (m == 8) return __int_as_float(__builtin_amdgcn_update_dpp(0, __float_as_int(v), 0x128, 0xF, 0xF, false));
  if (m == 16) return __int_as_float(__builtin_amdgcn_ds_swizzle(__float_as_int(v), 0x401F));
  if (m == 32) {
    const u32x2_t r = __builtin_amdgcn_permlane32_swap(__float_as_uint(v), __float_as_uint(v), false, false);
    return __uint_as_float(((opaque_tid() & 32) != 0) ? r[0] : r[1]);
  }
  const int l = opaque_tid() & 63;
  return __int_as_float(__builtin_amdgcn_ds_bpermute((l ^ m) << 2, __float_as_int(v)));
}
DI float shup(float v, int o) { const int l = opaque_tid() & 63; return __int_as_float(__builtin_amdgcn_ds_bpermute((l >= o ? l - o : l) << 2, __float_as_int(v))); }
DI unsigned shup(unsigned v, int o) { const int l = opaque_tid() & 63; return (unsigned)__builtin_amdgcn_ds_bpermute((l >= o ? l - o : l) << 2, (int)v); }
typedef unsigned short bf16;
typedef __attribute__((ext_vector_type(8))) short bf16x8;
typedef __attribute__((ext_vector_type(16))) float f32x16;
typedef __attribute__((ext_vector_type(2))) __bf16 bfv2;
typedef __attribute__((ext_vector_type(2))) float fv2;
typedef __attribute__((ext_vector_type(4))) unsigned u32x4;

constexpr int NTHR = 256;
constexpr int NB = 8, SEQ = 4096, CTX = 256;
constexpr int NTL = NB * SEQ, NTC = NB * CTX, NT = NTL + NTC;
constexpr int ZS = 2224;
constexpr int KTOT = SEQ + CTX;
constexpr int MEMAX = 4352;
constexpr float LN_EPS = 1e-6f;
constexpr float ALPHA = 1.41421356237f;
constexpr float QSCALE = 0.10206207261596577f * 1.4426950408889634f;

enum { I_X = 0, I_C, I_CTX, I_CCTX, I_WADA, I_BADA, I_WIN, I_BIN, I_SGLNG, I_SGLNB, I_SGW, I_SGB, I_QNG, I_KVNG, I_WUQ, I_WUKV,
       I_CONVW, I_CONVB, I_FBIAS, I_MLNG, I_WOUT, I_LN1G, I_LN1B, I_WROUTER, I_WGATE, I_WUP, I_WDOWN, I_LN2G, I_LN2B };

struct Params {
  const float* in[29];
  float* out;
  char* ws;
};

DI void launder_params(Params& q) {
  char* w = q.ws; float* o = q.out;
  asm volatile("" : "+s"(w), "+s"(o));
  q.ws = w; q.out = o;
}
constexpr size_t al(size_t x) { return (x + 255) & ~size_t(255); }
constexpr size_t OFF_ADA = 0;
constexpr size_t OFF_ROPE = al(OFF_ADA + 2ull * 9 * 6144 * 4);
constexpr size_t OFF_WIN = al(OFF_ROPE + 64 * 8 * 8);
constexpr size_t SZ_WIN1 = 2304ull * 1024 * 2;
constexpr size_t OFF_WUQ = al(OFF_WIN + 2 * SZ_WIN1);
constexpr size_t SZ_WUQ1 = 768ull * 384 * 2;
constexpr size_t OFF_WUKV = al(OFF_WUQ + 2 * SZ_WUQ1);
constexpr size_t SZ_WUKV1 = 1024ull * 256 * 2;
constexpr size_t OFF_WOUT = al(OFF_WUKV + 2 * SZ_WUKV1);
constexpr size_t SZ_WOUT1 = 1024ull * 1024 * 2;
constexpr size_t OFF_SGW = al(OFF_WOUT + 2 * SZ_WOUT1);
constexpr size_t SZ_SGW1 = 4ull * 128 * 128 * 2;
constexpr size_t OFF_WGU = al(OFF_SGW + 2 * SZ_SGW1);
constexpr size_t OFF_WD = al(OFF_WGU + 16ull * 2048 * 1024 * 2);
constexpr size_t OFF_X2 = al(OFF_WD + 16ull * 1024 * 1024 * 2);
constexpr size_t OFF_Z = al(OFF_X2 + (size_t)NT * 1024 * 4);
constexpr size_t OFF_KN = al(OFF_Z + (size_t)NT * ZS * 2);
constexpr size_t OFF_VT = al(OFF_KN + (size_t)NB * 8 * KTOT * 64 * 2);
constexpr size_t OFF_KR = al(OFF_VT + (size_t)NB * 8 * KTOT * 64 * 2);
constexpr size_t OFF_Y = al(OFF_KR + (size_t)NB * KTOT * 32 * 2);
constexpr size_t OFF_GATES = al(OFF_Y + (size_t)NT * 1024 * 2);
constexpr size_t OFF_AFFL = al(OFF_GATES + (size_t)NT * 16 * 4);
constexpr size_t OFF_AFFC = al(OFF_AFFL + 128ull * 4096 * 4);
constexpr size_t OFF_ROWTOK = al(OFF_AFFC + 128ull * 256 * 4);
constexpr size_t OFF_ROWGATE = al(OFF_ROWTOK + 16ull * MEMAX * 4);
constexpr size_t OFF_SM = al(OFF_ROWGATE + 16ull * MEMAX * 4);
constexpr size_t OFF_BAR = al(OFF_SM + 32ull * 2 * 68 * 4 * 4);
constexpr size_t OFF_TOKCNT = al(OFF_BAR + 3456 * 4);
constexpr size_t OFF_TOKLIST = al(OFF_TOKCNT + (size_t)NT * 4);
constexpr size_t WS_END = al(OFF_TOKLIST + (size_t)NT * 16 * 4);
constexpr size_t OOFF_SC = 0;
constexpr size_t OOFF_SN = OOFF_SC + 32ull * 2 * 68 * 4096 * 4;
constexpr size_t OOFF_Q = al(OOFF_SN + 32ull * 2 * 68 * 64 * 4);
static_assert(OOFF_Q + (size_t)NB * 8 * KTOT * 96 * 2 <= (size_t)NTL * 1024 * 4, "d_out scratch overflow");

constexpr int SMEM_BYTES = 75776;
#ifndef PHMASK
#define PHMASK 0xFFFF
#endif
#define PH(n) if (launder_params(p), ((PHMASK >> (n)) & 1))
#ifndef P3MASK
#define P3MASK 31
#endif

DI unsigned pack2(float a, float b) { fv2 f = {a, b}; bfv2 r = __builtin_convertvector(f, bfv2); return __builtin_bit_cast(unsigned, r); }
DI bf16 f2bf(float a) { return (bf16)(pack2(a, 0.f) & 0xffffu); }
DI float bf2f(bf16 h) { return __uint_as_float(((unsigned)h) << 16); }
DI float bflo(unsigned u) { return __uint_as_float(u << 16); }
DI float bfhi(unsigned u) { return __uint_as_float(u & 0xffff0000u); }
DI f32x16 mfma(bf16x8 a, bf16x8 b, f32x16 c) { return __builtin_amdgcn_mfma_f32_32x32x16_bf16(a, b, c, 0, 0, 0); }
DI f32x16 fzero() { f32x16 z; _Pragma("unroll") for (int i = 0; i < 16; ++i) z[i] = 0.f; return z; }
DI int crow(int r, int hh) { return (r & 3) + 8 * (r >> 2) + 4 * hh; }
#define DPP_F(v, ctrl) __int_as_float(__builtin_amdgcn_update_dpp(0, __float_as_int(v), (ctrl), 0xF, 0xF, false))
DI float wave_sum(float v) {
  v += DPP_F(v, 0xB1); v += DPP_F(v, 0x4E); v += DPP_F(v, 0x141); v += DPP_F(v, 0x140);
  v += __int_as_float(__builtin_amdgcn_ds_swizzle(__float_as_int(v), 0x401F));
  return __int_as_float(__builtin_amdgcn_readlane(__float_as_int(v), 0)) + __int_as_float(__builtin_amdgcn_readlane(__float_as_int(v), 32));
}
#define DPP_O(old, v, ctrl, rmask) __builtin_amdgcn_update_dpp((old), (v), (ctrl), (rmask), 0xF, false)
DI float wave_scan_add(float v) {
  v += __int_as_float(DPP_O(0, __float_as_int(v), 0x111, 0xF));
  v += __int_as_float(DPP_O(0, __float_as_int(v), 0x112, 0xF));
  v += __int_as_float(DPP_O(0, __float_as_int(v), 0x114, 0xF));
  v += __int_as_float(DPP_O(0, __float_as_int(v), 0x118, 0xF));
  v += __int_as_float(DPP_O(0, __float_as_int(v), 0x142, 0xA));
  v += __int_as_float(DPP_O(0, __float_as_int(v), 0x143, 0xC));
  return v;
}
DI unsigned wave_scan_add_u(unsigned v) {
  v += (unsigned)DPP_O(0, (int)v, 0x111, 0xF);
  v += (unsigned)DPP_O(0, (int)v, 0x112, 0xF);
  v += (unsigned)DPP_O(0, (int)v, 0x114, 0xF);
  v += (unsigned)DPP_O(0, (int)v, 0x118, 0xF);
  v += (unsigned)DPP_O(0, (int)v, 0x142, 0xA);
  v += (unsigned)DPP_O(0, (int)v, 0x143, 0xC);
  return v;
}
DI float wave_scan_max(float v) {
  const int ninf = (int)0xff800000u;
  v = fmaxf(v, __int_as_float(DPP_O(ninf, __float_as_int(v), 0x111, 0xF)));
  v = fmaxf(v, __int_as_float(DPP_O(ninf, __float_as_int(v), 0x112, 0xF)));
  v = fmaxf(v, __int_as_float(DPP_O(ninf, __float_as_int(v), 0x114, 0xF)));
  v = fmaxf(v, __int_as_float(DPP_O(ninf, __float_as_int(v), 0x118, 0xF)));
  v = fmaxf(v, __int_as_float(DPP_O(ninf, __float_as_int(v), 0x142, 0xA)));
  v = fmaxf(v, __int_as_float(DPP_O(ninf, __float_as_int(v), 0x143, 0xC)));
  return v;
}
DI float wave_max(float v) {
  v = fmaxf(v, DPP_F(v, 0xB1)); v = fmaxf(v, DPP_F(v, 0x4E)); v = fmaxf(v, DPP_F(v, 0x141)); v = fmaxf(v, DPP_F(v, 0x140));
  v = fmaxf(v, __int_as_float(__builtin_amdgcn_ds_swizzle(__float_as_int(v), 0x401F)));
  return fmaxf(__int_as_float(__builtin_amdgcn_readlane(__float_as_int(v), 0)), __int_as_float(__builtin_amdgcn_readlane(__float_as_int(v), 32)));
}
DI float silu_f(float a) { return a / (1.f + __expf(-a)); }
DI float sigmoid_f(float a) { return 1.f / (1.f + __expf(-a)); }
DI float gelu_tanh(float x) {
  float y = 0.7978845608028654f * (x + 0.044715f * x * x * x);
  float t = 1.f - 2.f / (__expf(2.f * y) + 1.f);
  return 0.5f * x * (1.f + t);
}
struct Params;
DI int ada_row(int tok) { return tok < NTL ? (tok >> 12) : 8; }

DI void tr_tile(const float* s0, const float* s1, int ld, int nv0, int nv1, const float* ksc, bf16* dst, int ldd, float* t) {
  const int tid = opaque_tid();
  const int n4 = (tid & 15) * 4, kq = tid >> 4;
  const float* s = (n4 < 32) ? (s0 + n4) : (s1 + (n4 - 32));
  const int nv = (n4 < 32) ? (nv0 - n4) : (nv1 - (n4 - 32));
  __syncthreads();
#pragma unroll
  for (int i = 0; i < 4; ++i) {
    const int k = i * 16 + kq;
    float4 v = make_float4(0.f, 0.f, 0.f, 0.f);
    if (nv >= 4) v = *(const float4*)(s + (size_t)k * ld);
    if (ksc) { const float sc = ksc[k]; v.x *= sc; v.y *= sc; v.z *= sc; v.w *= sc; }
    t[k * 65 + n4] = v.x; t[k * 65 + n4 + 1] = v.y; t[k * 65 + n4 + 2] = v.z; t[k * 65 + n4 + 3] = v.w;
  }
  __syncthreads();
  const int kp = tid & 31, nn = tid >> 5;
#pragma unroll
  for (int i = 0; i < 8; ++i) {
    int n2 = i * 8 + nn;
    float a = t[(2 * kp) * 65 + n2], b = t[(2 * kp + 1) * 65 + n2];
    *(unsigned*)&dst[(size_t)n2 * ldd + 2 * kp] = pack2(a, b);
  }
}

constexpr int NE_TILES = 8192 + 4096;
DI void convert_expert_item(const Params& p, int l, int it, float* sm) {
  if (it < 8192) {
    int e = it >> 9, rem = it & 511, q = rem >> 4, kt = rem & 15;
    const float* g = p.in[I_WGATE] + ((size_t)(l * 16 + e) * 1024 + kt * 64) * 1024 + q * 32;
    const float* u = p.in[I_WUP] + ((size_t)(l * 16 + e) * 1024 + kt * 64) * 1024 + q * 32;
    bf16* dst = (bf16*)(p.ws + OFF_WGU) + ((size_t)e * 2048 + q * 64) * 1024 + kt * 64;
    tr_tile(g, u, 1024, 32, 32, nullptr, dst, 1024, sm);
  } else {
    it -= 8192;
    int e = it >> 8, rem = it & 255, nt = rem >> 4, kt = rem & 15;
    const float* s = p.in[I_WDOWN] + ((size_t)(l * 16 + e) * 1024 + kt * 64) * 1024 + nt * 64;
    bf16* dst = (bf16*)(p.ws + OFF_WD) + ((size_t)e * 1024 + nt * 64) * 1024 + kt * 64;
    tr_tile(s, s + 32, 1024, 32, 32, nullptr, dst, 1024, sm);
  }
}

constexpr int NW_TILES = 576 + 72 + 64 + 256 + 64;
DI void convert_weight_item(const Params& p, int l, int it, float* sm) {
  if (it < 576) {
    int nt = it >> 4, kt = it & 15;
    int n0 = nt * 64;
    int nv0 = min(32, max(0, 2224 - n0)), nv1 = min(32, max(0, 2224 - n0 - 32));
    const float* s = p.in[I_WIN] + ((size_t)l * 1024 + kt * 64) * 2224 + n0;
    bf16* dst = (bf16*)(p.ws + OFF_WIN + l * SZ_WIN1) + (size_t)n0 * 1024 + kt * 64;
    tr_tile(s, s + 32, 2224, nv0, nv1, nullptr, dst, 1024, sm);
    return;
  }
  it -= 576;
  if (it < 72) {
    int nt = it / 6, kt = it % 6;
    const float* s = p.in[I_WUQ] + ((size_t)l * 384 + kt * 64) * 768 + nt * 64;
    bf16* dst = (bf16*)(p.ws + OFF_WUQ + l * SZ_WUQ1) + (size_t)nt * 64 * 384 + kt * 64;
    tr_tile(s, s + 32, 768, 32, 32, p.in[I_QNG] + l * 384 + kt * 64, dst, 384, sm);
    return;
  }
  it -= 72;
  if (it < 64) {
    int nt = it >> 2, kt = it & 3;
    const float* s = p.in[I_WUKV] + ((size_t)l * 256 + kt * 64) * 1024 + nt * 64;
    bf16* dst = (bf16*)(p.ws + OFF_WUKV + l * SZ_WUKV1) + (size_t)nt * 64 * 256 + kt * 64;
    tr_tile(s, s + 32, 1024, 32, 32, p.in[I_KVNG] + l * 256 + kt * 64, dst, 256, sm);
    return;
  }
  it -= 64;
  if (it < 256) {
    int nt = it >> 4, kt = it & 15;
    const float* s = p.in[I_WOUT] + ((size_t)l * 1024 + kt * 64) * 1024 + nt * 64;
    bf16* dst = (bf16*)(p.ws + OFF_WOUT + l * SZ_WOUT1) + (size_t)nt * 64 * 1024 + kt * 64;
    tr_tile(s, s + 32, 1024, 32, 32, nullptr, dst, 1024, sm);
    return;
  }
  it -= 256;
  {
    const int t4 = opaque_tid() * 4;
    const float* s = p.in[I_SGW] + (size_t)l * 65536 + it * 1024 + t4;
    float4 v = *(const float4*)s;
    uint2 o; o.x = pack2(v.x, v.y); o.y = pack2(v.z, v.w);
    *(uint2*)((bf16*)(p.ws + OFF_SGW + l * SZ_SGW1) + it * 1024 + t4) = o;
  }
}

DI void ada_item(const Params& p, int it, float* sm) {
  const int tid = opaque_tid();
  int l = it / 192, cb = it % 192;
  float* sc = sm;
  float* red = sm + 9 * 1024;
  __syncthreads();
  for (int i = tid; i < 9 * 1024; i += NTHR) {
    int r = i >> 10, k = i & 1023;
    float c = r < 8 ? p.in[I_C][r * 1024 + k] : p.in[I_CCTX][k];
    sc[i] = c / (1.f + expf(-c));
  }
  __syncthreads();
  int kg = tid >> 5, cl = tid & 31;
  const float* W = p.in[I_WADA] + (size_t)l * 1024 * 6144 + cb * 32 + cl;
  float acc[9];
#pragma unroll
  for (int r = 0; r < 9; ++r) acc[r] = 0.f;
#pragma unroll 8
  for (int k = kg * 128; k < kg * 128 + 128; ++k) {
    float w = W[(size_t)k * 6144];
#pragma unroll
    for (int r = 0; r < 9; ++r) acc[r] += sc[r * 1024 + k] * w;
  }
#pragma unroll
  for (int r = 0; r < 9; ++r) red[(kg * 9 + r) * 32 + cl] = acc[r];
  __syncthreads();
  float* ada = (float*)(p.ws + OFF_ADA);
  for (int i = tid; i < 288; i += NTHR) {
    int r = i >> 5, c2 = i & 31;
    float s = 0.f;
#pragma unroll
    for (int g = 0; g < 8; ++g) s += red[(g * 9 + r) * 32 + c2];
    ada[(size_t)(l * 9 + r) * 6144 + cb * 32 + c2] = s + p.in[I_BADA][l * 6144 + cb * 32 + c2];
  }
}

DI void row_load(const float* row, float v[16]) {
  const int lane = opaque_tid() & 63;
#pragma unroll
  for (int i = 0; i < 4; ++i) {
    float4 t = *(const float4*)(row + 4 * lane + 256 * i);
    v[4 * i] = t.x; v[4 * i + 1] = t.y; v[4 * i + 2] = t.z; v[4 * i + 3] = t.w;
  }
}
DI void row_store(float* row, const float v[16]) {
  const int lane = opaque_tid() & 63;
#pragma unroll
  for (int i = 0; i < 4; ++i) *(float4*)(row + 4 * lane + 256 * i) = make_float4(v[4 * i], v[4 * i + 1], v[4 * i + 2], v[4 * i + 3]);
}
DI void row_store_bf(bf16* row, const float v[16]) {
  const int lane = opaque_tid() & 63;
#pragma unroll
  for (int i = 0; i < 4; ++i) {
    uint2 o; o.x = pack2(v[4 * i], v[4 * i + 1]); o.y = pack2(v[4 * i + 2], v[4 * i + 3]);
    *(uint2*)(row + 4 * lane + 256 * i) = o;
  }
}
DI void row_norm(float v[16]) {
  float s = 0.f;
#pragma unroll
  for (int i = 0; i < 16; ++i) s += v[i];
  float mean = wave_sum(s) * (1.f / 1024.f);
  float q = 0.f;
#pragma unroll
  for (int i = 0; i < 16; ++i) { v[i] -= mean; q += v[i] * v[i]; }
  float rstd = rsqrtf(wave_sum(q) * (1.f / 1024.f) + LN_EPS);
#pragma unroll
  for (int i = 0; i < 16; ++i) v[i] *= rstd;
}
template <int ONE>
DI void row_affine(float v[16], const float* a, const float* b) {
  const int lane = opaque_tid() & 63;
#pragma unroll
  for (int i = 0; i < 4; ++i) {
    float4 fa = *(const float4*)(a + 4 * lane + 256 * i);
    float4 fb = *(const float4*)(b + 4 * lane + 256 * i);
    v[4 * i] = v[4 * i] * (fa.x + ONE) + fb.x;
    v[4 * i + 1] = v[4 * i + 1] * (fa.y + ONE) + fb.y;
    v[4 * i + 2] = v[4 * i + 2] * (fa.z + ONE) + fb.z;
    v[4 * i + 3] = v[4 * i + 3] * (fa.w + ONE) + fb.w;
  }
}

constexpr int GEMM_STAGE = 128 * 128;
constexpr int GEMM_LDS = 4 * GEMM_STAGE;
template <bool SSQ, int VAR = 0>
DI void gemm_core(const bf16* (&a_row)[4], const bf16* (&b_row)[4], int K, char* smem, float ssq_div, f32x16 (&acc)[2][2]) {
  float* rowscale = (float*)(smem + GEMM_LDS);
  const int tid = opaque_tid(), lane = tid & 63, w = tid >> 6, wm = w >> 1, wn = w & 1, l31 = lane & 31, hh = lane >> 5;
#pragma unroll
  for (int i = 0; i < 2; ++i)
#pragma unroll
    for (int j = 0; j < 2; ++j) acc[i][j] = fzero();
  int srcoff[4];
#pragma unroll
  for (int j = 0; j < 4; ++j) {
    int row = 32 * w + 8 * j + (lane >> 3);
    srcoff[j] = ((lane & 7) ^ ((row >> 1) & 7)) * 8;
  }
  const int nk = K >> 6;
  auto issue = [&](int kt, int buf) {
    char* sa = smem + buf * 2 * GEMM_STAGE;
    char* sb = sa + GEMM_STAGE;
#pragma unroll
    for (int j = 0; j < 4; ++j) {
      const int ldsoff = (32 * w + 8 * j) * 128 + lane * 16;
      __builtin_amdgcn_global_load_lds((const unsigned*)(a_row[j] + kt * 64 + srcoff[j]), (__attribute__((address_space(3))) unsigned*)(sa + ldsoff), 16, 0, 0);
      __builtin_amdgcn_global_load_lds((const unsigned*)(b_row[j] + kt * 64 + srcoff[j]), (__attribute__((address_space(3))) unsigned*)(sb + ldsoff), 16, 0, 0);
    }
  };
  float ssq[2] = {0.f, 0.f};
  asm volatile("s_waitcnt vmcnt(0)" ::: "memory");
  __syncthreads();
  issue(0, 0);
  if (nk > 1) issue(1, 1);
  for (int kt = 0; kt < nk; ++kt) {
    if (kt + 1 < nk) asm volatile("s_waitcnt vmcnt(8)" ::: "memory");
    else asm volatile("s_waitcnt vmcnt(0)" ::: "memory");
    __builtin_amdgcn_s_barrier();
    const char* sa = smem + (kt & 1) * 2 * GEMM_STAGE;
    const char* sb = sa + GEMM_STAGE;
    bf16x8 af[4][2], bfr[4][2];
#pragma unroll
    for (int ks = 0; ks < 4; ++ks) {
#pragma unroll
      for (int i = 0; i < 2; ++i) {
        int row = wm * 64 + i * 32 + l31;
        af[ks][i] = *(const bf16x8*)(sa + row * 128 + (((ks * 2 + hh) ^ ((row >> 1) & 7)) << 4));
      }
#pragma unroll
      for (int j = 0; j < 2; ++j) {
        int row = wn * 64 + j * 32 + l31;
        bfr[ks][j] = *(const bf16x8*)(sb + row * 128 + (((ks * 2 + hh) ^ ((row >> 1) & 7)) << 4));
      }
    }
    __builtin_amdgcn_s_waitcnt(0xc07f);
    __builtin_amdgcn_s_barrier();
    if (kt + 2 < nk) issue(kt + 2, kt & 1);
#pragma unroll
    for (int ks = 0; ks < 4; ++ks) {
      if (SSQ) {
#pragma unroll
        for (int i = 0; i < 2; ++i)
#pragma unroll
          for (int e = 0; e < 8; ++e) { float x = bf2f((bf16)af[ks][i][e]); ssq[i] += x * x; }
      }
#pragma unroll
      for (int i = 0; i < 2; ++i)
#pragma unroll
        for (int j = 0; j < 2; ++j) acc[i][j] = mfma(af[ks][i], bfr[ks][j], acc[i][j]);
    }
  }
  __syncthreads();
  if (SSQ) {
#pragma unroll
    for (int i = 0; i < 2; ++i) {
      float s = ssq[i] + shx(ssq[i], 32);
      if (hh == 0 && wn == 0) rowscale[wm * 64 + i * 32 + l31] = rsqrtf(s * ssq_div + LN_EPS);
    }
    __syncthreads();
  }
}

DI void inproj_tile(const Params& p, int l, int tm, int tn, char* smem) {
  const int tid = opaque_tid(), lane = tid & 63, w = tid >> 6, wm = w >> 1, wn = w & 1, l31 = lane & 31, hh = lane >> 5;
  const bf16* A = (const bf16*)(p.ws + OFF_Y);
  const bf16* Bt = (const bf16*)(p.ws + OFF_WIN + l * SZ_WIN1);
  const bf16* ap[4]; const bf16* bp[4];
#pragma unroll
  for (int j = 0; j < 4; ++j) {
    int r = 32 * (tid >> 6) + 8 * j + ((tid & 63) >> 3);
    ap[j] = A + (size_t)(tm * 128 + r) * 1024;
    bp[j] = Bt + (size_t)(tn * 128 + r) * 1024;
  }
  f32x16 acc[2][2];
  gemm_core<false>(ap, bp, 1024, smem, 0.f, acc);
  bf16* T = (bf16*)smem;
  float* Gt = (float*)(p.ws + OFF_GATES) + (size_t)tm * 128 * 16;
  const int lrow = wm * 64 + 4 * hh;
  __syncthreads();
#pragma unroll
  for (int j = 0; j < 2; ++j) {
    const int cbase = tn * 128 + wn * 64 + j * 32;
    const int gn = cbase + l31;
    const float bias = gn < 2224 ? p.in[I_BIN][l * 2224 + gn] : 0.f;
    const int toff = lrow * 136 + wn * 64 + j * 32 + l31;
    const int goff = lrow * 16 + l31;
#pragma unroll
    for (int i = 0; i < 2; ++i)
#pragma unroll
      for (int r = 0; r < 16; ++r) {
        const int mo = i * 32 + 8 * (r >> 2) + (r & 3);
        float v = acc[i][j][r] + bias;
        if (cbase < 512) v = gelu_tanh(v);
        T[toff + mo * 136] = f2bf(v);
        if (cbase == 2208 && l31 < 16) Gt[goff + mo * 16] = v;
      }
  }
  __syncthreads();
  {
    bf16* Zt = (bf16*)(p.ws + OFF_Z) + (size_t)tm * 128 * ZS + tn * 128;
    const int cmax = (2208 - tn * 128) >> 3;
#pragma unroll
    for (int i = 0; i < 8; ++i) {
      const int id = tid + 256 * i, row = id >> 4, c = id & 15;
      if (c < cmax) *(u32x4*)(Zt + (size_t)row * ZS + c * 8) = *(const u32x4*)(T + row * 136 + c * 8);
    }
  }
}

DI void uq_tile(const Params& p, int l, int tm, int tn, char* smem) {
  const int tid = opaque_tid(), lane = tid & 63, w = tid >> 6, wm = w >> 1, wn = w & 1, l31 = lane & 31, hh = lane >> 5;
  const bf16* Z = (const bf16*)(p.ws + OFF_Z);
  const bf16* Bt = (const bf16*)(p.ws + OFF_WUQ + l * SZ_WUQ1);
  const bf16* ap[4]; const bf16* bp[4];
#pragma unroll
  for (int j = 0; j < 4; ++j) {
    int r = 32 * (tid >> 6) + 8 * j + ((tid & 63) >> 3);
    ap[j] = Z + (size_t)(tm * 128 + r) * ZS + 512;
    bp[j] = Bt + (size_t)(tn * 128 + r) * 384;
  }
  f32x16 acc[2][2];
  gemm_core<true>(ap, bp, 384, smem, 1.f / 384.f, acc);
  const float* rowscale = (const float*)(smem + GEMM_LDS);
  float2* ropes = (float2*)(smem + GEMM_LDS + 512);
  bf16* T = (bf16*)smem;
  const int tok0 = tm * 128;
  const bool lat = tok0 < NTL;
  const int b = lat ? (tok0 >> 12) : ((tok0 - NTL) >> 8);
  const int pos0 = lat ? (tok0 & 4095) : ((tok0 - NTL) & 255);
  const int qbase = lat ? pos0 : 4096 + pos0;
  const int lrow = wm * 64 + 4 * hh;
  ropes[tid] = ((const float2*)(p.ws + OFF_ROPE))[tid];
  ropes[256 + tid] = ((const float2*)(p.ws + OFF_ROPE))[256 + tid];
  __syncthreads();
#pragma unroll
  for (int j = 0; j < 2; ++j) {
    const int cb = tn * 4 + wn * 2 + j;
    const int seg = cb % 3;
#pragma unroll
    for (int i = 0; i < 2; ++i)
#pragma unroll
      for (int r = 0; r < 16; ++r) {
        const int m = lrow + i * 32 + 8 * (r >> 2) + (r & 3);
        float v = acc[i][j][r] * rowscale[m] * QSCALE;
        if (seg == 2) {
          float pr = shx(v, 8);
          if (lat) {
            const int pos = pos0 + m;
            const int ap2 = (l31 & 16) ? (pos & 63) : (pos >> 6);
            const float2 cs = ropes[ap2 * 8 + (l31 & 7)];
            v = (l31 & 8) ? (v * cs.x + pr * cs.y) : (v * cs.x - pr * cs.y);
          }
        }
        T[m * 136 + wn * 64 + j * 32 + l31] = f2bf(v);
      }
  }
  __syncthreads();
  {
    bf16* Qb = (bf16*)((char*)p.out + OOFF_Q);
#pragma unroll
    for (int i = 0; i < 8; ++i) {
      const int id = tid + 256 * i, row = id >> 4, c = id & 15;
      const int col = tn * 128 + c * 8, hq = col / 96, d = col - hq * 96;
      *(u32x4*)(Qb + ((size_t)(b * 8 + hq) * KTOT + qbase + row) * 96 + d) = *(const u32x4*)(T + row * 136 + c * 8);
    }
  }
}

DI void ukv_tile(const Params& p, int l, int tm, int tn, char* smem) {
  const int tid = opaque_tid(), lane = tid & 63, w = tid >> 6, wm = w >> 1, wn = w & 1, l31 = lane & 31, hh = lane >> 5;
  const bf16* Z = (const bf16*)(p.ws + OFF_Z);
  const bf16* Bt = (const bf16*)(p.ws + OFF_WUKV + l * SZ_WUKV1);
  const bf16* ap[4]; const bf16* bp[4];
#pragma unroll
  for (int j = 0; j < 4; ++j) {
    int r = 32 * (tid >> 6) + 8 * j + ((tid & 63) >> 3);
    ap[j] = Z + (size_t)(tm * 128 + r) * ZS + 896;
    bp[j] = Bt + (size_t)(tn * 128 + r) * 256;
  }
  f32x16 acc[2][2];
  gemm_core<true>(ap, bp, 256, smem, 1.f / 256.f, acc);
  const float* rowscale = (const float*)(smem + GEMM_LDS);
  const int tok0 = tm * 128;
  const bool lat = tok0 < NTL;
  const int b = lat ? (tok0 >> 12) : ((tok0 - NTL) >> 8);
  const int kbase = lat ? (tok0 & 4095) : 4096 + ((tok0 - NTL) & 255);
  const int bh = b * 8 + tn;
  bf16* TK = (bf16*)smem;
  bf16* TV = TK + 128 * 72;
  const int lrow = wm * 64 + 4 * hh;
  __syncthreads();
#pragma unroll
  for (int j = 0; j < 2; ++j)
#pragma unroll
    for (int i = 0; i < 2; ++i)
#pragma unroll
      for (int r = 0; r < 16; ++r) {
        const int m = lrow + i * 32 + 8 * (r >> 2) + (r & 3);
        const bf16 v = f2bf(acc[i][j][r] * rowscale[m]);
        if (wn == 0) TK[m * 72 + j * 32 + l31] = v;
        else TV[(j * 32 + l31) * 136 + m] = v;
      }
  __syncthreads();
  {
    bf16* KNt = (bf16*)(p.ws + OFF_KN) + ((size_t)bh * KTOT + kbase) * 64;
    bf16* VTt = (bf16*)(p.ws + OFF_VT) + (size_t)bh * 64 * KTOT + kbase;
#pragma unroll
    for (int i = 0; i < 4; ++i) {
      const int id = tid + 256 * i;
      { const int row = id >> 3, c = id & 7; *(u32x4*)(KNt + (size_t)row * 64 + c * 8) = *(const u32x4*)(TK + row * 72 + c * 8); }
      { const int dv = id >> 4, c = id & 15; *(u32x4*)(VTt + (size_t)dv * KTOT + c * 8) = *(const u32x4*)(TV + dv * 136 + c * 8); }
    }
  }
}

DI void krope_item(const Params& p, int tm) {
  const int tid = opaque_tid();
  const bf16* Z = (const bf16*)(p.ws + OFF_Z);
  bf16* KR = (bf16*)(p.ws + OFF_KR);
  const float2* rope = (const float2*)(p.ws + OFF_ROPE);
  int tok = tm * 128 + (tid >> 1), half = tid & 1;
  const bool lat = tok < NTL;
  int b = lat ? (tok >> 12) : ((tok - NTL) >> 8);
  int pos = lat ? (tok & 4095) : ((tok - NTL) & 255);
  int kpos = lat ? pos : 4096 + pos;
  const uint4* src = (const uint4*)(Z + (size_t)tok * ZS + 1152 + half * 16);
  uint4 u0 = src[0], u1 = src[1];
  float z[16];
  z[0] = bflo(u0.x); z[1] = bfhi(u0.x); z[2] = bflo(u0.y); z[3] = bfhi(u0.y);
  z[4] = bflo(u0.z); z[5] = bfhi(u0.z); z[6] = bflo(u0.w); z[7] = bfhi(u0.w);
  z[8] = bflo(u1.x); z[9] = bfhi(u1.x); z[10] = bflo(u1.y); z[11] = bfhi(u1.y);
  z[12] = bflo(u1.z); z[13] = bfhi(u1.z); z[14] = bflo(u1.w); z[15] = bfhi(u1.w);
  float o[16];
  if (lat) {
    int ap2 = half ? (pos & 63) : (pos >> 6);
#pragma unroll
    for (int jj = 0; jj < 8; ++jj) {
      float2 cs = rope[ap2 * 8 + jj];
      o[jj] = z[jj] * cs.x - z[8 + jj] * cs.y;
      o[8 + jj] = z[8 + jj] * cs.x + z[jj] * cs.y;
    }
  } else {
#pragma unroll
    for (int jj = 0; jj < 16; ++jj) o[jj] = z[jj];
  }
  uint4 w0, w1;
  w0.x = pack2(o[0], o[1]); w0.y = pack2(o[2], o[3]); w0.z = pack2(o[4], o[5]); w0.w = pack2(o[6], o[7]);
  w1.x = pack2(o[8], o[9]); w1.y = pack2(o[10], o[11]); w1.z = pack2(o[12], o[13]); w1.w = pack2(o[14], o[15]);
  uint4* dst = (uint4*)(KR + ((size_t)b * KTOT + kpos) * 32 + half * 16);
  dst[0] = w0; dst[1] = w1;
}

DI void gmlp_item(const Params& p, int l, int c, char* smem) {
  const int tid = opaque_tid(), lane = tid & 63, w = tid >> 6, l31 = lane & 31, hh = lane >> 5;
  bf16* vT = (bf16*)smem;
  float* st = (float*)(smem + 128 * 136 * 2);
  float* lng = st + 256;
  float* lnb = lng + 256;
  float* sgbs = lnb + 256;
  const bf16* Z = (const bf16*)(p.ws + OFF_Z);
  bf16* Y = (bf16*)(p.ws + OFF_Y);
  const bf16* SGW = (const bf16*)(p.ws + OFF_SGW + l * SZ_SGW1);
  const int tok0 = c * 128;
  __syncthreads();
  lng[tid] = p.in[I_SGLNG][l * 256 + tid]; lnb[tid] = p.in[I_SGLNB][l * 256 + tid];
  sgbs[tid] = p.in[I_SGB][l * 512 + tid]; sgbs[256 + tid] = p.in[I_SGB][l * 512 + 256 + tid];
  {
    int t = tid >> 1, half = tid & 1;
    const uint4* src = (const uint4*)(Z + (size_t)(tok0 + t) * ZS + 256 + half * 128);
    float s = 0.f, q = 0.f;
#pragma unroll 4
    for (int i = 0; i < 16; ++i) {
      uint4 u = src[i];
      float a0 = bflo(u.x), a1 = bfhi(u.x), a2 = bflo(u.y), a3 = bfhi(u.y), a4 = bflo(u.z), a5 = bfhi(u.z), a6 = bflo(u.w), a7 = bfhi(u.w);
      s += a0 + a1 + a2 + a3 + a4 + a5 + a6 + a7;
      q += a0 * a0 + a1 * a1 + a2 * a2 + a3 * a3 + a4 * a4 + a5 * a5 + a6 * a6 + a7 * a7;
    }
    s += shx(s, 1); q += shx(q, 1);
    float mean = s * (1.f / 256.f);
    float var = fmaxf(q * (1.f / 256.f) - mean * mean, 0.f);
    if (half == 0) { st[2 * t] = mean; st[2 * t + 1] = rsqrtf(var + LN_EPS); }
  }
  for (int rd = 0; rd < 2; ++rd) {
    __syncthreads();
#pragma unroll 2
    for (int i = 0; i < 8; ++i) {
      int id = tid + 256 * i;
      int t = id & 127, cc = id >> 7;
      int ch0 = rd * 128 + cc * 8;
      uint4 u = *(const uint4*)(Z + (size_t)(tok0 + t) * ZS + 256 + ch0);
      float mean = st[2 * t], rstd = st[2 * t + 1];
      float a[8] = {bflo(u.x), bfhi(u.x), bflo(u.y), bfhi(u.y), bflo(u.z), bfhi(u.z), bflo(u.w), bfhi(u.w)};
#pragma unroll
      for (int e = 0; e < 8; ++e) {
        float g = lng[ch0 + e], bb = lnb[ch0 + e];
        vT[(cc * 8 + e) * 136 + t] = f2bf((a[e] - mean) * rstd * g + bb);
      }
    }
    __syncthreads();
    const int g = 2 * rd + (w >> 1), tb2 = w & 1;
    f32x16 acc[2][2];
#pragma unroll
    for (int i = 0; i < 2; ++i)
#pragma unroll
      for (int j = 0; j < 2; ++j) acc[i][j] = fzero();
#pragma unroll 2
    for (int ks = 0; ks < 8; ++ks) {
      bf16x8 af[2], bfr[2];
#pragma unroll
      for (int i = 0; i < 2; ++i) af[i] = *(const bf16x8*)(SGW + ((size_t)g * 128 + tb2 * 64 + i * 32 + l31) * 128 + ks * 16 + hh * 8);
#pragma unroll
      for (int j = 0; j < 2; ++j) bfr[j] = *(const bf16x8*)&vT[((w >> 1) * 64 + j * 32 + l31) * 136 + ks * 16 + hh * 8];
#pragma unroll
      for (int i = 0; i < 2; ++i)
#pragma unroll
        for (int j = 0; j < 2; ++j) acc[i][j] = mfma(af[i], bfr[j], acc[i][j]);
    }
    __syncthreads();
    {
      const float* sgb = sgbs + g * 128;
      const int lrow = tb2 * 64 + 4 * hh;
#pragma unroll
      for (int i = 0; i < 2; ++i)
#pragma unroll
        for (int j = 0; j < 2; ++j) {
          const int to = lrow * 136 + (w >> 1) * 64 + j * 32 + l31;
#pragma unroll
          for (int r = 0; r < 16; ++r) {
            const int mo = i * 32 + 8 * (r >> 2) + (r & 3);
            vT[to + mo * 136] = f2bf(acc[i][j][r] + sgb[lrow + mo]);
          }
        }
    }
    __syncthreads();
#pragma unroll 2
    for (int i = 0; i < 8; ++i) {
      const int id = tid + 256 * i, row = id >> 4, cc = id & 15;
      const u32x4 uu = *(const u32x4*)(Z + (size_t)(tok0 + row) * ZS + rd * 128 + cc * 8);
      const u32x4 mm = *(const u32x4*)(vT + row * 136 + cc * 8);
      u32x4 o;
      o.x = pack2(bflo(uu.x) * bflo(mm.x), bfhi(uu.x) * bfhi(mm.x));
      o.y = pack2(bflo(uu.y) * bflo(mm.y), bfhi(uu.y) * bfhi(mm.y));
      o.z = pack2(bflo(uu.z) * bflo(mm.z), bfhi(uu.z) * bfhi(mm.z));
      o.w = pack2(bflo(uu.w) * bflo(mm.w), bfhi(uu.w) * bfhi(mm.w));
      *(u32x4*)(Y + (size_t)(tok0 + row) * 1024 + rd * 128 + cc * 8) = o;
    }
  }
}

DI float conv_silu(const Params& p, int l, const bf16* Z, int seq0, int slen, int pos, int zcol, int ch) {
  float a = p.in[I_CONVB][l * 512 + ch];
#pragma unroll
  for (int tap = 0; tap < 5; ++tap) {
    int pp = pos + tap - 2;
    if (pp >= 0 && pp < slen) a += p.in[I_CONVW][(l * 5 + tap) * 512 + ch] * bf2f(Z[(size_t)(seq0 + pp) * ZS + zcol]);
  }
  return silu_f(a);
}
DI void conv16(const Params& p, int l, const bf16* Zcol, int slen, int pos_start, int ch, float (&out)[16]) {
  float wgt[5];
#pragma unroll
  for (int tap = 0; tap < 5; ++tap) wgt[tap] = p.in[I_CONVW][(l * 5 + tap) * 512 + ch];
  const float bias = p.in[I_CONVB][l * 512 + ch];
  float x[20];
#pragma unroll
  for (int i = 0; i < 20; ++i) {
    int pp = pos_start - 2 + i;
    x[i] = (pp >= 0 && pp < slen) ? bf2f(Zcol[(size_t)pp * ZS]) : 0.f;
  }
#pragma unroll
  for (int i = 0; i < 16; ++i) {
    float a = bias;
#pragma unroll
    for (int tap = 0; tap < 5; ++tap) a += wgt[tap] * x[i + tap];
    out[i] = silu_f(a);
  }
}
DI void stage_rows68(const bf16* Zseq  , int slen, int pos_start, bf16* raw) {
  const int tid = opaque_tid();
#pragma unroll
  for (int i = 0; i < 3; ++i) {
    const int id = tid + 256 * i;
    if (id < 68 * 8) {
      const int row = id >> 3, c = id & 7, pp = pos_start - 2 + row;
      u32x4 u = {0u, 0u, 0u, 0u};
      if (pp >= 0 && pp < slen) u = *(const u32x4*)(Zseq + (size_t)pp * ZS + c * 8);
      *(u32x4*)(raw + row * 64 + c * 8) = u;
    }
  }
}
DI void conv16_lds(const Params& p, int l, const bf16* rawcol  , int row0, int ch, float (&out)[16]) {
  float wgt[5];
#pragma unroll
  for (int tap = 0; tap < 5; ++tap) wgt[tap] = p.in[I_CONVW][(l * 5 + tap) * 512 + ch];
  const float bias = p.in[I_CONVB][l * 512 + ch];
  float x[20];
#pragma unroll
  for (int i = 0; i < 20; ++i) x[i] = bf2f(rawcol[(row0 + i) * 64]);
#pragma unroll
  for (int i = 0; i < 16; ++i) {
    float a = bias;
#pragma unroll
    for (int tap = 0; tap < 5; ++tap) a += wgt[tap] * x[i + tap];
    out[i] = silu_f(a);
  }
}
DI float log_sigmoid_f(float x) { return fminf(x, 0.f) - __logf(1.f + __expf(-fabsf(x))); }

DI void ml1_item(const Params& p, int l, int b, int h, int c, char* smem) {
  const int tid = opaque_tid(), lane = tid & 63, w = tid >> 6, l31 = lane & 31, hh = lane >> 5;
  bf16* kT = (bf16*)smem;
  bf16* wvT = kT + 64 * 72;
  float* lf = (float*)(wvT + 2 * 64 * 72);
  float* li = lf + 128;
  float* wv = li + 128;
  float* misc = wv + 128;
  bf16* kraw = (bf16*)(misc + 4);
  bf16* vraw = kraw + 68 * 64;
  const bf16* Z = (const bf16*)(p.ws + OFF_Z);
  const float* G = (const float*)(p.ws + OFF_GATES);
  int seq0, slen, pos0;
  if (c < 64) { seq0 = b * 4096; slen = 4096; pos0 = c * 64; } else { seq0 = NTL + b * 256; slen = 256; pos0 = (c - 64) * 64; }
  const int bh = b * 4 + h;
  __syncthreads();
  if (tid < 128) {
    int dir = tid >> 6, s = tid & 63;
    const float* g = G + (size_t)(seq0 + pos0 + s) * 16 + dir * 8 + h;
    li[tid] = g[0];
    lf[tid] = log_sigmoid_f(g[4] + p.in[I_FBIAS][l * 8 + dir * 4 + h]);
  }
  stage_rows68(Z + (size_t)seq0 * ZS + 1440 + h * 64, slen, pos0, kraw);
#pragma unroll
  for (int i = 0; i < 2; ++i) {
    const int id = tid + 256 * i, row = id >> 3, cc = id & 7;
    *(u32x4*)(vraw + row * 64 + cc * 8) = *(const u32x4*)(Z + (size_t)(seq0 + pos0 + row) * ZS + 1696 + h * 64 + cc * 8);
  }
  __syncthreads();
  {
    const int j = tid & 63, sg = tid >> 6;
    float kk[16];
    conv16_lds(p, l, kraw + j, sg * 16, 256 + h * 64 + j, kk);
#pragma unroll
    for (int i = 0; i < 16; i += 2) *(unsigned*)&kT[j * 72 + sg * 16 + i] = pack2(kk[i] * 0.125f, kk[i + 1] * 0.125f);
  }
  __syncthreads();
  if (w < 2) {
    const int dir = w, sidx = dir ? 63 - lane : lane;
    float cum = wave_scan_add(lf[dir * 64 + sidx]);
    float bend = __int_as_float(__builtin_amdgcn_readlane(__float_as_int(cum), 63));
    float g = bend - cum + li[dir * 64 + sidx];
    float mloc = wave_max(g);
    wv[dir * 64 + sidx] = __expf(g - mloc);
    if (lane == 0) { misc[dir * 2] = mloc; misc[dir * 2 + 1] = bend; }
  }
  __syncthreads();
  for (int e = tid; e < 4096; e += NTHR) {
    int s = e >> 6, i = e & 63;
    float v = bf2f(vraw[s * 64 + i]);
    wvT[i * 72 + s] = f2bf(v * wv[s]);
    wvT[(64 + i) * 72 + s] = f2bf(v * wv[64 + s]);
  }
  __syncthreads();
  float* SC = (float*)((char*)p.out + OOFF_SC);
  float* SN = (float*)((char*)p.out + OOFF_SN);
  float* SM = (float*)(p.ws + OFF_SM);
  {
    const int dir = w >> 1, ib = w & 1;
    f32x16 acc[2]; acc[0] = fzero(); acc[1] = fzero();
#pragma unroll
    for (int ks = 0; ks < 4; ++ks) {
      bf16x8 a = *(const bf16x8*)&wvT[(dir * 64 + ib * 32 + l31) * 72 + ks * 16 + hh * 8];
#pragma unroll
      for (int jb = 0; jb < 2; ++jb) {
        bf16x8 bb = *(const bf16x8*)&kT[(jb * 32 + l31) * 72 + ks * 16 + hh * 8];
        acc[jb] = mfma(a, bb, acc[jb]);
      }
    }
    float* dst = SC + ((size_t)(bh * 2 + dir) * 68 + c) * 4096;
#pragma unroll
    for (int jb = 0; jb < 2; ++jb)
#pragma unroll
      for (int r = 0; r < 16; ++r) dst[(ib * 32 + crow(r, hh)) * 64 + jb * 32 + l31] = acc[jb][r];
  }
  if (tid < 128) {
    int dir = tid >> 6, j = tid & 63;
    float a = 0.f;
    for (int s = 0; s < 64; ++s) a += wv[dir * 64 + s] * bf2f(kT[j * 72 + s]);
    SN[((size_t)(bh * 2 + dir) * 68 + c) * 64 + j] = a;
  }
  if (tid == 0 || tid == 64) {
    int dir = tid >> 6;
    float* sm = SM + ((size_t)(bh * 2 + dir) * 68 + c) * 4;
    sm[0] = misc[dir * 2]; sm[1] = misc[dir * 2 + 1];
  }
}

DI void ml2_item(const Params& p, int it, char* smem) {
  const int tid = opaque_tid();
  const int eb = it & 3, bd = it >> 2;
  const int dir = bd & 1;
  float* aa = (float*)smem;
  float* ss = aa + 68;
  float* SC = (float*)((char*)p.out + OOFF_SC) + (size_t)bd * 68 * 4096;
  float* SN = (float*)((char*)p.out + OOFF_SN) + (size_t)bd * 68 * 64;
  float* SM = (float*)(p.ws + OFF_SM) + (size_t)bd * 68 * 4;
  float* mls = ss + 68;
  float* bes = mls + 68;
  float* m0s = bes + 68;
  __syncthreads();
  if (tid < 68) { mls[tid] = SM[tid * 4]; bes[tid] = SM[tid * 4 + 1]; }
  __syncthreads();
  if (tid == 0) {
    float m = 0.f;
    for (int n = 0; n < 68; ++n) {
      int c = (n < 4) ? (dir ? 67 - n : 64 + n) : (dir ? 67 - n : n - 4);
      float ml = mls[c], be = bes[c];
      float mn = fmaxf(be + m, ml);
      aa[n] = __expf(be + m - mn);
      ss[n] = __expf(ml - mn);
      m0s[c] = m;
      m = mn;
    }
  }
  __syncthreads();
  if (eb == 0 && tid < 68) SM[tid * 4 + 2] = m0s[tid];
  {
    typedef __attribute__((ext_vector_type(4))) float f32x4v;
    const int e = (eb * 256 + tid) * 4;
    f32x4v C = {0.f, 0.f, 0.f, 0.f};
#pragma unroll 1
    for (int n0 = 0; n0 < 68; n0 += 17) {
      f32x4v cl[17];
#pragma unroll
      for (int u = 0; u < 17; ++u) {
        const int n = n0 + u;
        const int c = (n < 4) ? (dir ? 67 - n : 64 + n) : (dir ? 67 - n : n - 4);
        cl[u] = *(const f32x4v*)(SC + (size_t)c * 4096 + e);
      }
#pragma unroll
      for (int u = 0; u < 17; ++u) {
        const int n = n0 + u;
        const int c = (n < 4) ? (dir ? 67 - n : 64 + n) : (dir ? 67 - n : n - 4);
        *(f32x4v*)(SC + (size_t)c * 4096 + e) = C;
        C = aa[n] * C + ss[n] * cl[u];
      }
    }
  }
  if (eb == 0 && tid < 64) {
    float cl[68];
#pragma unroll
    for (int n = 0; n < 68; ++n) {
      const int c = (n < 4) ? (dir ? 67 - n : 64 + n) : (dir ? 67 - n : n - 4);
      cl[n] = SN[c * 64 + tid];
    }
    float C = 0.f;
#pragma unroll
    for (int n = 0; n < 68; ++n) {
      const int c = (n < 4) ? (dir ? 67 - n : 64 + n) : (dir ? 67 - n : n - 4);
      SN[c * 64 + tid] = C;
      C = aa[n] * C + ss[n] * cl[n];
    }
  }
}

DI void ml3_item(const Params& p, int l, int b, int h, int c, char* smem) {
  const int tid = opaque_tid(), lane = tid & 63, w = tid >> 6, l31 = lane & 31, hh = lane >> 5;
  bf16* qs = (bf16*)smem;
  bf16* ks_ = qs + 64 * 72;
  bf16* vT = ks_ + 64 * 72;
  float* hbuf = (float*)(vT + 64 * 72);
  float* lf = hbuf + 64 * 65;
  float* li = lf + 128;
  float* bc = li + 128;
  float* cv = bc + 128;
  float* mt = cv + 128;
  float* n0s = mt + 128;
  float* m0s = n0s + 128;
  bf16* qraw = (bf16*)(m0s + 4);
  bf16* kraw = qraw + 68 * 64;
  const bf16* Z = (const bf16*)(p.ws + OFF_Z);
  const float* G = (const float*)(p.ws + OFF_GATES);
  bf16* Y = (bf16*)(p.ws + OFF_Y);
  int seq0, slen, pos0;
  if (c < 64) { seq0 = b * 4096; slen = 4096; pos0 = c * 64; } else { seq0 = NTL + b * 256; slen = 256; pos0 = (c - 64) * 64; }
  const int bh = b * 4 + h;
  const float* SC = (const float*)((char*)p.out + OOFF_SC);
  const float* SN = (const float*)((char*)p.out + OOFF_SN);
  const float* SM = (const float*)(p.ws + OFF_SM);
  __syncthreads();
  if (tid < 128) {
    int dir = tid >> 6, s = tid & 63;
    const float* g = G + (size_t)(seq0 + pos0 + s) * 16 + dir * 8 + h;
    li[tid] = g[0];
    lf[tid] = log_sigmoid_f(g[4] + p.in[I_FBIAS][l * 8 + dir * 4 + h]);
    n0s[tid] = SN[((size_t)(bh * 2 + dir) * 68 + c) * 64 + s];
  }
  if (tid < 2) m0s[tid] = SM[((size_t)(bh * 2 + tid) * 68 + c) * 4 + 2];
  stage_rows68(Z + (size_t)seq0 * ZS + 1184 + h * 64, slen, pos0, qraw);
  stage_rows68(Z + (size_t)seq0 * ZS + 1440 + h * 64, slen, pos0, kraw);
#pragma unroll
  for (int i = 0; i < 2; ++i) {
    const int id = tid + 256 * i, row = id >> 3, cc = id & 7;
    u32x4 u = *(const u32x4*)(Z + (size_t)(seq0 + pos0 + row) * ZS + 1696 + h * 64 + cc * 8);
    bf16* d = vT + (cc * 8) * 72 + row;
    d[0 * 72] = (bf16)(u.x & 0xffffu); d[1 * 72] = (bf16)(u.x >> 16);
    d[2 * 72] = (bf16)(u.y & 0xffffu); d[3 * 72] = (bf16)(u.y >> 16);
    d[4 * 72] = (bf16)(u.z & 0xffffu); d[5 * 72] = (bf16)(u.z >> 16);
    d[6 * 72] = (bf16)(u.w & 0xffffu); d[7 * 72] = (bf16)(u.w >> 16);
  }
  __syncthreads();
  {
    const int j = tid & 63, sg = tid >> 6;
    float qq[16], kk[16];
    conv16_lds(p, l, qraw + j, sg * 16, h * 64 + j, qq);
    conv16_lds(p, l, kraw + j, sg * 16, 256 + h * 64 + j, kk);
#pragma unroll
    for (int i = 0; i < 16; ++i) {
      qs[(sg * 16 + i) * 72 + j] = f2bf(qq[i]);
      ks_[(sg * 16 + i) * 72 + j] = f2bf(kk[i] * 0.125f);
    }
  }
  __syncthreads();
  if (w < 2) {
    const int dr = w, sidx = dr ? 63 - lane : lane;
    float cum = wave_scan_add(lf[dr * 64 + sidx]);
    float x = li[dr * 64 + sidx] - cum;
    float pm = wave_scan_max(x);
    bc[dr * 64 + sidx] = cum; cv[dr * 64 + sidx] = x;
    mt[dr * 64 + sidx] = fmaxf(cum + m0s[dr], cum + pm);
  }
  __syncthreads();
  const int dir = w >> 1, tb = w & 1;
  const int t = tb * 32 + l31;
  bf16x8 qf[4];
#pragma unroll
  for (int ks = 0; ks < 4; ++ks) qf[ks] = *(const bf16x8*)&qs[t * 72 + ks * 16 + hh * 8];
  f32x16 sacc[2]; sacc[0] = fzero(); sacc[1] = fzero();
#pragma unroll
  for (int sb = 0; sb < 2; ++sb)
#pragma unroll
    for (int ks = 0; ks < 4; ++ks) {
      bf16x8 a = *(const bf16x8*)&ks_[(sb * 32 + l31) * 72 + ks * 16 + hh * 8];
      sacc[sb] = mfma(a, qf[ks], sacc[sb]);
    }
  const float bt = bc[dir * 64 + t], mtt = mt[dir * 64 + t], m0d = m0s[dir];
  const float base = bt - mtt;
  float psum = 0.f;
#pragma unroll
  for (int sb = 0; sb < 2; ++sb)
#pragma unroll
    for (int r = 0; r < 16; ++r) {
      int s = sb * 32 + crow(r, hh);
      bool valid = dir ? (s >= t) : (s <= t);
      float pv = valid ? __expf(base + cv[dir * 64 + s]) * sacc[sb][r] : 0.f;
      psum += pv;
      sacc[sb][r] = pv;
    }
  psum += shx(psum, 32);
  f32x16 num1[2], num2[2];
  num1[0] = fzero(); num1[1] = fzero(); num2[0] = fzero(); num2[1] = fzero();
#pragma unroll
  for (int slab = 0; slab < 4; ++slab) {
    const int sb = slab >> 1, s2 = slab & 1;
    uint4 pu;
    pu.x = pack2(sacc[sb][8 * s2 + 0], sacc[sb][8 * s2 + 1]);
    pu.y = pack2(sacc[sb][8 * s2 + 2], sacc[sb][8 * s2 + 3]);
    pu.z = pack2(sacc[sb][8 * s2 + 4], sacc[sb][8 * s2 + 5]);
    pu.w = pack2(sacc[sb][8 * s2 + 6], sacc[sb][8 * s2 + 7]);
    bf16x8 pf = __builtin_bit_cast(bf16x8, pu);
#pragma unroll
    for (int ib = 0; ib < 2; ++ib) {
      uint2 lo = *(const uint2*)&vT[(ib * 32 + l31) * 72 + slab * 16 + 4 * hh];
      uint2 hi = *(const uint2*)&vT[(ib * 32 + l31) * 72 + slab * 16 + 8 + 4 * hh];
      uint4 au; au.x = lo.x; au.y = lo.y; au.z = hi.x; au.w = hi.y;
      num2[ib] = mfma(__builtin_bit_cast(bf16x8, au), pf, num2[ib]);
    }
  }
  {
    const float* C0 = SC + ((size_t)(bh * 2 + dir) * 68 + c) * 4096;
#pragma unroll
    for (int ib = 0; ib < 2; ++ib)
#pragma unroll
      for (int ks = 0; ks < 4; ++ks) {
        const float4* src = (const float4*)(C0 + (ib * 32 + l31) * 64 + ks * 16 + hh * 8);
        float4 f0 = src[0], f1 = src[1];
        uint4 au; au.x = pack2(f0.x, f0.y); au.y = pack2(f0.z, f0.w); au.z = pack2(f1.x, f1.y); au.w = pack2(f1.z, f1.w);
        num1[ib] = mfma(__builtin_bit_cast(bf16x8, au), qf[ks], num1[ib]);
      }
  }
  float nq = 0.f;
#pragma unroll
  for (int ks = 0; ks < 4; ++ks)
#pragma unroll
    for (int e = 0; e < 8; ++e) nq += bf2f((bf16)qf[ks][e]) * n0s[dir * 64 + ks * 16 + hh * 8 + e];
  nq += shx(nq, 32);
  const float inter = __expf(bt + m0d - mtt);
  const float den = inter * nq + psum;
  const float inv = 1.f / fmaxf(fabsf(den), __expf(-mtt));
#pragma unroll
  for (int ib = 0; ib < 2; ++ib)
#pragma unroll
    for (int r = 0; r < 16; ++r) num2[ib][r] = (inter * num1[ib][r] + num2[ib][r]) * inv;
  if (dir == 1) {
#pragma unroll
    for (int ib = 0; ib < 2; ++ib)
#pragma unroll
      for (int r = 0; r < 16; ++r) hbuf[t * 65 + ib * 32 + crow(r, hh)] = num2[ib][r];
  }
  __syncthreads();
  if (dir == 0) {
    float s = 0.f;
#pragma unroll
    for (int ib = 0; ib < 2; ++ib)
#pragma unroll
      for (int r = 0; r < 16; ++r) { num2[ib][r] += hbuf[t * 65 + ib * 32 + crow(r, hh)]; s += num2[ib][r]; }
    s += shx(s, 32);
    float mean = s * (1.f / 64.f);
    float q = 0.f;
#pragma unroll
    for (int ib = 0; ib < 2; ++ib)
#pragma unroll
      for (int r = 0; r < 16; ++r) { num2[ib][r] -= mean; q += num2[ib][r] * num2[ib][r]; }
    q += shx(q, 32);
    float rstd = rsqrtf(q * (1.f / 64.f) + LN_EPS);
    const int tok = seq0 + pos0 + t;
#pragma unroll
    for (int ib = 0; ib < 2; ++ib)
#pragma unroll
      for (int rg = 0; rg < 4; ++rg) {
        int i0 = ib * 32 + 8 * rg + 4 * hh;
        uint2 ou = *(const uint2*)&Z[(size_t)tok * ZS + 1952 + h * 64 + i0];
        float og[4] = {bflo(ou.x), bfhi(ou.x), bflo(ou.y), bfhi(ou.y)};
        float y[4];
#pragma unroll
        for (int e = 0; e < 4; ++e) y[e] = num2[ib][4 * rg + e] * rstd * p.in[I_MLNG][l * 256 + h * 64 + i0 + e] * sigmoid_f(og[e]);
        uint2 o; o.x = pack2(y[0], y[1]); o.y = pack2(y[2], y[3]);
        *(uint2*)&Y[(size_t)tok * 1024 + 768 + h * 64 + i0] = o;
      }
  }
}

DI void attn_item(const Params& p, int b, int h, int q0, int key0, int nkt, int tok0, char* smem) {
  const int tid = opaque_tid(), lane = tid & 63, w = tid >> 6, l31 = lane & 31, hh = lane >> 5;
  bf16* Ks = (bf16*)smem;
  bf16* Vs = Ks + 64 * 104;
  bf16* Qs = Vs + 64 * 72;
  const bf16* Q = (const bf16*)((const char*)p.out + OOFF_Q);
  const bf16* KN = (const bf16*)(p.ws + OFF_KN);
  const bf16* VT = (const bf16*)(p.ws + OFF_VT);
  const bf16* KR = (const bf16*)(p.ws + OFF_KR);
  bf16* Y = (bf16*)(p.ws + OFF_Y);
  const int bh = b * 8 + h;
  __syncthreads();
  {
    const bf16* qsrc = Q + ((size_t)bh * KTOT + q0) * 96;
#pragma unroll 4
    for (int i = 0; i < 12; ++i) {
      const int id = tid + 256 * i, row = id / 12, c = id - row * 12;
      *(u32x4*)&Qs[row * 104 + c * 8] = *(const u32x4*)(qsrc + (size_t)row * 96 + c * 8);
    }
  }
  f32x16 o[2][2];
#pragma unroll
  for (int qb = 0; qb < 2; ++qb) { o[qb][0] = fzero(); o[qb][1] = fzero(); }
  float mrun[2] = {-INFINITY, -INFINITY}, lrun[2] = {0.f, 0.f};
  u32x4 pkA[2], pvA[2], prA, pkB[2], pvB[2], prB;
  const bf16* knp[2]; const bf16* vtp[2];
#pragma unroll
  for (int i = 0; i < 2; ++i) {
    int id = tid + 256 * i, row = id >> 3, ch = id & 7;
    knp[i] = KN + ((size_t)bh * KTOT + key0 + row) * 64 + ch * 8;
    vtp[i] = VT + ((size_t)bh * 64 + row) * KTOT + key0 + ch * 8;
  }
  const bf16* krp = KR + ((size_t)b * KTOT + key0 + (tid >> 2)) * 32 + (tid & 3) * 8;
#pragma unroll
  for (int i = 0; i < 2; ++i) { pkA[i] = *(const u32x4*)knp[i]; pvA[i] = *(const u32x4*)vtp[i]; }
  prA = *(const u32x4*)krp;
#pragma unroll
  for (int i = 0; i < 2; ++i) { pkB[i] = *(const u32x4*)(knp[i] + 64 * 64); pvB[i] = *(const u32x4*)(vtp[i] + 64); }
  prB = *(const u32x4*)(krp + 64 * 32);
  auto tstep = [&](u32x4 (&pk)[2], u32x4 (&pv)[2], u32x4& pr, int knext) {
    __syncthreads();
#pragma unroll
    for (int i = 0; i < 2; ++i) {
      int id = tid + 256 * i, row = id >> 3, ch = id & 7;
      *(u32x4*)&Ks[row * 104 + ch * 8] = pk[i];
      *(u32x4*)&Vs[row * 72 + ch * 8] = pv[i];
    }
    *(u32x4*)&Ks[(tid >> 2) * 104 + 64 + (tid & 3) * 8] = pr;
    __syncthreads();
    if (knext < nkt) {
#pragma unroll
      for (int i = 0; i < 2; ++i) {
        pk[i] = *(const u32x4*)(knp[i] + (size_t)knext * 64 * 64);
        pv[i] = *(const u32x4*)(vtp[i] + knext * 64);
      }
      pr = *(const u32x4*)(krp + (size_t)knext * 64 * 32);
    }
#pragma unroll
    for (int qb = 0; qb < 2; ++qb) {
      bf16x8 qf[6];
#pragma unroll
      for (int ks = 0; ks < 6; ++ks) qf[ks] = *(const bf16x8*)&Qs[(w * 64 + qb * 32 + l31) * 104 + ks * 16 + hh * 8];
      const float mref0 = mrun[qb] == -INFINITY ? 0.f : mrun[qb];
      f32x16 s[2];
#pragma unroll
      for (int r = 0; r < 16; ++r) { s[0][r] = -mref0; s[1][r] = -mref0; }
#pragma unroll
      for (int kb = 0; kb < 2; ++kb)
#pragma unroll
        for (int ks = 0; ks < 6; ++ks) {
          bf16x8 a = *(const bf16x8*)&Ks[(kb * 32 + l31) * 104 + ks * 16 + hh * 8];
          s[kb] = mfma(a, qf[ks], s[kb]);
        }
      float mx = fmaxf(s[0][0], s[1][0]);
#pragma unroll
      for (int r = 1; r < 16; ++r) mx = fmaxf(fmaxf(mx, s[0][r]), s[1][r]);
      mx = fmaxf(mx, shx(mx, 32));
      if (__builtin_amdgcn_ballot_w64(mrun[qb] == -INFINITY || mx > 8.f) != 0ull) {
        const float d = fmaxf(mx, 0.f);
        const float mnew = (mrun[qb] == -INFINITY) ? mx : mref0 + d;
        const float shift = mnew - mref0;
        const float alpha = (mrun[qb] == -INFINITY) ? 0.f : __builtin_amdgcn_exp2f(-shift);
        mrun[qb] = mnew;
        lrun[qb] *= alpha;
#pragma unroll
        for (int db = 0; db < 2; ++db)
#pragma unroll
          for (int r = 0; r < 16; ++r) o[qb][db][r] *= alpha;
#pragma unroll
        for (int kb = 0; kb < 2; ++kb)
#pragma unroll
          for (int r = 0; r < 16; ++r) s[kb][r] -= shift;
      }
      float rs = 0.f;
#pragma unroll
      for (int kb = 0; kb < 2; ++kb)
#pragma unroll
        for (int r = 0; r < 16; ++r) { float e = __builtin_amdgcn_exp2f(s[kb][r]); s[kb][r] = e; rs += e; }
      lrun[qb] += rs;
#pragma unroll
      for (int slab = 0; slab < 4; ++slab) {
        const int kb = slab >> 1, s2 = slab & 1;
        uint4 pu;
        pu.x = pack2(s[kb][8 * s2 + 0], s[kb][8 * s2 + 1]);
        pu.y = pack2(s[kb][8 * s2 + 2], s[kb][8 * s2 + 3]);
        pu.z = pack2(s[kb][8 * s2 + 4], s[kb][8 * s2 + 5]);
        pu.w = pack2(s[kb][8 * s2 + 6], s[kb][8 * s2 + 7]);
        bf16x8 pf = __builtin_bit_cast(bf16x8, pu);
#pragma unroll
        for (int db = 0; db < 2; ++db) {
          uint2 lo = *(const uint2*)&Vs[(db * 32 + l31) * 72 + slab * 16 + 4 * hh];
          uint2 hi = *(const uint2*)&Vs[(db * 32 + l31) * 72 + slab * 16 + 8 + 4 * hh];
          uint4 au; au.x = lo.x; au.y = lo.y; au.z = hi.x; au.w = hi.y;
          o[qb][db] = mfma(__builtin_bit_cast(bf16x8, au), pf, o[qb][db]);
        }
      }
    }
  };
  for (int kt = 0; kt < nkt; kt += 2) {
    tstep(pkA, pvA, prA, kt + 2);
    tstep(pkB, pvB, prB, kt + 3);
  }
#pragma unroll
  for (int qb = 0; qb < 2; ++qb) {
    const float lsum = lrun[qb] + shx(lrun[qb], 32);
    const float inv = 1.f / lsum;
    const int tok = tok0 + w * 64 + qb * 32 + l31;
#pragma unroll
    for (int db = 0; db < 2; ++db)
#pragma unroll
      for (int rg = 0; rg < 4; ++rg) {
        int dv = db * 32 + 8 * rg + 4 * hh;
        uint2 ou;
        ou.x = pack2(o[qb][db][4 * rg] * inv, o[qb][db][4 * rg + 1] * inv);
        ou.y = pack2(o[qb][db][4 * rg + 2] * inv, o[qb][db][4 * rg + 3] * inv);
        *(uint2*)&Y[(size_t)tok * 1024 + 256 + h * 64 + dv] = ou;
      }
  }
}

DI void outproj_tile(const Params& p, int l, int tm, int tn, char* smem, float* R, const float* XL, const float* XC) {
  const int tid = opaque_tid(), lane = tid & 63, w = tid >> 6, wm = w >> 1, wn = w & 1, l31 = lane & 31, hh = lane >> 5;
  const bf16* A = (const bf16*)(p.ws + OFF_Y);
  const bf16* Bt = (const bf16*)(p.ws + OFF_WOUT + l * SZ_WOUT1);
  const bf16* ap[4]; const bf16* bp[4];
#pragma unroll
  for (int j = 0; j < 4; ++j) {
    int r = 32 * (tid >> 6) + 8 * j + ((tid & 63) >> 3);
    ap[j] = A + (size_t)(tm * 128 + r) * 1024;
    bp[j] = Bt + (size_t)(tn * 128 + r) * 1024;
  }
  f32x16 acc[2][2];
  gemm_core<false>(ap, bp, 1024, smem, 0.f, acc);
  const int tok0 = tm * 128;
  const float* xres = (tok0 < NTL ? (XL + (size_t)tok0 * 1024) : (XC + (size_t)(tok0 - NTL) * 1024)) + tn * 128;
  float* Rt = R + (size_t)tok0 * 1024 + tn * 128;
  const float* g1 = (const float*)(p.ws + OFF_ADA) + (size_t)(l * 9 + ada_row(tok0)) * 6144 + 2 * 1024 + tn * 128;
  float* T = (float*)smem;
#pragma unroll
  for (int half = 0; half < 2; ++half) {
    __syncthreads();
    if (wm == half) {
#pragma unroll
      for (int i = 0; i < 2; ++i)
#pragma unroll
        for (int j = 0; j < 2; ++j)
#pragma unroll
          for (int r = 0; r < 16; ++r) T[(i * 32 + crow(r, hh)) * 132 + wn * 64 + j * 32 + l31] = acc[i][j][r];
    }
    __syncthreads();
#pragma unroll 2
    for (int i = 0; i < 8; ++i) {
      const int id = tid + 256 * i, row = id >> 5, c4 = (id & 31) * 4;
      const float4 a = *(const float4*)(T + row * 132 + c4);
      const float4 g = *(const float4*)(g1 + c4);
      const float4 x = *(const float4*)(xres + (size_t)(half * 64 + row) * 1024 + c4);
      float4 o;
      o.x = ALPHA * x.x + g.x * a.x; o.y = ALPHA * x.y + g.y * a.y; o.z = ALPHA * x.z + g.z * a.z; o.w = ALPHA * x.w + g.w * a.w;
      *(float4*)(Rt + (size_t)(half * 64 + row) * 1024 + c4) = o;
    }
  }
}

DI void ln1_router_item(const Params& p, int l, int it, char* smem, float* R, const float (&wr)[16][4]) {
  const int tid = opaque_tid(), lane = tid & 63, w = tid >> 6;
  float* hrow = (float*)smem;
  float* lg = hrow + 4 * 1024;
  const int tok = it * 4 + w;
  const float* ada = (const float*)(p.ws + OFF_ADA) + (size_t)(l * 9 + ada_row(tok)) * 6144;
  float v[16];
  float* row = R + (size_t)tok * 1024;
  row_load(row, v);
  row_norm(v);
  row_affine<0>(v, p.in[I_LN1G] + l * 1024, p.in[I_LN1B] + l * 1024);
  {
    float t[16];
#pragma unroll
    for (int i = 0; i < 16; ++i) t[i] = ALPHA * v[i];
    row_store(row, t);
  }
  row_norm(v);
  row_affine<1>(v, ada + 4 * 1024, ada + 3 * 1024);
  row_store_bf((bf16*)(p.ws + OFF_Y) + (size_t)tok * 1024, v);
  if (lane == 0) ((int*)(p.ws + OFF_TOKCNT))[tok] = 0;
  __syncthreads();
  row_store(hrow + w * 1024, v);
  __syncthreads();
  float part[4][4];
#pragma unroll
  for (int r = 0; r < 4; ++r) {
    float hv[16];
    row_load(hrow + r * 1024, hv);
#pragma unroll
    for (int e = 0; e < 4; ++e) {
      float s = 0.f;
#pragma unroll
      for (int i = 0; i < 16; ++i) s += hv[i] * wr[i][e];
      part[r][e] = s;
    }
  }
#pragma unroll
  for (int r = 0; r < 4; ++r)
#pragma unroll
    for (int e = 0; e < 4; ++e) {
      float s = wave_sum(part[r][e]);
      if (lane == 0) lg[r * 16 + w * 4 + e] = s;
    }
  __syncthreads();
  if (tid < 64) {
    int r = tid >> 4, e = tid & 15;
    float mx = -INFINITY;
#pragma unroll
    for (int i = 0; i < 16; ++i) mx = fmaxf(mx, lg[r * 16 + i]);
    float sum = 0.f;
#pragma unroll
    for (int i = 0; i < 16; ++i) sum += __expf(lg[r * 16 + i] - mx);
    float a = __expf(lg[r * 16 + e] - mx) / sum;
    int tk = it * 4 + r;
    if (tk < NTL) ((float*)(p.ws + OFF_AFFL))[((size_t)((tk >> 12) * 16 + e)) * 4096 + (tk & 4095)] = a;
    else { int tc = tk - NTL; ((float*)(p.ws + OFF_AFFC))[((size_t)((tc >> 8) * 16 + e)) * 256 + (tc & 255)] = a; }
  }
}

template <int NV>
DI void topk_item(const Params& p, int be, bool is_ctx, int me, char* smem) {
  const int tid = opaque_tid(), lane = tid & 63, w = tid >> 6;
  constexpr int N = NV * 256;
  constexpr int KSEL = N / 8;
  unsigned* hist = (unsigned*)smem;
  unsigned* ctl = hist + 256;
  unsigned* wtot = ctl + 4;
  const float* src = (const float*)(p.ws + (is_ctx ? OFF_AFFC : OFF_AFFL)) + (size_t)be * N + tid * NV;
  float v[NV]; unsigned u[NV];
  if (NV == 16) {
#pragma unroll
    for (int i = 0; i < NV / 4; ++i) { float4 t = ((const float4*)src)[i]; v[4 * i] = t.x; v[4 * i + 1] = t.y; v[4 * i + 2] = t.z; v[4 * i + 3] = t.w; }
  } else {
#pragma unroll
    for (int i = 0; i < NV; ++i) v[i] = src[i];
  }
#pragma unroll
  for (int i = 0; i < NV; ++i) u[i] = __float_as_uint(v[i]);
  unsigned prefix = 0, mask = 0, remaining = KSEL;
  for (int pass = 0; pass < 4; ++pass) {
    const int shift = 24 - 8 * pass;
    __syncthreads();
    hist[tid] = 0;
    __syncthreads();
#pragma unroll
    for (int i = 0; i < NV; ++i)
      if ((u[i] & mask) == prefix) atomicAdd(&hist[(u[i] >> shift) & 255], 1u);
    __syncthreads();
    if (w == 0) {
      const unsigned h0 = hist[255 - 4 * lane], h1 = hist[254 - 4 * lane], h2 = hist[253 - 4 * lane], h3 = hist[252 - 4 * lane];
      const unsigned s4 = h0 + h1 + h2 + h3;
      const unsigned inc = wave_scan_add_u(s4);
      const unsigned exc = inc - s4;
      if ((exc < remaining && inc >= remaining) || (lane == 63 && inc < remaining)) {
        unsigned cum = exc; int d = 255 - 4 * lane;
        if (cum + h0 < remaining) { cum += h0; --d; if (cum + h1 < remaining) { cum += h1; --d; if (cum + h2 < remaining) { cum += h2; --d; } } }
        ctl[0] = prefix | ((unsigned)d << shift);
        ctl[1] = remaining - cum;
      }
    }
    __syncthreads();
    prefix = ctl[0]; remaining = ctl[1];
    mask |= 255u << shift;
  }
  const unsigned thresh = prefix;
  unsigned cgt = 0, ceq = 0;
#pragma unroll
  for (int i = 0; i < NV; ++i) { cgt += (u[i] > thresh); ceq += (u[i] == thresh); }
  unsigned sg = wave_scan_add_u(cgt), se = wave_scan_add_u(ceq);
  __syncthreads();
  if (lane == 63) { wtot[w] = sg; wtot[4 + w] = se; }
  __syncthreads();
  unsigned og = 0, oe = 0, totg = 0;
#pragma unroll
  for (int i = 0; i < 4; ++i) { if (i < w) { og += wtot[i]; oe += wtot[4 + i]; } totg += wtot[i]; }
  unsigned pg = og + sg - cgt, pe = oe + se - ceq;
  const int b = be >> 4, e = be & 15;
  int* rowtok = (int*)(p.ws + OFF_ROWTOK) + (size_t)e * MEMAX + (is_ctx ? 4096 + b * 32 : b * 512);
  float* rowgate = (float*)(p.ws + OFF_ROWGATE) + (size_t)e * MEMAX + (is_ctx ? 4096 + b * 32 : b * 512);
  const int tokbase = is_ctx ? NTL + b * 256 : b * 4096;
#pragma unroll
  for (int i = 0; i < NV; ++i) {
    int slot = -1;
    if (u[i] > thresh) slot = (int)pg++;
    else if (u[i] == thresh) { if (pe < remaining) slot = (int)(totg + pe); pe++; }
    if (slot >= 0 && slot < KSEL) {
      const int tk = tokbase + tid * NV + i;
      rowtok[slot] = tk; rowgate[slot] = v[i];
      const int c = atomicAdd((int*)(p.ws + OFF_TOKCNT) + tk, 1);
      ((int*)(p.ws + OFF_TOKLIST))[tk * 16 + c] = e * 4096 * 0 + (is_ctx ? -(e * 256 + b * 32 + slot) - 1 : e * 4096 + b * 512 + slot);
    }
  }
}

DI void moe1_tile(const Params& p, int e, int tm, int tn, char* smem) {
  const int tid = opaque_tid(), lane = tid & 63, w = tid >> 6, wm = w >> 1, wn = w & 1, l31 = lane & 31, hh = lane >> 5;
  const bf16* XM = (const bf16*)(p.ws + OFF_Y);
  const bf16* Bt = (const bf16*)(p.ws + OFF_WGU) + (size_t)e * 2048 * 1024;
  const int* rowtok = (const int*)(p.ws + OFF_ROWTOK) + (size_t)e * MEMAX;
  const bf16* ap[4]; const bf16* bp[4];
#pragma unroll
  for (int j = 0; j < 4; ++j) {
    int r = 32 * (tid >> 6) + 8 * j + ((tid & 63) >> 3);
    ap[j] = XM + (size_t)rowtok[tm * 128 + r] * 1024;
    bp[j] = Bt + (size_t)(tn * 128 + r) * 1024;
  }
  f32x16 acc[2][2];
  gemm_core<false>(ap, bp, 1024, smem, 0.f, acc);
  bf16* T = (bf16*)smem;
  __syncthreads();
  {
    const int toff = (wm * 64 + 4 * hh) * 72 + wn * 32 + l31;
#pragma unroll
    for (int i = 0; i < 2; ++i)
#pragma unroll
      for (int r = 0; r < 16; ++r) {
        const int mo = i * 32 + 8 * (r >> 2) + (r & 3);
        float g = acc[i][0][r], u = acc[i][1][r];
        T[toff + mo * 72] = f2bf(silu_f(g) * u);
      }
  }
  __syncthreads();
  {
    bf16* hid = (bf16*)(p.ws + OFF_Z) + ((size_t)e * MEMAX + tm * 128) * 1024 + 64 * tn;
#pragma unroll
    for (int i = 0; i < 4; ++i) {
      const int id = tid + 256 * i, row = id >> 3, c = id & 7;
      *(u32x4*)(hid + (size_t)row * 1024 + c * 8) = *(const u32x4*)(T + row * 72 + c * 8);
    }
  }
}

DI void moe2_tile(const Params& p, int l, int e, int tm, int tn, char* smem, bf16* YEL, bf16* YEC) {
  const int tid = opaque_tid(), lane = tid & 63, w = tid >> 6, wm = w >> 1, wn = w & 1, l31 = lane & 31, hh = lane >> 5;
  const bf16* A = (const bf16*)(p.ws + OFF_Z) + (size_t)e * MEMAX * 1024;
  const bf16* Bt = (const bf16*)(p.ws + OFF_WD) + (size_t)e * 1024 * 1024;
  const int* rowtok = (const int*)(p.ws + OFF_ROWTOK) + (size_t)e * MEMAX;
  const float* rowgate = (const float*)(p.ws + OFF_ROWGATE) + (size_t)e * MEMAX;
  const bf16* ap[4]; const bf16* bp[4];
#pragma unroll
  for (int j = 0; j < 4; ++j) {
    int r = 32 * (tid >> 6) + 8 * j + ((tid & 63) >> 3);
    ap[j] = A + (size_t)(tm * 128 + r) * 1024;
    bp[j] = Bt + (size_t)(tn * 128 + r) * 1024;
  }
  f32x16 acc[2][2];
  gemm_core<false>(ap, bp, 1024, smem, 0.f, acc);
  const int arow = tm * 128 < 4096 ? (tm * 128) >> 9 : 8;
  const float* g2 = (const float*)(p.ws + OFF_ADA) + (size_t)(l * 9 + arow) * 6144 + 5 * 1024 + tn * 128 + wn * 64 + l31;
  const float g2v0 = g2[0], g2v1 = g2[32];
  bf16* T = (bf16*)smem;
  float* gs = (float*)(smem + GEMM_LDS);
  if (tid < 128) gs[tid] = rowgate[tm * 128 + tid];
  __syncthreads();
#pragma unroll
  for (int i = 0; i < 2; ++i)
#pragma unroll
    for (int r = 0; r < 16; ++r) {
      const int ml = wm * 64 + i * 32 + crow(r, hh);
      const float gt = gs[ml];
      T[ml * 136 + wn * 64 + l31] = f2bf(g2v0 * gt * acc[i][0][r]);
      T[ml * 136 + wn * 64 + 32 + l31] = f2bf(g2v1 * gt * acc[i][1][r]);
    }
  __syncthreads();
  {
    const int m0 = tm * 128;
    bf16* dst = (m0 < 4096 ? YEL + ((size_t)e * 4096 + m0) * 1024 : YEC + ((size_t)e * 256 + (m0 - 4096)) * 1024) + tn * 128;
#pragma unroll
    for (int i = 0; i < 8; ++i) {
      const int id = tid + 256 * i, row = id >> 4, c = id & 15;
      *(u32x4*)(dst + (size_t)row * 1024 + c * 8) = *(const u32x4*)(T + row * 136 + c * 8);
    }
  }
}

#define XB_TMO      128
#define XB_XCNT(j)  (256  + 64 * (j))
#define XB_XSUB(j)  (1280 + 64 * (j))
#define XB_XGEN(j)  (2304 + 64 * (j))
#define XB_TOP      3328
#define XB_TOPGEN   3392
#define XCD_BAR_WORDS 3456
#define XB_SPIN_CAP (1u << 22)
#define LAS __attribute__((address_space(3)))
DI unsigned xb_ld(unsigned* p) { return __hip_atomic_load(p, __ATOMIC_RELAXED, __HIP_MEMORY_SCOPE_AGENT); }
DI unsigned xb_add(unsigned* p, unsigned v) { return __hip_atomic_fetch_add(p, v, __ATOMIC_RELAXED, __HIP_MEMORY_SCOPE_AGENT); }
DI unsigned xb_xcc_id() { return (unsigned)__builtin_amdgcn_s_getreg((3 << 11) | 20) & 0xFu; }
#define XB_SPIN(cond, bar) do { unsigned _sp = 0; while (cond) { __builtin_amdgcn_s_sleep(1); \
    if ((++_sp & 255u) == 0u) { if (xb_ld(&(bar)[XB_TMO])) break; if (_sp > XB_SPIN_CAP) { atomicAdd(&(bar)[XB_TMO], 1u); break; } } } } while (0)
struct XcdBarrier { unsigned* bar; unsigned x; volatile LAS unsigned* st; };
DI XcdBarrier xcd_barrier_post(unsigned* bar, volatile LAS unsigned* st) {
  XcdBarrier b; b.bar = bar; b.x = (unsigned)__builtin_amdgcn_readfirstlane((int)xb_xcc_id()); b.st = st;
  if (threadIdx.x == 0) (void)xb_add(&bar[XB_XCNT(b.x)], 1u);
  return b;
}
DI void xcd_barrier_complete(unsigned* bar, unsigned x, unsigned& nloc, unsigned& nx) {
  const unsigned G = gridDim.x * gridDim.y * gridDim.z;
  unsigned sum, cnt, mine, sp = 0u;
  for (;;) {
    sum = 0u; cnt = 0u; mine = 0u;
#pragma unroll
    for (unsigned j = 0; j < 16; ++j) { const unsigned c = xb_ld(&bar[XB_XCNT(j)]); sum += c; cnt += (c > 0u) ? 1u : 0u; mine = (j == x) ? c : mine; }
    if (sum == G) break;
    __builtin_amdgcn_s_sleep(1);
    if ((++sp & 255u) == 0u) { if (xb_ld(&bar[XB_TMO])) break; if (sp > XB_SPIN_CAP) { atomicAdd(&bar[XB_TMO], 1u); break; } }
  }
  nloc = mine > 0u ? mine : 1u; nx = cnt > 0u ? cnt : 1u;
}
DI void xcd_barrier(const XcdBarrier& b) {
  asm volatile("s_waitcnt vmcnt(0)" ::: "memory");
  __syncthreads();
  if (threadIdx.x == 0) {
    unsigned* bar = b.bar;
    unsigned bx = b.x;
    asm volatile("" : "+s"(bx), "+s"(bar));
    __builtin_amdgcn_s_waitcnt(0);
    unsigned nloc = b.st[0], nx = b.st[1];
    if (nloc == 0u) { xcd_barrier_complete(bar, bx, nloc, nx); b.st[0] = nloc; b.st[1] = nx; }
    const unsigned old = xb_add(&bar[XB_XSUB(bx)], 1u);
    const unsigned gen = old / nloc;
    if (old + 1u == (gen + 1u) * nloc) {
      __builtin_amdgcn_fence(__ATOMIC_RELEASE, "agent");
      asm volatile("s_waitcnt vmcnt(0)" ::: "memory");
      const unsigned og = xb_add(&bar[XB_TOP], 1u);
      const unsigned tg = og / nx;
      if (og + 1u == (tg + 1u) * nx) xb_add(&bar[XB_TOPGEN], 1u);
      else XB_SPIN(xb_ld(&bar[XB_TOPGEN]) == tg, bar);
      __builtin_amdgcn_fence(__ATOMIC_ACQUIRE, "agent");
      xb_add(&bar[XB_XGEN(bx)], 1u);
      asm volatile("s_waitcnt vmcnt(0)" ::: "memory");
    } else {
      XB_SPIN(xb_ld(&bar[XB_XGEN(bx)]) == gen, bar);
      __builtin_amdgcn_fence(__ATOMIC_ACQUIRE, "agent");
      asm volatile("s_waitcnt vmcnt(0)" ::: "memory");
    }
  }
  __syncthreads();
}

__global__ void __launch_bounds__(NTHR, 2) hybrid_mega(Params p_in) {
  Params p = p_in;
  cg::grid_group grid = cg::this_grid();
  extern __shared__ __attribute__((aligned(16))) char smem[];
  const int tid = opaque_tid(), lane = tid & 63, w = tid >> 6;
  const int G = gridDim.x, bid = blockIdx.x;
  int nlb = G >> 3, vx = bid & 7, lb = (bid < 8 * nlb) ? (bid >> 3) : (1 << 28);
  __shared__ uint4 xb_words;
  __shared__ int xmap[2];
  if (tid == 0) xb_words = make_uint4(0u, 0u, 0u, 0u);
  __syncthreads();
  XcdBarrier xb = xcd_barrier_post((unsigned*)(p.ws + OFF_BAR), (volatile LAS unsigned*)&xb_words);
  if (p.ws == nullptr) grid.sync();
  if (tid == 0) xmap[0] = (int)xb_add((unsigned*)(p.ws + OFF_BAR) + 8 * xb.x, 1u);
  float* X2 = (float*)(p.ws + OFF_X2);
  bf16* XM = (bf16*)(p.ws + OFF_Y);
  const float* ADA = (const float*)(p.ws + OFF_ADA);

  PH(0) {
    const int n_ada = 384, n_w = 2 * NW_TILES, n_e = NE_TILES;
    const int total = n_ada + 1 + n_w + n_e;
    for (int it = bid; it < total; it += G) {
      if (it < n_ada) ada_item(p, it, (float*)smem);
      else if (it == n_ada) {
        for (int i = opaque_tid(); i < 512; i += NTHR) {
          int ap2 = i >> 3, j = i & 7;
          float inv = powf(10000.f, -(float)j * 2.0f / 16.0f);
          float ang = (float)ap2 * inv;
          ((float2*)(p.ws + OFF_ROPE))[i] = make_float2(cosf(ang), sinf(ang));
        }
      } else if (it < n_ada + 1 + n_w) {
        int k = it - n_ada - 1;
        convert_weight_item(p, k / NW_TILES, k % NW_TILES, (float*)smem);
      } else convert_expert_item(p, 0, it - n_ada - 1 - n_w, (float*)smem);
    }
  }
  xcd_barrier(xb);
  {
    if (tid == 0) {
      unsigned* bar = (unsigned*)(p.ws + OFF_BAR);
      int ok = (G & 7) == 0;
      for (int j = 0; j < 16; ++j) { unsigned c = xb_ld(&bar[XB_XCNT(j)]); if (c != (j < 8 ? (unsigned)(G >> 3) : 0u)) ok = 0; }
      xmap[1] = ok;
    }
    __syncthreads();
    if (__builtin_amdgcn_readfirstlane(xmap[1])) { vx = (int)xb.x; lb = __builtin_amdgcn_readfirstlane(xmap[0]); }
  }
  PH(1) for (int it = bid; it < NT / 4; it += G) {
    const int w = opaque_tid() >> 6;
    int tok = it * 4 + w;
    const float* row = tok < NTL ? p.in[I_X] + (size_t)tok * 1024 : p.in[I_CTX] + (size_t)(tok - NTL) * 1024;
    const float* ada = ADA + (size_t)ada_row(tok) * 6144;
    float v[16];
    row_load(row, v);
    row_norm(v);
    row_affine<1>(v, ada + 1024, ada);
    row_store_bf(XM + (size_t)tok * 1024, v);
  }
  xcd_barrier(xb);

  for (int l = 0; l < 2; ++l) {
    const bool upd = (l == 0);
    const int mt_q = upd ? 272 : 256;
    float* R = upd ? X2 : p.out;
    bf16* YEL = upd ? (bf16*)p.out : (bf16*)(p.ws + OFF_X2);
    bf16* YEC = (bf16*)(p.ws + OFF_KN);
    PH(2) for (int li = lb; li < 68 * 9; li += nlb) {
      int mi = li / 9, ntl = li - mi * 9;
      inproj_tile(p, l, (vx & 3) + 4 * mi, (vx >> 2) * 9 + ntl, smem);
    }
    xcd_barrier(xb);
    PH(3) {
      const int n_ml1 = 32 * 68, n_g = mt_q, n_kr = 272;
      if (P3MASK & 1) for (int li = lb; li < (mt_q / 8) * 6; li += nlb) { int mi = li / 6; uq_tile(p, l, vx + 8 * mi, li - mi * 6, smem); }
      if (P3MASK & 2) for (int li = lb; li < 34 * 8; li += nlb) ukv_tile(p, l, vx + 8 * (li >> 3), li & 7, smem);
      const int total = n_ml1 + n_g + n_kr;
      for (int it = bid; it < total; it += G) {
        int k = it;
        if (k < n_ml1) { int c = k % 68, bh = k / 68; if (P3MASK & 4) ml1_item(p, l, bh >> 2, bh & 3, c, smem); continue; }
        k -= n_ml1;
        if (k < n_g) { if (P3MASK & 8) gmlp_item(p, l, k, smem); continue; }
        k -= n_g;
        if (P3MASK & 16) krope_item(p, k);
      }
    }
    xcd_barrier(xb);
    PH(4) {
      const int n_ml2 = 64 * 4, n_ac = upd ? 8 * 8 * 2 : 0;
      for (int it = bid; it < n_ml2; it += G) ml2_item(p, it, smem);
      for (int li = lb; li < 8 * 16; li += nlb) {
        int bh = vx + 8 * (li >> 4), qt = li & 15;
        int b = bh >> 3, h = bh & 7;
        attn_item(p, b, h, qt * 256, 0, 68, b * 4096 + qt * 256, smem);
      }
      if (upd) for (int k = bid; k < 64; k += G) {
        int b = k >> 3, h = k & 7;
        attn_item(p, b, h, 4096, 4096, 4, NTL + b * 256, smem);
      }
    }
    xcd_barrier(xb);
    PH(5) {
      const int ncl = 32 * 64, ncc = upd ? 32 * 4 : 0;
      for (int it = bid; it < ncl + ncc; it += G) {
        if (it < ncl) { int c = it & 63, bh = it >> 6; ml3_item(p, l, bh >> 2, bh & 3, c, smem); }
        else { int k = it - ncl; int c = 64 + (k & 3), bh = k >> 2; ml3_item(p, l, bh >> 2, bh & 3, c, smem); }
      }
    }
    xcd_barrier(xb);
    PH(6) {
      const float* XL = upd ? p.in[I_X] : X2;
      const float* XC = upd ? p.in[I_CTX] : (X2 + (size_t)NTL * 1024);
      for (int li = lb; li < (mt_q / 8) * 8; li += nlb) outproj_tile(p, l, vx + 8 * (li >> 3), li & 7, smem, R, XL, XC);
    }
    xcd_barrier(xb);
    PH(7) {
      float wr[16][4];
      {
        const int t2 = opaque_tid(); const int lane = t2 & 63, w = t2 >> 6;
        const float* W = p.in[I_WROUTER] + (size_t)l * 1024 * 16;
#pragma unroll
        for (int i = 0; i < 4; ++i)
#pragma unroll
          for (int c = 0; c < 4; ++c) {
            int k = 4 * lane + 256 * i + c;
            float4 t = *(const float4*)(W + (size_t)k * 16 + w * 4);
            wr[4 * i + c][0] = t.x; wr[4 * i + c][1] = t.y; wr[4 * i + c][2] = t.z; wr[4 * i + c][3] = t.w;
          }
      }
      const int nrows = upd ? NT : NTL;
      for (int it = bid; it < nrows / 4; it += G) ln1_router_item(p, l, it, smem, R, wr);
    }
    xcd_barrier(xb);
    PH(8) {
      const int me = upd ? 4352 : 4096;
      const int total = upd ? 256 : 128;
      for (int it = bid; it < total; it += G) {
        if (it < 128) topk_item<16>(p, it, false, me, smem);
        else topk_item<1>(p, it - 128, true, me, smem);
      }
    }
    xcd_barrier(xb);
    PH(9) {
      const int mtiles = upd ? 34 : 32;
      const int per_e = mtiles * 16, per_h = mtiles * 8;
      for (int li = lb; li < 2 * per_e; li += nlb) {
        int ei = li / per_e, rem = li - ei * per_e;
        int half = rem / per_h, rem2 = rem - half * per_h;
        moe1_tile(p, 2 * vx + ei, rem2 >> 3, half * 8 + (rem2 & 7), smem);
      }
    }
    xcd_barrier(xb);
    PH(10) {
      const int mtiles = upd ? 34 : 32;
      const int per_e = mtiles * 8;
      for (int li = lb; li < 2 * per_e; li += nlb) {
        int ei = li / per_e, rem = li - ei * per_e;
        moe2_tile(p, l, 2 * vx + ei, rem >> 3, rem & 7, smem, YEL, YEC);
      }
    }
    xcd_barrier(xb);
    PH(11) {
      const int nrows = upd ? NT : NTL;
      const int n_r = nrows / 4;
      const int total = n_r + (upd ? NE_TILES : 0);
      for (int it = bid; it < total; it += G) {
        if (it < n_r) {
          const int w = opaque_tid() >> 6;
          int tok = it * 4 + w;
          float v[16];
          float* row = R + (size_t)tok * 1024;
          row_load(row, v);
          {
            const int ln = opaque_tid() & 63;
            const int cnt = ((const int*)(p.ws + OFF_TOKCNT))[tok];
            const int* lst = (const int*)(p.ws + OFF_TOKLIST) + (size_t)tok * 16;
            for (int c = 0; c < cnt; ++c) {
              const int code = lst[c];
              const bf16* yr = code >= 0 ? YEL + (size_t)code * 1024 : YEC + (size_t)(-code - 1) * 1024;
#pragma unroll
              for (int i = 0; i < 4; ++i) {
                uint2 u = *(const uint2*)(yr + 4 * ln + 256 * i);
                v[4 * i] += bflo(u.x); v[4 * i + 1] += bfhi(u.x); v[4 * i + 2] += bflo(u.y); v[4 * i + 3] += bfhi(u.y);
              }
            }
          }
          row_norm(v);
          row_affine<0>(v, p.in[I_LN2G] + l * 1024, p.in[I_LN2B] + l * 1024);
          row_store(row, v);
          if (upd) {
            const float* ada = ADA + (size_t)(9 + ada_row(tok)) * 6144;
            row_norm(v);
            row_affine<1>(v, ada + 1024, ada);
            row_store_bf(XM + (size_t)tok * 1024, v);
          }
        } else convert_expert_item(p, 1, it - n_r, (float*)smem);
      }
    }
    if (l == 0) xcd_barrier(xb);
  }
}

extern "C" void kernel_launch(void* const* d_in, const int* in_sizes, int n_in, void* d_out, int out_size, void* d_ws, size_t ws_size,
                              hipStream_t stream) {
  static int grid_blocks = 0;
  if (!grid_blocks) {
    int dev = 0, cus = 0, per_cu = 0;
    hipGetDevice(&dev);
    hipDeviceGetAttribute(&cus, hipDeviceAttributeMultiprocessorCount, dev);
    hipFuncSetAttribute((const void*)hybrid_mega, hipFuncAttributeMaxDynamicSharedMemorySize, SMEM_BYTES);
    hipOccupancyMaxActiveBlocksPerMultiprocessor(&per_cu, hybrid_mega, NTHR, SMEM_BYTES);
    if (per_cu > 2) per_cu = 2;
    if (per_cu < 1) per_cu = 1;
    grid_blocks = cus * per_cu;
  }
  if (ws_size < WS_END) fprintf(stderr, "workspace too small: %zu < %zu\n", ws_size, (size_t)WS_END);
  hipMemsetAsync((char*)d_ws + OFF_BAR, 0, XCD_BAR_WORDS * 4, stream);
  Params p{};
  for (int i = 0; i < 29; ++i) p.in[i] = (const float*)d_in[i];
  p.out = (float*)d_out;
  p.ws = (char*)d_ws;
  void* args[] = {&p};
  hipError_t e = hipLaunchCooperativeKernel((void*)hybrid_mega, dim3(grid_blocks), dim3(NTHR), args, SMEM_BYTES, stream);
  if (e != hipSuccess) fprintf(stderr, "cooperative launch failed: %s (grid %d)\n", hipGetErrorString(e), grid_blocks);
}
```

```cpp
#include <hip/hip_runtime.h>
#include <hip/hip_cooperative_groups.h>
#include <cstdio>
namespace cg = cooperative_groups;

#define DI __device__ __forceinline__
#define MEMBAR() asm volatile("" ::: "memory")
DI int opaque_tid() { int t = threadIdx.x; asm volatile("" : "+v"(t)); return t; }
typedef unsigned u32x2_t __attribute__((ext_vector_type(2)));
DI float shx(float v, int m) {
  if (m == 1) return __int_as_float(__builtin_amdgcn_update_dpp(0, __float_as_int(v), 0xB1, 0xF, 0xF, false));
  if (m == 2) return __int_as_float(__builtin_amdgcn_update_dpp(0, __float_as_int(v), 0x4E, 0xF, 0xF, false));
  if (m == 8) return __int_as_float(__builtin_amdgcn_update_dpp(0, __float_as_int(v), 0x128, 0xF, 0xF, false));
  if (m == 16) return __int_as_float(__builtin_amdgcn_ds_swizzle(__float_as_int(v), 0x401F));
  if (m == 32) {
    const u32x2_t r = __builtin_amdgcn_permlane32_swap(__float_as_uint(v), __float_as_uint(v), false, false);
    return __uint_as_float(((opaque_tid() & 32) != 0) ? r[0] : r[1]);
  }
  const int l = opaque_tid() & 63;
  return __int_as_float(__builtin_amdgcn_ds_bpermute((l ^ m) << 2, __float_as_int(v)));
}
DI float shup(float v, int o) { const int l = opaque_tid() & 63; return __int_as_float(__builtin_amdgcn_ds_bpermute((l >= o ? l - o : l) << 2, __float_as_int(v))); }
DI unsigned shup(unsigned v, int o) { const int l = opaque_tid() & 63; return (unsigned)__builtin_amdgcn_ds_bpermute((l >= o ? l - o : l) << 2, (int)v); }
typedef unsigned short bf16;
typedef __attribute__((ext_vector_type(8))) short bf16x8;
typedef __attribute__((ext_vector_type(16))) float f32x16;
typedef __attribute__((ext_vector_type(2))) __bf16 bfv2;
typedef __attribute__((ext_vector_type(2))) float fv2;
typedef __attribute__((ext_vector_type(4))) unsigned u32x4;

constexpr int NTHR = 256;
constexpr int NB = 8, SEQ = 4096, CTX = 256;
constexpr int NTL = NB * SEQ, NTC = NB * CTX, NT = NTL + NTC;
constexpr int ZS = 2224;
constexpr int KTOT = SEQ + CTX;
constexpr int MEMAX = 4352;
constexpr float LN_EPS = 1e-6f;
constexpr float ALPHA = 1.41421356237f;
constexpr float QSCALE = 0.10206207261596577f * 1.4426950408889634f;

enum { I_X = 0, I_C, I_CTX, I_CCTX, I_WADA, I_BADA, I_WIN, I_BIN, I_SGLNG, I_SGLNB, I_SGW, I_SGB, I_QNG, I_KVNG, I_WUQ, I_WUKV,
       I_CONVW, I_CONVB, I_FBIAS, I_MLNG, I_WOUT, I_LN1G, I_LN1B, I_WROUTER, I_WGATE, I_WUP, I_WDOWN, I_LN2G, I_LN2B };

struct Params {
  const float* in[29];
  float* out;
  char* ws;
};

DI void launder_params(Params& q) {
  char* w = q.ws; float* o = q.out;
  asm volatile("" : "+s"(w), "+s"(o));
  q.ws = w; q.out = o;
}
constexpr size_t al(size_t x) { return (x + 255) & ~size_t(255); }
constexpr size_t OFF_ADA = 0;
constexpr size_t OFF_ROPE = al(OFF_ADA + 2ull * 9 * 6144 * 4);
constexpr size_t OFF_WIN = al(OFF_ROPE + 64 * 8 * 8);
constexpr size_t SZ_WIN1 = 2304ull * 1024 * 2;
constexpr size_t OFF_WUQ = al(OFF_WIN + 2 * SZ_WIN1);
constexpr size_t SZ_WUQ1 = 768ull * 384 * 2;
constexpr size_t OFF_WUKV = al(OFF_WUQ + 2 * SZ_WUQ1);
constexpr size_t SZ_WUKV1 = 1024ull * 256 * 2;
constexpr size_t OFF_WOUT = al(OFF_WUKV + 2 * SZ_WUKV1);
constexpr size_t SZ_WOUT1 = 1024ull * 1024 * 2;
constexpr size_t OFF_SGW = al(OFF_WOUT + 2 * SZ_WOUT1);
constexpr size_t SZ_SGW1 = 4ull * 128 * 128 * 2;
constexpr size_t OFF_WGU = al(OFF_SGW + 2 * SZ_SGW1);
constexpr size_t OFF_WD = al(OFF_WGU + 16ull * 2048 * 1024 * 2);
constexpr size_t OFF_X2 = al(OFF_WD + 16ull * 1024 * 1024 * 2);
constexpr size_t OFF_Z = al(OFF_X2 + (size_t)NT * 1024 * 4);
constexpr size_t OFF_KN = al(OFF_Z + (size_t)NT * ZS * 2);
constexpr size_t OFF_VT = al(OFF_KN + (size_t)NB * 8 * KTOT * 64 * 2);
constexpr size_t OFF_KR = al(OFF_VT + (size_t)NB * 8 * KTOT * 64 * 2);
constexpr size_t OFF_Y = al(OFF_KR + (size_t)NB * KTOT * 32 * 2);
constexpr size_t OFF_GATES = al(OFF_Y + (size_t)NT * 1024 * 2);
constexpr size_t OFF_AFFL = al(OFF_GATES + (size_t)NT * 16 * 4);
constexpr size_t OFF_AFFC = al(OFF_AFFL + 128ull * 4096 * 4);
constexpr size_t OFF_ROWTOK = al(OFF_AFFC + 128ull * 256 * 4);
constexpr size_t OFF_ROWGATE = al(OFF_ROWTOK + 16ull * MEMAX * 4);
constexpr size_t OFF_SM = al(OFF_ROWGATE + 16ull * MEMAX * 4);
constexpr size_t OFF_BAR = al(OFF_SM + 32ull * 2 * 68 * 4 * 4);
constexpr size_t OFF_TOKCNT = al(OFF_BAR + 3456 * 4);
constexpr size_t OFF_TOKLIST = al(OFF_TOKCNT + (size_t)NT * 4);
constexpr size_t WS_END = al(OFF_TOKLIST + (size_t)NT * 16 * 4);
constexpr size_t OOFF_SC = 0;
constexpr size_t OOFF_SN = OOFF_SC + 32ull * 2 * 68 * 4096 * 4;
constexpr size_t OOFF_Q = al(OOFF_SN + 32ull * 2 * 68 * 64 * 4);
static_assert(OOFF_Q + (size_t)NB * 8 * KTOT * 96 * 2 <= (size_t)NTL * 1024 * 4, "d_out scratch overflow");

constexpr int SMEM_BYTES = 75776;
#ifndef PHMASK
#define PHMASK 0xFFFF
#endif
#define PH(n) if (launder_params(p), ((PHMASK >> (n)) & 1))
#ifndef P3MASK
#define P3MASK 31
#endif

DI unsigned pack2(float a, float b) { fv2 f = {a, b}; bfv2 r = __builtin_convertvector(f, bfv2); return __builtin_bit_cast(unsigned, r); }
DI bf16 f2bf(float a) { return (bf16)(pack2(a, 0.f) & 0xffffu); }
DI float bf2f(bf16 h) { return __uint_as_float(((unsigned)h) << 16); }
DI float bflo(unsigned u) { return __uint_as_float(u << 16); }
DI float bfhi(unsigned u) { return __uint_as_float(u & 0xffff0000u); }
DI f32x16 mfma(bf16x8 a, bf16x8 b, f32x16 c) { return __builtin_amdgcn_mfma_f32_32x32x16_bf16(a, b, c, 0, 0, 0); }
DI f32x16 fzero() { f32x16 z; _Pragma("unroll") for (int i = 0; i < 16; ++i) z[i] = 0.f; return z; }
DI int crow(int r, int hh) { return (r & 3) + 8 * (r >> 2) + 4 * hh; }
#define DPP_F(v, ctrl) __int_as_float(__builtin_amdgcn_update_dpp(0, __float_as_int(v), (ctrl), 0xF, 0xF, false))
DI float wave_sum(float v) {
  v += DPP_F(v, 0xB1); v += DPP_F(v, 0x4E); v += DPP_F(v, 0x141); v += DPP_F(v, 0x140);
  v += __int_as_float(__builtin_amdgcn_ds_swizzle(__float_as_int(v), 0x401F));
  return __int_as_float(__builtin_amdgcn_readlane(__float_as_int(v), 0)) + __int_as_float(__builtin_amdgcn_readlane(__float_as_int(v), 32));
}
#define DPP_O(old, v, ctrl, rmask) __builtin_amdgcn_update_dpp((old), (v), (ctrl), (rmask), 0xF, false)
DI float wave_scan_add(float v) {
  v += __int_as_float(DPP_O(0, __float_as_int(v), 0x111, 0xF));
  v += __int_as_float(DPP_O(0, __float_as_int(v), 0x112, 0xF));
  v += __int_as_float(DPP_O(0, __float_as_int(v), 0x114, 0xF));
  v += __int_as_float(DPP_O(0, __float_as_int(v), 0x118, 0xF));
  v += __int_as_float(DPP_O(0, __float_as_int(v), 0x142, 0xA));
  v += __int_as_float(DPP_O(0, __float_as_int(v), 0x143, 0xC));
  return v;
}
DI unsigned wave_scan_add_u(unsigned v) {
  v += (unsigned)DPP_O(0, (int)v, 0x111, 0xF);
  v += (unsigned)DPP_O(0, (int)v, 0x112, 0xF);
  v += (unsigned)DPP_O(0, (int)v, 0x114, 0xF);
  v += (unsigned)DPP_O(0, (int)v, 0x118, 0xF);
  v += (unsigned)DPP_O(0, (int)v, 0x142, 0xA);
  v += (unsigned)DPP_O(0, (int)v, 0x143, 0xC);
  return v;
}
DI float wave_scan_max(float v) {
  const int ninf = (int)0xff800000u;
  v = fmaxf(v, __int_as_float(DPP_O(ninf, __float_as_int(v), 0x111, 0xF)));
  v = fmaxf(v, __int_as_float(DPP_O(ninf, __float_as_int(v), 0x112, 0xF)));
  v = fmaxf(v, __int_as_float(DPP_O(ninf, __float_as_int(v), 0x114, 0xF)));
  v = fmaxf(v, __int_as_float(DPP_O(ninf, __float_as_int(v), 0x118, 0xF)));
  v = fmaxf(v, __int_as_float(DPP_O(ninf, __float_as_int(v), 0x142, 0xA)));
  v = fmaxf(v, __int_as_float(DPP_O(ninf, __float_as_int(v), 0x143, 0xC)));
  return v;
}
DI float wave_max(float v) {
  v = fmaxf(v, DPP_F(v, 0xB1)); v = fmaxf(v, DPP_F(v, 0x4E)); v = fmaxf(v, DPP_F(v, 0x141)); v = fmaxf(v, DPP_F(v, 0x140));
  v = fmaxf(v, __int_as_float(__builtin_amdgcn_ds_swizzle(__float_as_int(v), 0x401F)));
  return fmaxf(__int_as_float(__builtin_amdgcn_readlane(__float_as_int(v), 0)), __int_as_float(__builtin_amdgcn_readlane(__float_as_int(v), 32)));
}
DI float silu_f(float a) { return a / (1.f + __expf(-a)); }
DI float sigmoid_f(float a) { return 1.f / (1.f + __expf(-a)); }
DI float gelu_tanh(float x) {
  float y = 0.7978845608028654f * (x + 0.044715f * x * x * x);
  float t = 1.f - 2.f / (__expf(2.f * y) + 1.f);
  return 0.5f * x * (1.f + t);
}
struct Params;
DI int ada_row(int tok) { return tok < NTL ? (tok >> 12) : 8; }

DI void tr_tile(const float* s0, const float* s1, int ld, int nv0, int nv1, const float* ksc, bf16* dst, int ldd, float* t) {
  const int tid = opaque_tid();
  const int n4 = (tid & 15) * 4, kq = tid >> 4;
  const float* s = (n4 < 32) ? (s0 + n4) : (s1 + (n4 - 32));
  const int nv = (n4 < 32) ? (nv0 - n4) : (nv1 - (n4 - 32));
  __syncthreads();
#pragma unroll
  for (int i = 0; i < 4; ++i) {
    const int k = i * 16 + kq;
    float4 v = make_float4(0.f, 0.f, 0.f, 0.f);
    if (nv >= 4) v = *(const float4*)(s + (size_t)k * ld);
    if (ksc) { const float sc = ksc[k]; v.x *= sc; v.y *= sc; v.z *= sc; v.w *= sc; }
    t[k * 65 + n4] = v.x; t[k * 65 + n4 + 1] = v.y; t[k * 65 + n4 + 2] = v.z; t[k * 65 + n4 + 3] = v.w;
  }
  __syncthreads();
  const int kp = tid & 31, nn = tid >> 5;
#pragma unroll
  for (int i = 0; i < 8; ++i) {
    int n2 = i * 8 + nn;
    float a = t[(2 * kp) * 65 + n2], b = t[(2 * kp + 1) * 65 + n2];
    *(unsigned*)&dst[(size_t)n2 * ldd + 2 * kp] = pack2(a, b);
  }
}

constexpr int NE_TILES = 8192 + 4096;
DI void convert_expert_item(const Params& p, int l, int it, float* sm) {
  if (it < 8192) {
    int e = it >> 9, rem = it & 511, q = rem >> 4, kt = rem & 15;
    const float* g = p.in[I_WGATE] + ((size_t)(l * 16 + e) * 1024 + kt * 64) * 1024 + q * 32;
    const float* u = p.in[I_WUP] + ((size_t)(l * 16 + e) * 1024 + kt * 64) * 1024 + q * 32;
    bf16* dst = (bf16*)(p.ws + OFF_WGU) + ((size_t)e * 2048 + q * 64) * 1024 + kt * 64;
    tr_tile(g, u, 1024, 32, 32, nullptr, dst, 1024, sm);
  } else {
    it -= 8192;
    int e = it >> 8, rem = it & 255, nt = rem >> 4, kt = rem & 15;
    const float* s = p.in[I_WDOWN] + ((size_t)(l * 16 + e) * 1024 + kt * 64) * 1024 + nt * 64;
    bf16* dst = (bf16*)(p.ws + OFF_WD) + ((size_t)e * 1024 + nt * 64) * 1024 + kt * 64;
    tr_tile(s, s + 32, 1024, 32, 32, nullptr, dst, 1024, sm);
  }
}

constexpr int NW_TILES = 576 + 72 + 64 + 256 + 64;
DI void convert_weight_item(const Params& p, int l, int it, float* sm) {
  if (it < 576) {
    int nt = it >> 4, kt = it & 15;
    int n0 = nt * 64;
    int nv0 = min(32, max(0, 2224 - n0)), nv1 = min(32, max(0, 2224 - n0 - 32));
    const float* s = p.in[I_WIN] + ((size_t)l * 1024 + kt * 64) * 2224 + n0;
    bf16* dst = (bf16*)(p.ws + OFF_WIN + l * SZ_WIN1) + (size_t)n0 * 1024 + kt * 64;
    tr_tile(s, s + 32, 2224, nv0, nv1, nullptr, dst, 1024, sm);
    return;
  }
  it -= 576;
  if (it < 72) {
    int nt = it / 6, kt = it % 6;
    const float* s = p.in[I_WUQ] + ((size_t)l * 384 + kt * 64) * 768 + nt * 64;
    bf16* dst = (bf16*)(p.ws + OFF_WUQ + l * SZ_WUQ1) + (size_t)nt * 64 * 384 + kt * 64;
    tr_tile(s, s + 32, 768, 32, 32, p.in[I_QNG] + l * 384 + kt * 64, dst, 384, sm);
    return;
  }
  it -= 72;
  if (it < 64) {
    int nt = it >> 2, kt = it & 3;
    const float* s = p.in[I_WUKV] + ((size_t)l * 256 + kt * 64) * 1024 + nt * 64;
    bf16* dst = (bf16*)(p.ws + OFF_WUKV + l * SZ_WUKV1) + (size_t)nt * 64 * 256 + kt * 64;
    tr_tile(s, s + 32, 1024, 32, 32, p.in[I_KVNG] + l * 256 + kt * 64, dst, 256, sm);
    return;
  }
  it -= 64;
  if (it < 256) {
    int nt = it >> 4, kt = it & 15;
    const float* s = p.in[I_WOUT] + ((size_t)l * 1024 + kt * 64) * 1024 + nt * 64;
    bf16* dst = (bf16*)(p.ws + OFF_WOUT + l * SZ_WOUT1) + (size_t)nt * 64 * 1024 + kt * 64;
    tr_tile(s, s + 32, 1024, 32, 32, nullptr, dst, 1024, sm);
    return;
  }
  it -= 256;
  {
    const int t4 = opaque_tid() * 4;
    const float* s = p.in[I_SGW] + (size_t)l * 65536 + it * 1024 + t4;
    float4 v = *(const float4*)s;
    uint2 o; o.x = pack2(v.x, v.y); o.y = pack2(v.z, v.w);
    *(uint2*)((bf16*)(p.ws + OFF_SGW + l * SZ_SGW1) + it * 1024 + t4) = o;
  }
}

DI void ada_item(const Params& p, int it, float* sm) {
  const int tid = opaque_tid();
  int l = it / 192, cb = it % 192;
  float* sc = sm;
  float* red = sm + 9 * 1024;
  __syncthreads();
  for (int i = tid; i < 9 * 1024; i += NTHR) {
    int r = i >> 10, k = i & 1023;
    float c = r < 8 ? p.in[I_C][r * 1024 + k] : p.in[I_CCTX][k];
    sc[i] = c / (1.f + expf(-c));
  }
  __syncthreads();
  int kg = tid >> 5, cl = tid & 31;
  const float* W = p.in[I_WADA] + (size_t)l * 1024 * 6144 + cb * 32 + cl;
  float acc[9];
#pragma unroll
  for (int r = 0; r < 9; ++r) acc[r] = 0.f;
#pragma unroll 8
  for (int k = kg * 128; k < kg * 128 + 128; ++k) {
    float w = W[(size_t)k * 6144];
#pragma unroll
    for (int r = 0; r < 9; ++r) acc[r] += sc[r * 1024 + k] * w;
  }
#pragma unroll
  for (int r = 0; r < 9; ++r) red[(kg * 9 + r) * 32 + cl] = acc[r];
  __syncthreads();
  float* ada = (float*)(p.ws + OFF_ADA);
  for (int i = tid; i < 288; i += NTHR) {
    int r = i >> 5, c2 = i & 31;
    float s = 0.f;
#pragma unroll
    for (int g = 0; g < 8; ++g) s += red[(g * 9 + r) * 32 + c2];
    ada[(size_t)(l * 9 + r) * 6144 + cb * 32 + c2] = s + p.in[I_BADA][l * 6144 + cb * 32 + c2];
  }
}

DI void row_load(const float* row, float v[16]) {
  const int lane = opaque_tid() & 63;
#pragma unroll
  for (int i = 0; i < 4; ++i) {
    float4 t = *(const float4*)(row + 4 * lane + 256 * i);
    v[4 * i] = t.x; v[4 * i + 1] = t.y; v[4 * i + 2] = t.z; v[4 * i + 3] = t.w;
  }
}
DI void row_store(float* row, const float v[16]) {
  const int lane = opaque_tid() & 63;
#pragma unroll
  for (int i = 0; i < 4; ++i) *(float4*)(row + 4 * lane + 256 * i) = make_float4(v[4 * i], v[4 * i + 1], v[4 * i + 2], v[4 * i + 3]);
}
DI void row_store_bf(bf16* row, const float v[16]) {
  const int lane = opaque_tid() & 63;
#pragma unroll
  for (int i = 0; i < 4; ++i) {
    uint2 o; o.x = pack2(v[4 * i], v[4 * i + 1]); o.y = pack2(v[4 * i + 2], v[4 * i + 3]);
    *(uint2*)(row + 4 * lane + 256 * i) = o;
  }
}
DI void row_norm(float v[16]) {
  float s = 0.f;
#pragma unroll
  for (int i = 0; i < 16; ++i) s += v[i];
  float mean = wave_sum(s) * (1.f / 1024.f);
  float q = 0.f;
#pragma unroll
  for (int i = 0; i < 16; ++i) { v[i] -= mean; q += v[i] * v[i]; }
  float rstd = rsqrtf(wave_sum(q) * (1.f / 1024.f) + LN_EPS);
#pragma unroll
  for (int i = 0; i < 16; ++i) v[i] *= rstd;
}
template <int ONE>
DI void row_affine(float v[16], const float* a, const float* b) {
  const int lane = opaque_tid() & 63;
#pragma unroll
  for (int i = 0; i < 4; ++i) {
    float4 fa = *(const float4*)(a + 4 * lane + 256 * i);
    float4 fb = *(const float4*)(b + 4 * lane + 256 * i);
    v[4 * i] = v[4 * i] * (fa.x + ONE) + fb.x;
    v[4 * i + 1] = v[4 * i + 1] * (fa.y + ONE) + fb.y;
    v[4 * i + 2] = v[4 * i + 2] * (fa.z + ONE) + fb.z;
    v[4 * i + 3] = v[4 * i + 3] * (fa.w + ONE) + fb.w;
  }
}

constexpr int GEMM_STAGE = 128 * 128;
constexpr int GEMM_LDS = 4 * GEMM_STAGE;
template <bool SSQ, int VAR = 0>
DI void gemm_core(const bf16* (&a_row)[4], const bf16* (&b_row)[4], int K, char* smem, float ssq_div, f32x16 (&acc)[2][2]) {
  float* rowscale = (float*)(smem + GEMM_LDS);
  const int tid = opaque_tid(), lane = tid & 63, w = tid >> 6, wm = w >> 1, wn = w & 1, l31 = lane & 31, hh = lane >> 5;
#pragma unroll
  for (int i = 0; i < 2; ++i)
#pragma unroll
    for (int j = 0; j < 2; ++j) acc[i][j] = fzero();
  int srcoff[4];
#pragma unroll
  for (int j = 0; j < 4; ++j) {
    int row = 32 * w + 8 * j + (lane >> 3);
    srcoff[j] = ((lane & 7) ^ ((row >> 1) & 7)) * 8;
  }
  const int nk = K >> 6;
  auto issue = [&](int kt, int buf) {
    char* sa = smem + buf * 2 * GEMM_STAGE;
    char* sb = sa + GEMM_STAGE;
#pragma unroll
    for (int j = 0; j < 4; ++j) {
      const int ldsoff = (32 * w + 8 * j) * 128 + lane * 16;
      __builtin_amdgcn_global_load_lds((const unsigned*)(a_row[j] + kt * 64 + srcoff[j]), (__attribute__((address_space(3))) unsigned*)(sa + ldsoff), 16, 0, 0);
      __builtin_amdgcn_global_load_lds((const unsigned*)(b_row[j] + kt * 64 + srcoff[j]), (__attribute__((address_space(3))) unsigned*)(sb + ldsoff), 16, 0, 0);
    }
  };
  float ssq[2] = {0.f, 0.f};
  asm volatile("s_waitcnt vmcnt(0)" ::: "memory");
  __syncthreads();
  issue(0, 0);
  if (nk > 1) issue(1, 1);
  for (int kt = 0; kt < nk; ++kt) {
    if (kt + 1 < nk) asm volatile("s_waitcnt vmcnt(8)" ::: "memory");
    else asm volatile("s_waitcnt vmcnt(0)" ::: "memory");
    __builtin_amdgcn_s_barrier();
    const char* sa = smem + (kt & 1) * 2 * GEMM_STAGE;
    const char* sb = sa + GEMM_STAGE;
    bf16x8 af[4][2], bfr[4][2];
#pragma unroll
    for (int ks = 0; ks < 4; ++ks) {
#pragma unroll
      for (int i = 0; i < 2; ++i) {
        int row = wm * 64 + i * 32 + l31;
        af[ks][i] = *(const bf16x8*)(sa + row * 128 + (((ks * 2 + hh) ^ ((row >> 1) & 7)) << 4));
      }
#pragma unroll
      for (int j = 0; j < 2; ++j) {
        int row = wn * 64 + j * 32 + l31;
        bfr[ks][j] = *(const bf16x8*)(sb + row * 128 + (((ks * 2 + hh) ^ ((row >> 1) & 7)) << 4));
      }
    }
    __builtin_amdgcn_s_waitcnt(0xc07f);
    __builtin_amdgcn_s_barrier();
    if (kt + 2 < nk) issue(kt + 2, kt & 1);
#pragma unroll
    for (int ks = 0; ks < 4; ++ks) {
      if (SSQ) {
#pragma unroll
        for (int i = 0; i < 2; ++i)
#pragma unroll
          for (int e = 0; e < 8; ++e) { float x = bf2f((bf16)af[ks][i][e]); ssq[i] += x * x; }
      }
#pragma unroll
      for (int i = 0; i < 2; ++i)
#pragma unroll
        for (int j = 0; j < 2; ++j) acc[i][j] = mfma(af[ks][i], bfr[ks][j], acc[i][j]);
    }
  }
  __syncthreads();
  if (SSQ) {
#pragma unroll
    for (int i = 0; i < 2; ++i) {
      float s = ssq[i] + shx(ssq[i], 32);
      if (hh == 0 && wn == 0) rowscale[wm * 64 + i * 32 + l31] = rsqrtf(s * ssq_div + LN_EPS);
    }
    __syncthreads();
  }
}

DI void inproj_tile(const Params& p, int l, int tm, int tn, char* smem) {
  const int tid = opaque_tid(), lane = tid & 63, w = tid >> 6, wm = w >> 1, wn = w & 1, l31 = lane & 31, hh = lane >> 5;
  const bf16* A = (const bf16*)(p.ws + OFF_Y);
  const bf16* Bt = (const bf16*)(p.ws + OFF_WIN + l * SZ_WIN1);
  const bf16* ap[4]; const bf16* bp[4];
#pragma unroll
  for (int j = 0; j < 4; ++j) {
    int r = 32 * (tid >> 6) + 8 * j + ((tid & 63) >> 3);
    ap[j] = A + (size_t)(tm * 128 + r) * 1024;
    bp[j] = Bt + (size_t)(tn * 128 + r) * 1024;
  }
  f32x16 acc[2][2];
  gemm_core<false>(ap, bp, 1024, smem, 0.f, acc);
  bf16* T = (bf16*)smem;
  float* Gt = (float*)(p.ws + OFF_GATES) + (size_t)tm * 128 * 16;
  const int lrow = wm * 64 + 4 * hh;
  __syncthreads();
#pragma unroll
  for (int j = 0; j < 2; ++j) {
    const int cbase = tn * 128 + wn * 64 + j * 32;
    const int gn = cbase + l31;
    const float bias = gn < 2224 ? p.in[I_BIN][l * 2224 + gn] : 0.f;
    const int toff = lrow * 136 + wn * 64 + j * 32 + l31;
    const int goff = lrow * 16 + l31;
#pragma unroll
    for (int i = 0; i < 2; ++i)
#pragma unroll
      for (int r = 0; r < 16; ++r) {
        const int mo = i * 32 + 8 * (r >> 2) + (r & 3);
        float v = acc[i][j][r] + bias;
        if (cbase < 512) v = gelu_tanh(v);
        T[toff + mo * 136] = f2bf(v);
        if (cbase == 2208 && l31 < 16) Gt[goff + mo * 16] = v;
      }
  }
  __syncthreads();
  {
    bf16* Zt = (bf16*)(p.ws + OFF_Z) + (size_t)tm * 128 * ZS + tn * 128;
    const int cmax = (2208 - tn * 128) >> 3;
#pragma unroll
    for (int i = 0; i < 8; ++i) {
      const int id = tid + 256 * i, row = id >> 4, c = id & 15;
      if (c < cmax) *(u32x4*)(Zt + (size_t)row * ZS + c * 8) = *(const u32x4*)(T + row * 136 + c * 8);
    }
  }
}

DI void uq_tile(const Params& p, int l, int tm, int tn, char* smem) {
  const int tid = opaque_tid(), lane = tid & 63, w = tid >> 6, wm = w >> 1, wn = w & 1, l31 = lane & 31, hh = lane >> 5;
  const bf16* Z = (const bf16*)(p.ws + OFF_Z);
  const bf16* Bt = (const bf16*)(p.ws + OFF_WUQ + l * SZ_WUQ1);
  const bf16* ap[4]; const bf16* bp[4];
#pragma unroll
  for (int j = 0; j < 4; ++j) {
    int r = 32 * (tid >> 6) + 8 * j + ((tid & 63) >> 3);
    ap[j] = Z + (size_t)(tm * 128 + r) * ZS + 512;
    bp[j] = Bt + (size_t)(tn * 128 + r) * 384;
  }
  f32x16 acc[2][2];
  gemm_core<true>(ap, bp, 384, smem, 1.f / 384.f, acc);
  const float* rowscale = (const float*)(smem + GEMM_LDS);
  float2* ropes = (float2*)(smem + GEMM_LDS + 512);
  bf16* T = (bf16*)smem;
  const int tok0 = tm * 128;
  const bool lat = tok0 < NTL;
  const int b = lat ? (tok0 >> 12) : ((tok0 - NTL) >> 8);
  const int pos0 = lat ? (tok0 & 4095) : ((tok0 - NTL) & 255);
  const int qbase = lat ? pos0 : 4096 + pos0;
  const int lrow = wm * 64 + 4 * hh;
  ropes[tid] = ((const float2*)(p.ws + OFF_ROPE))[tid];
  ropes[256 + tid] = ((const float2*)(p.ws + OFF_ROPE))[256 + tid];
  __syncthreads();
#pragma unroll
  for (int j = 0; j < 2; ++j) {
    const int cb = tn * 4 + wn * 2 + j;
    const int seg = cb % 3;
#pragma unroll
    for (int i = 0; i < 2; ++i)
#pragma unroll
      for (int r = 0; r < 16; ++r) {
        const int m = lrow + i * 32 + 8 * (r >> 2) + (r & 3);
        float v = acc[i][j][r] * rowscale[m] * QSCALE;
        if (seg == 2) {
          float pr = shx(v, 8);
          if (lat) {
            const int pos = pos0 + m;
            const int ap2 = (l31 & 16) ? (pos & 63) : (pos >> 6);
            const float2 cs = ropes[ap2 * 8 + (l31 & 7)];
            v = (l31 & 8) ? (v * cs.x + pr * cs.y) : (v * cs.x - pr * cs.y);
          }
        }
        T[m * 136 + wn * 64 + j * 32 + l31] = f2bf(v);
      }
  }
  __syncthreads();
  {
    bf16* Qb = (bf16*)((char*)p.out + OOFF_Q);
#pragma unroll
    for (int i = 0; i < 8; ++i) {
      const int id = tid + 256 * i, row = id >> 4, c = id & 15;
      const int col = tn * 128 + c * 8, hq = col / 96, d = col - hq * 96;
      *(u32x4*)(Qb + ((size_t)(b * 8 + hq) * KTOT + qbase + row) * 96 + d) = *(const u32x4*)(T + row * 136 + c * 8);
    }
  }
}

DI void ukv_tile(const Params& p, int l, int tm, int tn, char* smem) {
  const int tid = opaque_tid(), lane = tid & 63, w = tid >> 6, wm = w >> 1, wn = w & 1, l31 = lane & 31, hh = lane >> 5;
  const bf16* Z = (const bf16*)(p.ws + OFF_Z);
  const bf16* Bt = (const bf16*)(p.ws + OFF_WUKV + l * SZ_WUKV1);
  const bf16* ap[4]; const bf16* bp[4];
#pragma unroll
  for (int j = 0; j < 4; ++j) {
    int r = 32 * (tid >> 6) + 8 * j + ((tid & 63) >> 3);
    ap[j] = Z + (size_t)(tm * 128 + r) * ZS + 896;
    bp[j] = Bt + (size_t)(tn * 128 + r) * 256;
  }
  f32x16 acc[2][2];
  gemm_core<true>(ap, bp, 256, smem, 1.f / 256.f, acc);
  const float* rowscale = (const float*)(smem + GEMM_LDS);
  const int tok0 = tm * 128;
  const bool lat = tok0 < NTL;
  const int b = lat ? (tok0 >> 12) : ((tok0 - NTL) >> 8);
  const int kbase = lat ? (tok0 & 4095) : 4096 + ((tok0 - NTL) & 255);
  const int bh = b * 8 + tn;
  bf16* TK = (bf16*)smem;
  bf16* TV = TK + 128 * 72;
  const int lrow = wm * 64 + 4 * hh;
  __syncthreads();
#pragma unroll
  for (int j = 0; j < 2; ++j)
#pragma unroll
    for (int i = 0; i < 2; ++i)
#pragma unroll
      for (int r = 0; r < 16; ++r) {
        const int m = lrow + i * 32 + 8 * (r >> 2) + (r & 3);
        const bf16 v = f2bf(acc[i][j][r] * rowscale[m]);
        if (wn == 0) TK[m * 72 + j * 32 + l31] = v;
        else TV[(j * 32 + l31) * 136 + m] = v;
      }
  __syncthreads();
  {
    bf16* KNt = (bf16*)(p.ws + OFF_KN) + ((size_t)bh * KTOT + kbase) * 64;
    bf16* VTt = (bf16*)(p.ws + OFF_VT) + (size_t)bh * 64 * KTOT + kbase;
#pragma unroll
    for (int i = 0; i < 4; ++i) {
      const int id = tid + 256 * i;
      { const int row = id >> 3, c = id & 7; *(u32x4*)(KNt + (size_t)row * 64 + c * 8) = *(const u32x4*)(TK + row * 72 + c * 8); }
      { const int dv = id >> 4, c = id & 15; *(u32x4*)(VTt + (size_t)dv * KTOT + c * 8) = *(const u32x4*)(TV + dv * 136 + c * 8); }
    }
  }
}

DI void krope_item(const Params& p, int tm) {
  const int tid = opaque_tid();
  const bf16* Z = (const bf16*)(p.ws + OFF_Z);
  bf16* KR = (bf16*)(p.ws + OFF_KR);
  const float2* rope = (const float2*)(p.ws + OFF_ROPE);
  int tok = tm * 128 + (tid >> 1), half = tid & 1;
  const bool lat = tok < NTL;
  int b = lat ? (tok >> 12) : ((tok - NTL) >> 8);
  int pos = lat ? (tok & 4095) : ((tok - NTL) & 255);
  int kpos = lat ? pos : 4096 + pos;
  const uint4* src = (const uint4*)(Z + (size_t)tok * ZS + 1152 + half * 16);
  uint4 u0 = src[0], u1 = src[1];
  float z[16];
  z[0] = bflo(u0.x); z[1] = bfhi(u0.x); z[2] = bflo(u0.y); z[3] = bfhi(u0.y);
  z[4] = bflo(u0.z); z[5] = bfhi(u0.z); z[6] = bflo(u0.w); z[7] = bfhi(u0.w);
  z[8] = bflo(u1.x); z[9] = bfhi(u1.x); z[10] = bflo(u1.y); z[11] = bfhi(u1.y);
  z[12] = bflo(u1.z); z[13] = bfhi(u1.z); z[14] = bflo(u1.w); z[15] = bfhi(u1.w);
  float o[16];
  if (lat) {
    int ap2 = half ? (pos & 63) : (pos >> 6);
#pragma unroll
    for (int jj = 0; jj < 8; ++jj) {
      float2 cs = rope[ap2 * 8 + jj];
      o[jj] = z[jj] * cs.x - z[8 + jj] * cs.y;
      o[8 + jj] = z[8 + jj] * cs.x + z[jj] * cs.y;
    }
  } else {
#pragma unroll
    for (int jj = 0; jj < 16; ++jj) o[jj] = z[jj];
  }
  uint4 w0, w1;
  w0.x = pack2(o[0], o[1]); w0.y = pack2(o[2], o[3]); w0.z = pack2(o[4], o[5]); w0.w = pack2(o[6], o[7]);
  w1.x = pack2(o[8], o[9]); w1.y = pack2(o[10], o[11]); w1.z = pack2(o[12], o[13]); w1.w = pack2(o[14], o[15]);
  uint4* dst = (uint4*)(KR + ((size_t)b * KTOT + kpos) * 32 + half * 16);
  dst[0] = w0; dst[1] = w1;
}

DI void gmlp_item(const Params& p, int l, int c, char* smem) {
  const int tid = opaque_tid(), lane = tid & 63, w = tid >> 6, l31 = lane & 31, hh = lane >> 5;
  bf16* vT = (bf16*)smem;
  float* st = (float*)(smem + 128 * 136 * 2);
  float* lng = st + 256;
  float* lnb = lng + 256;
  float* sgbs = lnb + 256;
  const bf16* Z = (const bf16*)(p.ws + OFF_Z);
  bf16* Y = (bf16*)(p.ws + OFF_Y);
  const bf16* SGW = (const bf16*)(p.ws + OFF_SGW + l * SZ_SGW1);
  const int tok0 = c * 128;
  __syncthreads();
  lng[tid] = p.in[I_SGLNG][l * 256 + tid]; lnb[tid] = p.in[I_SGLNB][l * 256 + tid];
  sgbs[tid] = p.in[I_SGB][l * 512 + tid]; sgbs[256 + tid] = p.in[I_SGB][l * 512 + 256 + tid];
  {
    int t = tid >> 1, half = tid & 1;
    const uint4* src = (const uint4*)(Z + (size_t)(tok0 + t) * ZS + 256 + half * 128);
    float s = 0.f, q = 0.f;
#pragma unroll 4
    for (int i = 0; i < 16; ++i) {
      uint4 u = src[i];
      float a0 = bflo(u.x), a1 = bfhi(u.x), a2 = bflo(u.y), a3 = bfhi(u.y), a4 = bflo(u.z), a5 = bfhi(u.z), a6 = bflo(u.w), a7 = bfhi(u.w);
      s += a0 + a1 + a2 + a3 + a4 + a5 + a6 + a7;
      q += a0 * a0 + a1 * a1 + a2 * a2 + a3 * a3 + a4 * a4 + a5 * a5 + a6 * a6 + a7 * a7;
    }
    s += shx(s, 1); q += shx(q, 1);
    float mean = s * (1.f / 256.f);
    float var = fmaxf(q * (1.f / 256.f) - mean * mean, 0.f);
    if (half == 0) { st[2 * t] = mean; st[2 * t + 1] = rsqrtf(var + LN_EPS); }
  }
  for (int rd = 0; rd < 2; ++rd) {
    __syncthreads();
#pragma unroll 2
    for (int i = 0; i < 8; ++i) {
      int id = tid + 256 * i;
      int t = id & 127, cc = id >> 7;
      int ch0 = rd * 128 + cc * 8;
      uint4 u = *(const uint4*)(Z + (size_t)(tok0 + t) * ZS + 256 + ch0);
      float mean = st[2 * t], rstd = st[2 * t + 1];
      float a[8] = {bflo(u.x), bfhi(u.x), bflo(u.y), bfhi(u.y), bflo(u.z), bfhi(u.z), bflo(u.w), bfhi(u.w)};
#pragma unroll
      for (int e = 0; e < 8; ++e) {
        float g = lng[ch0 + e], bb = lnb[ch0 + e];
        vT[(cc * 8 + e) * 136 + t] = f2bf((a[e] - mean) * rstd * g + bb);
      }
    }
    __syncthreads();
    const int g = 2 * rd + (w >> 1), tb2 = w & 1;
    f32x16 acc[2][2];
#pragma unroll
    for (int i = 0; i < 2; ++i)
#pragma unroll
      for (int j = 0; j < 2; ++j) acc[i][j] = fzero();
#pragma unroll 2
    for (int ks = 0; ks < 8; ++ks) {
      bf16x8 af[2], bfr[2];
#pragma unroll
      for (int i = 0; i < 2; ++i) af[i] = *(const bf16x8*)(SGW + ((size_t)g * 128 + tb2 * 64 + i * 32 + l31) * 128 + ks * 16 + hh * 8);
#pragma unroll
      for (int j = 0; j < 2; ++j) bfr[j] = *(const bf16x8*)&vT[((w >> 1) * 64 + j * 32 + l31) * 136 + ks * 16 + hh * 8];
#pragma unroll
      for (int i = 0; i < 2; ++i)
#pragma unroll
        for (int j = 0; j < 2; ++j) acc[i][j] = mfma(af[i], bfr[j], acc[i][j]);
    }
    __syncthreads();
    {
      const float* sgb = sgbs + g * 128;
      const int lrow = tb2 * 64 + 4 * hh;
#pragma unroll
      for (int i = 0; i < 2; ++i)
#pragma unroll
        for (int j = 0; j < 2; ++j) {
          const int to = lrow * 136 + (w >> 1) * 64 + j * 32 + l31;
#pragma unroll
          for (int r = 0; r < 16; ++r) {
            const int mo = i * 32 + 8 * (r >> 2) + (r & 3);
            vT[to + mo * 136] = f2bf(acc[i][j][r] + sgb[lrow + mo]);
          }
        }
    }
    __syncthreads();
#pragma unroll 2
    for (int i = 0; i < 8; ++i) {
      const int id = tid + 256 * i, row = id >> 4, cc = id & 15;
      const u32x4 uu = *(const u32x4*)(Z + (size_t)(tok0 + row) * ZS + rd * 128 + cc * 8);
      const u32x4 mm = *(const u32x4*)(vT + row * 136 + cc * 8);
      u32x4 o;
      o.x = pack2(bflo(uu.x) * bflo(mm.x), bfhi(uu.x) * bfhi(mm.x));
      o.y = pack2(bflo(uu.y) * bflo(mm.y), bfhi(uu.y) * bfhi(mm.y));
      o.z = pack2(bflo(uu.z) * bflo(mm.z), bfhi(uu.z) * bfhi(mm.z));
      o.w = pack2(bflo(uu.w) * bflo(mm.w), bfhi(uu.w) * bfhi(mm.w));
      *(u32x4*)(Y + (size_t)(tok0 + row) * 1024 + rd * 128 + cc * 8) = o;
    }
  }
}

DI float conv_silu(const Params& p, int l, const bf16* Z, int seq0, int slen, int pos, int zcol, int ch) {
  float a = p.in[I_CONVB][l * 512 + ch];
#pragma unroll
  for (int tap = 0; tap < 5; ++tap) {
    int pp = pos + tap - 2;
    if (pp >= 0 && pp < slen) a += p.in[I_CONVW][(l * 5 + tap) * 512 + ch] * bf2f(Z[(size_t)(seq0 + pp) * ZS + zcol]);
  }
  return silu_f(a);
}
DI void conv16(const Params& p, int l, const bf16* Zcol, int slen, int pos_start, int ch, float (&out)[16]) {
  float wgt[5];
#pragma unroll
  for (int tap = 0; tap < 5; ++tap) wgt[tap] = p.in[I_CONVW][(l * 5 + tap) * 512 + ch];
  const float bias = p.in[I_CONVB][l * 512 + ch];
  float x[20];
#pragma unroll
  for (int i = 0; i < 20; ++i) {
    int pp = pos_start - 2 + i;
    x[i] = (pp >= 0 && pp < slen) ? bf2f(Zcol[(size_t)pp * ZS]) : 0.f;
  }
#pragma unroll
  for (int i = 0; i < 16; ++i) {
    float a = bias;
#pragma unroll
    for (int tap = 0; tap < 5; ++tap) a += wgt[tap] * x[i + tap];
    out[i] = silu_f(a);
  }
}
DI void stage_rows68(const bf16* Zseq  , int slen, int pos_start, bf16* raw) {
  const int tid = opaque_tid();
#pragma unroll
  for (int i = 0; i < 3; ++i) {
    const int id = tid + 256 * i;
    if (id < 68 * 8) {
      const int row = id >> 3, c = id & 7, pp = pos_start - 2 + row;
      u32x4 u = {0u, 0u, 0u, 0u};
      if (pp >= 0 && pp < slen) u = *(const u32x4*)(Zseq + (size_t)pp * ZS + c * 8);
      *(u32x4*)(raw + row * 64 + c * 8) = u;
    }
  }
}
DI void conv16_lds(const Params& p, int l, const bf16* rawcol  , int row0, int ch, float (&out)[16]) {
  float wgt[5];
#pragma unroll
  for (int tap = 0; tap < 5; ++tap) wgt[tap] = p.in[I_CONVW][(l * 5 + tap) * 512 + ch];
  const float bias = p.in[I_CONVB][l * 512 + ch];
  float x[20];
#pragma unroll
  for (int i = 0; i < 20; ++i) x[i] = bf2f(rawcol[(row0 + i) * 64]);
#pragma unroll
  for (int i = 0; i < 16; ++i) {
    float a = bias;
#pragma unroll
    for (int tap = 0; tap < 5; ++tap) a += wgt[tap] * x[i + tap];
    out[i] = silu_f(a);
  }
}
DI float log_sigmoid_f(float x) { return fminf(x, 0.f) - __logf(1.f + __expf(-fabsf(x))); }

DI void ml1_item(const Params& p, int l, int b, int h, int c, char* smem) {
  const int tid = opaque_tid(), lane = tid & 63, w = tid >> 6, l31 = lane & 31, hh = lane >> 5;
  bf16* kT = (bf16*)smem;
  bf16* wvT = kT + 64 * 72;
  float* lf = (float*)(wvT + 2 * 64 * 72);
  float* li = lf + 128;
  float* wv = li + 128;
  float* misc = wv + 128;
  bf16* kraw = (bf16*)(misc + 4);
  bf16* vraw = kraw + 68 * 64;
  const bf16* Z = (const bf16*)(p.ws + OFF_Z);
  const float* G = (const float*)(p.ws + OFF_GATES);
  int seq0, slen, pos0;
  if (c < 64) { seq0 = b * 4096; slen = 4096; pos0 = c * 64; } else { seq0 = NTL + b * 256; slen = 256; pos0 = (c - 64) * 64; }
  const int bh = b * 4 + h;
  __syncthreads();
  if (tid < 128) {
    int dir = tid >> 6, s = tid & 63;
    const float* g = G + (size_t)(seq0 + pos0 + s) * 16 + dir * 8 + h;
    li[tid] = g[0];
    lf[tid] = log_sigmoid_f(g[4] + p.in[I_FBIAS][l * 8 + dir * 4 + h]);
  }
  stage_rows68(Z + (size_t)seq0 * ZS + 1440 + h * 64, slen, pos0, kraw);
#pragma unroll
  for (int i = 0; i < 2; ++i) {
    const int id = tid + 256 * i, row = id >> 3, cc = id & 7;
    *(u32x4*)(vraw + row * 64 + cc * 8) = *(const u32x4*)(Z + (size_t)(seq0 + pos0 + row) * ZS + 1696 + h * 64 + cc * 8);
  }
  __syncthreads();
  {
    const int j = tid & 63, sg = tid >> 6;
    float kk[16];
    conv16_lds(p, l, kraw + j, sg * 16, 256 + h * 64 + j, kk);
#pragma unroll
    for (int i = 0; i < 16; i += 2) *(unsigned*)&kT[j * 72 + sg * 16 + i] = pack2(kk[i] * 0.125f, kk[i + 1] * 0.125f);
  }
  __syncthreads();
  if (w < 2) {
    const int dir = w, sidx = dir ? 63 - lane : lane;
    float cum = wave_scan_add(lf[dir * 64 + sidx]);
    float bend = __int_as_float(__builtin_amdgcn_readlane(__float_as_int(cum), 63));
    float g = bend - cum + li[dir * 64 + sidx];
    float mloc = wave_max(g);
    wv[dir * 64 + sidx] = __expf(g - mloc);
    if (lane == 0) { misc[dir * 2] = mloc; misc[dir * 2 + 1] = bend; }
  }
  __syncthreads();
  for (int e = tid; e < 4096; e += NTHR) {
    int s = e >> 6, i = e & 63;
    float v = bf2f(vraw[s * 64 + i]);
    wvT[i * 72 + s] = f2bf(v * wv[s]);
    wvT[(64 + i) * 72 + s] = f2bf(v * wv[64 + s]);
  }
  __syncthreads();
  float* SC = (float*)((char*)p.out + OOFF_SC);
  float* SN = (float*)((char*)p.out + OOFF_SN);
  float* SM = (float*)(p.ws + OFF_SM);
  {
    const int dir = w >> 1, ib = w & 1;
    f32x16 acc[2]; acc[0] = fzero(); acc[1] = fzero();
#pragma unroll
    for (int ks = 0; ks < 4; ++ks) {
      bf16x8 a = *(const bf16x8*)&wvT[(dir * 64 + ib * 32 + l31) * 72 + ks * 16 + hh * 8];
#pragma unroll
      for (int jb = 0; jb < 2; ++jb) {
        bf16x8 bb = *(const bf16x8*)&kT[(jb * 32 + l31) * 72 + ks * 16 + hh * 8];
        acc[jb] = mfma(a, bb, acc[jb]);
      }
    }
    float* dst = SC + ((size_t)(bh * 2 + dir) * 68 + c) * 4096;
#pragma unroll
    for (int jb = 0; jb < 2; ++jb)
#pragma unroll
      for (int r = 0; r < 16; ++r) dst[(ib * 32 + crow(r, hh)) * 64 + jb * 32 + l31] = acc[jb][r];
  }
  if (tid < 128) {
    int dir = tid >> 6, j = tid & 63;
    float a = 0.f;
#pragma unroll 16
    for (int s = 0; s < 64; ++s) a += wv[dir * 64 + s] * bf2f(kT[j * 72 + s]);
    SN[((size_t)(bh * 2 + dir) * 68 + c) * 64 + j] = a;
  }
  if (tid == 0 || tid == 64) {
    int dir = tid >> 6;
    float* sm = SM + ((size_t)(bh * 2 + dir) * 68 + c) * 4;
    sm[0] = misc[dir * 2]; sm[1] = misc[dir * 2 + 1];
  }
}

DI void ml2_item(const Params& p, int it, char* smem) {
  const int tid = opaque_tid();
  const int eb = it & 3, bd = it >> 2;
  const int dir = bd & 1;
  float* aa = (float*)smem;
  float* ss = aa + 68;
  float* SC = (float*)((char*)p.out + OOFF_SC) + (size_t)bd * 68 * 4096;
  float* SN = (float*)((char*)p.out + OOFF_SN) + (size_t)bd * 68 * 64;
  float* SM = (float*)(p.ws + OFF_SM) + (size_t)bd * 68 * 4;
  float* mls = ss + 68;
  float* bes = mls + 68;
  float* m0s = bes + 68;
  __syncthreads();
  if (tid < 68) { mls[tid] = SM[tid * 4]; bes[tid] = SM[tid * 4 + 1]; }
  __syncthreads();
  if (tid == 0) {
    float m = 0.f;
    for (int n = 0; n < 68; ++n) {
      int c = (n < 4) ? (dir ? 67 - n : 64 + n) : (dir ? 67 - n : n - 4);
      float ml = mls[c], be = bes[c];
      float mn = fmaxf(be + m, ml);
      aa[n] = __expf(be + m - mn);
      ss[n] = __expf(ml - mn);
      m0s[c] = m;
      m = mn;
    }
  }
  __syncthreads();
  if (eb == 0 && tid < 68) SM[tid * 4 + 2] = m0s[tid];
  {
    typedef __attribute__((ext_vector_type(4))) float f32x4v;
    const int e = (eb * 256 + tid) * 4;
    f32x4v C = {0.f, 0.f, 0.f, 0.f};
#pragma unroll 1
    for (int n0 = 0; n0 < 68; n0 += 17) {
      f32x4v cl[17];
#pragma unroll
      for (int u = 0; u < 17; ++u) {
        const int n = n0 + u;
        const int c = (n < 4) ? (dir ? 67 - n : 64 + n) : (dir ? 67 - n : n - 4);
        cl[u] = *(const f32x4v*)(SC + (size_t)c * 4096 + e);
      }
#pragma unroll
      for (int u = 0; u < 17; ++u) {
        const int n = n0 + u;
        const int c = (n < 4) ? (dir ? 67 - n : 64 + n) : (dir ? 67 - n : n - 4);
        *(f32x4v*)(SC + (size_t)c * 4096 + e) = C;
        C = aa[n] * C + ss[n] * cl[u];
      }
    }
  }
  if (eb == 0 && tid < 64) {
    float cl[68];
#pragma unroll
    for (int n = 0; n < 68; ++n) {
      const int c = (n < 4) ? (dir ? 67 - n : 64 + n) : (dir ? 67 - n : n - 4);
      cl[n] = SN[c * 64 + tid];
    }
    float C = 0.f;
#pragma unroll
    for (int n = 0; n < 68; ++n) {
      const int c = (n < 4) ? (dir ? 67 - n : 64 + n) : (dir ? 67 - n : n - 4);
      SN[c * 64 + tid] = C;
      C = aa[n] * C + ss[n] * cl[n];
    }
  }
}

DI void ml3_item(const Params& p, int l, int b, int h, int c, char* smem) {
  const int tid = opaque_tid(), lane = tid & 63, w = tid >> 6, l31 = lane & 31, hh = lane >> 5;
  bf16* qs = (bf16*)smem;
  bf16* ks_ = qs + 64 * 72;
  bf16* vT = ks_ + 64 * 72;
  float* hbuf = (float*)(vT + 64 * 72);
  float* lf = hbuf + 64 * 65;
  float* li = lf + 128;
  float* bc = li + 128;
  float* cv = bc + 128;
  float* mt = cv + 128;
  float* n0s = mt + 128;
  float* m0s = n0s + 128;
  bf16* qraw = (bf16*)(m0s + 4);
  bf16* kraw = qraw + 68 * 64;
  const bf16* Z = (const bf16*)(p.ws + OFF_Z);
  const float* G = (const float*)(p.ws + OFF_GATES);
  bf16* Y = (bf16*)(p.ws + OFF_Y);
  int seq0, slen, pos0;
  if (c < 64) { seq0 = b * 4096; slen = 4096; pos0 = c * 64; } else { seq0 = NTL + b * 256; slen = 256; pos0 = (c - 64) * 64; }
  const int bh = b * 4 + h;
  const float* SC = (const float*)((char*)p.out + OOFF_SC);
  const float* SN = (const float*)((char*)p.out + OOFF_SN);
  const float* SM = (const float*)(p.ws + OFF_SM);
  __syncthreads();
  if (tid < 128) {
    int dir = tid >> 6, s = tid & 63;
    const float* g = G + (size_t)(seq0 + pos0 + s) * 16 + dir * 8 + h;
    li[tid] = g[0];
    lf[tid] = log_sigmoid_f(g[4] + p.in[I_FBIAS][l * 8 + dir * 4 + h]);
    n0s[tid] = SN[((size_t)(bh * 2 + dir) * 68 + c) * 64 + s];
  }
  if (tid < 2) m0s[tid] = SM[((size_t)(bh * 2 + tid) * 68 + c) * 4 + 2];
  stage_rows68(Z + (size_t)seq0 * ZS + 1184 + h * 64, slen, pos0, qraw);
  stage_rows68(Z + (size_t)seq0 * ZS + 1440 + h * 64, slen, pos0, kraw);
#pragma unroll
  for (int i = 0; i < 2; ++i) {
    const int id = tid + 256 * i, row = id >> 3, cc = id & 7;
    u32x4 u = *(const u32x4*)(Z + (size_t)(seq0 + pos0 + row) * ZS + 1696 + h * 64 + cc * 8);
    bf16* d = vT + (cc * 8) * 72 + row;
    d[0 * 72] = (bf16)(u.x & 0xffffu); d[1 * 72] = (bf16)(u.x >> 16);
    d[2 * 72] = (bf16)(u.y & 0xffffu); d[3 * 72] = (bf16)(u.y >> 16);
    d[4 * 72] = (bf16)(u.z & 0xffffu); d[5 * 72] = (bf16)(u.z >> 16);
    d[6 * 72] = (bf16)(u.w & 0xffffu); d[7 * 72] = (bf16)(u.w >> 16);
  }
  __syncthreads();
  {
    const int j = tid & 63, sg = tid >> 6;
    float qq[16], kk[16];
    conv16_lds(p, l, qraw + j, sg * 16, h * 64 + j, qq);
    conv16_lds(p, l, kraw + j, sg * 16, 256 + h * 64 + j, kk);
#pragma unroll
    for (int i = 0; i < 16; ++i) {
      qs[(sg * 16 + i) * 72 + j] = f2bf(qq[i]);
      ks_[(sg * 16 + i) * 72 + j] = f2bf(kk[i] * 0.125f);
    }
  }
  __syncthreads();
  if (w < 2) {
    const int dr = w, sidx = dr ? 63 - lane : lane;
    float cum = wave_scan_add(lf[dr * 64 + sidx]);
    float x = li[dr * 64 + sidx] - cum;
    float pm = wave_scan_max(x);
    bc[dr * 64 + sidx] = cum; cv[dr * 64 + sidx] = x;
    mt[dr * 64 + sidx] = fmaxf(cum + m0s[dr], cum + pm);
  }
  __syncthreads();
  const int dir = w >> 1, tb = w & 1;
  const int t = tb * 32 + l31;
  bf16x8 qf[4];
#pragma unroll
  for (int ks = 0; ks < 4; ++ks) qf[ks] = *(const bf16x8*)&qs[t * 72 + ks * 16 + hh * 8];
  f32x16 sacc[2]; sacc[0] = fzero(); sacc[1] = fzero();
#pragma unroll
  for (int sb = 0; sb < 2; ++sb)
#pragma unroll
    for (int ks = 0; ks < 4; ++ks) {
      bf16x8 a = *(const bf16x8*)&ks_[(sb * 32 + l31) * 72 + ks * 16 + hh * 8];
      sacc[sb] = mfma(a, qf[ks], sacc[sb]);
    }
  const float bt = bc[dir * 64 + t], mtt = mt[dir * 64 + t], m0d = m0s[dir];
  const float base = bt - mtt;
  float psum = 0.f;
#pragma unroll
  for (int sb = 0; sb < 2; ++sb)
#pragma unroll
    for (int r = 0; r < 16; ++r) {
      int s = sb * 32 + crow(r, hh);
      bool valid = dir ? (s >= t) : (s <= t);
      float pv = valid ? __expf(base + cv[dir * 64 + s]) * sacc[sb][r] : 0.f;
      psum += pv;
      sacc[sb][r] = pv;
    }
  psum += shx(psum, 32);
  f32x16 num1[2], num2[2];
  num1[0] = fzero(); num1[1] = fzero(); num2[0] = fzero(); num2[1] = fzero();
#pragma unroll
  for (int slab = 0; slab < 4; ++slab) {
    const int sb = slab >> 1, s2 = slab & 1;
    uint4 pu;
    pu.x = pack2(sacc[sb][8 * s2 + 0], sacc[sb][8 * s2 + 1]);
    pu.y = pack2(sacc[sb][8 * s2 + 2], sacc[sb][8 * s2 + 3]);
    pu.z = pack2(sacc[sb][8 * s2 + 4], sacc[sb][8 * s2 + 5]);
    pu.w = pack2(sacc[sb][8 * s2 + 6], sacc[sb][8 * s2 + 7]);
    bf16x8 pf = __builtin_bit_cast(bf16x8, pu);
#pragma unroll
    for (int ib = 0; ib < 2; ++ib) {
      uint2 lo = *(const uint2*)&vT[(ib * 32 + l31) * 72 + slab * 16 + 4 * hh];
      uint2 hi = *(const uint2*)&vT[(ib * 32 + l31) * 72 + slab * 16 + 8 + 4 * hh];
      uint4 au; au.x = lo.x; au.y = lo.y; au.z = hi.x; au.w = hi.y;
      num2[ib] = mfma(__builtin_bit_cast(bf16x8, au), pf, num2[ib]);
    }
  }
  {
    const float* C0 = SC + ((size_t)(bh * 2 + dir) * 68 + c) * 4096;
#pragma unroll
    for (int ib = 0; ib < 2; ++ib)
#pragma unroll
      for (int ks = 0; ks < 4; ++ks) {
        const float4* src = (const float4*)(C0 + (ib * 32 + l31) * 64 + ks * 16 + hh * 8);
        float4 f0 = src[0], f1 = src[1];
        uint4 au; au.x = pack2(f0.x, f0.y); au.y = pack2(f0.z, f0.w); au.z = pack2(f1.x, f1.y); au.w = pack2(f1.z, f1.w);
        num1[ib] = mfma(__builtin_bit_cast(bf16x8, au), qf[ks], num1[ib]);
      }
  }
  float nq = 0.f;
#pragma unroll
  for (int ks = 0; ks < 4; ++ks)
#pragma unroll
    for (int e = 0; e < 8; ++e) nq += bf2f((bf16)qf[ks][e]) * n0s[dir * 64 + ks * 16 + hh * 8 + e];
  nq += shx(nq, 32);
  const float inter = __expf(bt + m0d - mtt);
  const float den = inter * nq + psum;
  const float inv = 1.f / fmaxf(fabsf(den), __expf(-mtt));
#pragma unroll
  for (int ib = 0; ib < 2; ++ib)
#pragma unroll
    for (int r = 0; r < 16; ++r) num2[ib][r] = (inter * num1[ib][r] + num2[ib][r]) * inv;
  if (dir == 1) {
#pragma unroll
    for (int ib = 0; ib < 2; ++ib)
#pragma unroll
      for (int r = 0; r < 16; ++r) hbuf[t * 65 + ib * 32 + crow(r, hh)] = num2[ib][r];
  }
  __syncthreads();
  if (dir == 0) {
    float s = 0.f;
#pragma unroll
    for (int ib = 0; ib < 2; ++ib)
#pragma unroll
      for (int r = 0; r < 16; ++r) { num2[ib][r] += hbuf[t * 65 + ib * 32 + crow(r, hh)]; s += num2[ib][r]; }
    s += shx(s, 32);
    float mean = s * (1.f / 64.f);
    float q = 0.f;
#pragma unroll
    for (int ib = 0; ib < 2; ++ib)
#pragma unroll
      for (int r = 0; r < 16; ++r) { num2[ib][r] -= mean; q += num2[ib][r] * num2[ib][r]; }
    q += shx(q, 32);
    float rstd = rsqrtf(q * (1.f / 64.f) + LN_EPS);
    const int tok = seq0 + pos0 + t;
#pragma unroll
    for (int ib = 0; ib < 2; ++ib)
#pragma unroll
      for (int rg = 0; rg < 4; ++rg) {
        int i0 = ib * 32 + 8 * rg + 4 * hh;
        uint2 ou = *(const uint2*)&Z[(size_t)tok * ZS + 1952 + h * 64 + i0];
        float og[4] = {bflo(ou.x), bfhi(ou.x), bflo(ou.y), bfhi(ou.y)};
        float y[4];
#pragma unroll
        for (int e = 0; e < 4; ++e) y[e] = num2[ib][4 * rg + e] * rstd * p.in[I_MLNG][l * 256 + h * 64 + i0 + e] * sigmoid_f(og[e]);
        uint2 o; o.x = pack2(y[0], y[1]); o.y = pack2(y[2], y[3]);
        *(uint2*)&Y[(size_t)tok * 1024 + 768 + h * 64 + i0] = o;
      }
  }
}

DI void attn_item(const Params& p, int b, int h, int q0, int key0, int nkt, int tok0, char* smem) {
  const int tid = opaque_tid(), lane = tid & 63, w = tid >> 6, l31 = lane & 31, hh = lane >> 5;
  bf16* Ks = (bf16*)smem;
  bf16* Vs = Ks + 64 * 104;
  bf16* Qs = Vs + 64 * 72;
  const bf16* Q = (const bf16*)((const char*)p.out + OOFF_Q);
  const bf16* KN = (const bf16*)(p.ws + OFF_KN);
  const bf16* VT = (const bf16*)(p.ws + OFF_VT);
  const bf16* KR = (const bf16*)(p.ws + OFF_KR);
  bf16* Y = (bf16*)(p.ws + OFF_Y);
  const int bh = b * 8 + h;
  __syncthreads();
  {
    const bf16* qsrc = Q + ((size_t)bh * KTOT + q0) * 96;
#pragma unroll 4
    for (int i = 0; i < 12; ++i) {
      const int id = tid + 256 * i, row = id / 12, c = id - row * 12;
      *(u32x4*)&Qs[row * 104 + c * 8] = *(const u32x4*)(qsrc + (size_t)row * 96 + c * 8);
    }
  }
  f32x16 o[2][2];
#pragma unroll
  for (int qb = 0; qb < 2; ++qb) { o[qb][0] = fzero(); o[qb][1] = fzero(); }
  float mrun[2] = {-INFINITY, -INFINITY}, lrun[2] = {0.f, 0.f};
  u32x4 pkA[2], pvA[2], prA, pkB[2], pvB[2], prB;
  const bf16* knp[2]; const bf16* vtp[2];
#pragma unroll
  for (int i = 0; i < 2; ++i) {
    int id = tid + 256 * i, row = id >> 3, ch = id & 7;
    knp[i] = KN + ((size_t)bh * KTOT + key0 + row) * 64 + ch * 8;
    vtp[i] = VT + ((size_t)bh * 64 + row) * KTOT + key0 + ch * 8;
  }
  const bf16* krp = KR + ((size_t)b * KTOT + key0 + (tid >> 2)) * 32 + (tid & 3) * 8;
#pragma unroll
  for (int i = 0; i < 2; ++i) { pkA[i] = *(const u32x4*)knp[i]; pvA[i] = *(const u32x4*)vtp[i]; }
  prA = *(const u32x4*)krp;
#pragma unroll
  for (int i = 0; i < 2; ++i) { pkB[i] = *(const u32x4*)(knp[i] + 64 * 64); pvB[i] = *(const u32x4*)(vtp[i] + 64); }
  prB = *(const u32x4*)(krp + 64 * 32);
  auto tstep = [&](u32x4 (&pk)[2], u32x4 (&pv)[2], u32x4& pr, int knext) {
    __syncthreads();
#pragma unroll
    for (int i = 0; i < 2; ++i) {
      int id = tid + 256 * i, row = id >> 3, ch = id & 7;
      *(u32x4*)&Ks[row * 104 + ch * 8] = pk[i];
      *(u32x4*)&Vs[row * 72 + ch * 8] = pv[i];
    }
    *(u32x4*)&Ks[(tid >> 2) * 104 + 64 + (tid & 3) * 8] = pr;
    __syncthreads();
    if (knext < nkt) {
#pragma unroll
      for (int i = 0; i < 2; ++i) {
        pk[i] = *(const u32x4*)(knp[i] + (size_t)knext * 64 * 64);
        pv[i] = *(const u32x4*)(vtp[i] + knext * 64);
      }
      pr = *(const u32x4*)(krp + (size_t)knext * 64 * 32);
    }
#pragma unroll
    for (int qb = 0; qb < 2; ++qb) {
      bf16x8 qf[6];
#pragma unroll
      for (int ks = 0; ks < 6; ++ks) qf[ks] = *(const bf16x8*)&Qs[(w * 64 + qb * 32 + l31) * 104 + ks * 16 + hh * 8];
      const float mref0 = mrun[qb] == -INFINITY ? 0.f : mrun[qb];
      f32x16 s[2];
#pragma unroll
      for (int r = 0; r < 16; ++r) { s[0][r] = -mref0; s[1][r] = -mref0; }
#pragma unroll
      for (int kb = 0; kb < 2; ++kb)
#pragma unroll
        for (int ks = 0; ks < 6; ++ks) {
          bf16x8 a = *(const bf16x8*)&Ks[(kb * 32 + l31) * 104 + ks * 16 + hh * 8];
          s[kb] = mfma(a, qf[ks], s[kb]);
        }
      float mx = fmaxf(s[0][0], s[1][0]);
#pragma unroll
      for (int r = 1; r < 16; ++r) mx = fmaxf(fmaxf(mx, s[0][r]), s[1][r]);
      mx = fmaxf(mx, shx(mx, 32));
      if (__builtin_amdgcn_ballot_w64(mrun[qb] == -INFINITY || mx > 8.f) != 0ull) {
        const float d = fmaxf(mx, 0.f);
        const float mnew = (mrun[qb] == -INFINITY) ? mx : mref0 + d;
        const float shift = mnew - mref0;
        const float alpha = (mrun[qb] == -INFINITY) ? 0.f : __builtin_amdgcn_exp2f(-shift);
        mrun[qb] = mnew;
        lrun[qb] *= alpha;
#pragma unroll
        for (int db = 0; db < 2; ++db)
#pragma unroll
          for (int r = 0; r < 16; ++r) o[qb][db][r] *= alpha;
#pragma unroll
        for (int kb = 0; kb < 2; ++kb)
#pragma unroll
          for (int r = 0; r < 16; ++r) s[kb][r] -= shift;
      }
      float rs = 0.f;
#pragma unroll
      for (int kb = 0; kb < 2; ++kb)
#pragma unroll
        for (int r = 0; r < 16; ++r) { float e = __builtin_amdgcn_exp2f(s[kb][r]); s[kb][r] = e; rs += e; }
      lrun[qb] += rs;
#pragma unroll
      for (int slab = 0; slab < 4; ++slab) {
        const int kb = slab >> 1, s2 = slab & 1;
        uint4 pu;
        pu.x = pack2(s[kb][8 * s2 + 0], s[kb][8 * s2 + 1]);
        pu.y = pack2(s[kb][8 * s2 + 2], s[kb][8 * s2 + 3]);
        pu.z = pack2(s[kb][8 * s2 + 4], s[kb][8 * s2 + 5]);
        pu.w = pack2(s[kb][8 * s2 + 6], s[kb][8 * s2 + 7]);
        bf16x8 pf = __builtin_bit_cast(bf16x8, pu);
#pragma unroll
        for (int db = 0; db < 2; ++db) {
          uint2 lo = *(const uint2*)&Vs[(db * 32 + l31) * 72 + slab * 16 + 4 * hh];
          uint2 hi = *(const uint2*)&Vs[(db * 32 + l31) * 72 + slab * 16 + 8 + 4 * hh];
          uint4 au; au.x = lo.x; au.y = lo.y; au.z = hi.x; au.w = hi.y;
          o[qb][db] = mfma(__builtin_bit_cast(bf16x8, au), pf, o[qb][db]);
        }
      }
    }
  };
  for (int kt = 0; kt < nkt; kt += 2) {
    tstep(pkA, pvA, prA, kt + 2);
    tstep(pkB, pvB, prB, kt + 3);
  }
#pragma unroll
  for (int qb = 0; qb < 2; ++qb) {
    const float lsum = lrun[qb] + shx(lrun[qb], 32);
    const float inv = 1.f / lsum;
    const int tok = tok0 + w * 64 + qb * 32 + l31;
#pragma unroll
    for (int db = 0; db < 2; ++db)
#pragma unroll
      for (int rg = 0; rg < 4; ++rg) {
        int dv = db * 32 + 8 * rg + 4 * hh;
        uint2 ou;
        ou.x = pack2(o[qb][db][4 * rg] * inv, o[qb][db][4 * rg + 1] * inv);
        ou.y = pack2(o[qb][db][4 * rg + 2] * inv, o[qb][db][4 * rg + 3] * inv);
        *(uint2*)&Y[(size_t)tok * 1024 + 256 + h * 64 + dv] = ou;
      }
  }
}

DI void outproj_tile(const Params& p, int l, int tm, int tn, char* smem, float* R, const float* XL, const float* XC) {
  const int tid = opaque_tid(), lane = tid & 63, w = tid >> 6, wm = w >> 1, wn = w & 1, l31 = lane & 31, hh = lane >> 5;
  const bf16* A = (const bf16*)(p.ws + OFF_Y);
  const bf16* Bt = (const bf16*)(p.ws + OFF_WOUT + l * SZ_WOUT1);
  const bf16* ap[4]; const bf16* bp[4];
#pragma unroll
  for (int j = 0; j < 4; ++j) {
    int r = 32 * (tid >> 6) + 8 * j + ((tid & 63) >> 3);
    ap[j] = A + (size_t)(tm * 128 + r) * 1024;
    bp[j] = Bt + (size_t)(tn * 128 + r) * 1024;
  }
  f32x16 acc[2][2];
  gemm_core<false>(ap, bp, 1024, smem, 0.f, acc);
  const int tok0 = tm * 128;
  const float* xres = (tok0 < NTL ? (XL + (size_t)tok0 * 1024) : (XC + (size_t)(tok0 - NTL) * 1024)) + tn * 128;
  float* Rt = R + (size_t)tok0 * 1024 + tn * 128;
  const float* g1 = (const float*)(p.ws + OFF_ADA) + (size_t)(l * 9 + ada_row(tok0)) * 6144 + 2 * 1024 + tn * 128;
  float* T = (float*)smem;
#pragma unroll
  for (int half = 0; half < 2; ++half) {
    __syncthreads();
    if (wm == half) {
#pragma unroll
      for (int i = 0; i < 2; ++i)
#pragma unroll
        for (int j = 0; j < 2; ++j)
#pragma unroll
          for (int r = 0; r < 16; ++r) T[(i * 32 + crow(r, hh)) * 132 + wn * 64 + j * 32 + l31] = acc[i][j][r];
    }
    __syncthreads();
#pragma unroll 2
    for (int i = 0; i < 8; ++i) {
      const int id = tid + 256 * i, row = id >> 5, c4 = (id & 31) * 4;
      const float4 a = *(const float4*)(T + row * 132 + c4);
      const float4 g = *(const float4*)(g1 + c4);
      const float4 x = *(const float4*)(xres + (size_t)(half * 64 + row) * 1024 + c4);
      float4 o;
      o.x = ALPHA * x.x + g.x * a.x; o.y = ALPHA * x.y + g.y * a.y; o.z = ALPHA * x.z + g.z * a.z; o.w = ALPHA * x.w + g.w * a.w;
      *(float4*)(Rt + (size_t)(half * 64 + row) * 1024 + c4) = o;
    }
  }
}

DI void ln1_router_item(const Params& p, int l, int it, char* smem, float* R, const float (&wr)[16][4]) {
  const int tid = opaque_tid(), lane = tid & 63, w = tid >> 6;
  float* hrow = (float*)smem;
  float* lg = hrow + 4 * 1024;
  const int tok = it * 4 + w;
  const float* ada = (const float*)(p.ws + OFF_ADA) + (size_t)(l * 9 + ada_row(tok)) * 6144;
  float v[16];
  float* row = R + (size_t)tok * 1024;
  row_load(row, v);
  row_norm(v);
  row_affine<0>(v, p.in[I_LN1G] + l * 1024, p.in[I_LN1B] + l * 1024);
  {
    float t[16];
#pragma unroll
    for (int i = 0; i < 16; ++i) t[i] = ALPHA * v[i];
    row_store(row, t);
  }
  row_norm(v);
  row_affine<1>(v, ada + 4 * 1024, ada + 3 * 1024);
  row_store_bf((bf16*)(p.ws + OFF_Y) + (size_t)tok * 1024, v);
  if (lane == 0) ((int*)(p.ws + OFF_TOKCNT))[tok] = 0;
  __syncthreads();
  row_store(hrow + w * 1024, v);
  __syncthreads();
  float part[4][4];
#pragma unroll
  for (int r = 0; r < 4; ++r) {
    float hv[16];
    row_load(hrow + r * 1024, hv);
#pragma unroll
    for (int e = 0; e < 4; ++e) {
      float s = 0.f;
#pragma unroll
      for (int i = 0; i < 16; ++i) s += hv[i] * wr[i][e];
      part[r][e] = s;
    }
  }
#pragma unroll
  for (int r = 0; r < 4; ++r)
#pragma unroll
    for (int e = 0; e < 4; ++e) {
      float s = wave_sum(part[r][e]);
      if (lane == 0) lg[r * 16 + w * 4 + e] = s;
    }
  __syncthreads();
  if (tid < 64) {
    int r = tid >> 4, e = tid & 15;
    float mx = -INFINITY;
#pragma unroll
    for (int i = 0; i < 16; ++i) mx = fmaxf(mx, lg[r * 16 + i]);
    float sum = 0.f;
#pragma unroll
    for (int i = 0; i < 16; ++i) sum += __expf(lg[r * 16 + i] - mx);
    float a = __expf(lg[r * 16 + e] - mx) / sum;
    int tk = it * 4 + r;
    if (tk < NTL) ((float*)(p.ws + OFF_AFFL))[((size_t)((tk >> 12) * 16 + e)) * 4096 + (tk & 4095)] = a;
    else { int tc = tk - NTL; ((float*)(p.ws + OFF_AFFC))[((size_t)((tc >> 8) * 16 + e)) * 256 + (tc & 255)] = a; }
  }
}

template <int NV>
DI void topk_item(const Params& p, int be, bool is_ctx, int me, char* smem) {
  const int tid = opaque_tid(), lane = tid & 63, w = tid >> 6;
  constexpr int N = NV * 256;
  constexpr int KSEL = N / 8;
  unsigned* hist = (unsigned*)smem;
  unsigned* ctl = hist + 256;
  unsigned* wtot = ctl + 4;
  const float* src = (const float*)(p.ws + (is_ctx ? OFF_AFFC : OFF_AFFL)) + (size_t)be * N + tid * NV;
  float v[NV]; unsigned u[NV];
  if (NV == 16) {
#pragma unroll
    for (int i = 0; i < NV / 4; ++i) { float4 t = ((const float4*)src)[i]; v[4 * i] = t.x; v[4 * i + 1] = t.y; v[4 * i + 2] = t.z; v[4 * i + 3] = t.w; }
  } else {
#pragma unroll
    for (int i = 0; i < NV; ++i) v[i] = src[i];
  }
#pragma unroll
  for (int i = 0; i < NV; ++i) u[i] = __float_as_uint(v[i]);
  unsigned prefix = 0, mask = 0, remaining = KSEL;
  for (int pass = 0; pass < 4; ++pass) {
    const int shift = 24 - 8 * pass;
    __syncthreads();
    hist[tid] = 0;
    __syncthreads();
#pragma unroll
    for (int i = 0; i < NV; ++i)
      if ((u[i] & mask) == prefix) atomicAdd(&hist[(u[i] >> shift) & 255], 1u);
    __syncthreads();
    if (w == 0) {
      const unsigned h0 = hist[255 - 4 * lane], h1 = hist[254 - 4 * lane], h2 = hist[253 - 4 * lane], h3 = hist[252 - 4 * lane];
      const unsigned s4 = h0 + h1 + h2 + h3;
      const unsigned inc = wave_scan_add_u(s4);
      const unsigned exc = inc - s4;
      if ((exc < remaining && inc >= remaining) || (lane == 63 && inc < remaining)) {
        unsigned cum = exc; int d = 255 - 4 * lane;
        if (cum + h0 < remaining) { cum += h0; --d; if (cum + h1 < remaining) { cum += h1; --d; if (cum + h2 < remaining) { cum += h2; --d; } } }
        ctl[0] = prefix | ((unsigned)d << shift);
        ctl[1] = remaining - cum;
      }
    }
    __syncthreads();
    prefix = ctl[0]; remaining = ctl[1];
    mask |= 255u << shift;
  }
  const unsigned thresh = prefix;
  unsigned cgt = 0, ceq = 0;
#pragma unroll
  for (int i = 0; i < NV; ++i) { cgt += (u[i] > thresh); ceq += (u[i] == thresh); }
  unsigned sg = wave_scan_add_u(cgt), se = wave_scan_add_u(ceq);
  __syncthreads();
  if (lane == 63) { wtot[w] = sg; wtot[4 + w] = se; }
  __syncthreads();
  unsigned og = 0, oe = 0, totg = 0;
#pragma unroll
  for (int i = 0; i < 4; ++i) { if (i < w) { og += wtot[i]; oe += wtot[4 + i]; } totg += wtot[i]; }
  unsigned pg = og + sg - cgt, pe = oe + se - ceq;
  const int b = be >> 4, e = be & 15;
  int* rowtok = (int*)(p.ws + OFF_ROWTOK) + (size_t)e * MEMAX + (is_ctx ? 4096 + b * 32 : b * 512);
  float* rowgate = (float*)(p.ws + OFF_ROWGATE) + (size_t)e * MEMAX + (is_ctx ? 4096 + b * 32 : b * 512);
  const int tokbase = is_ctx ? NTL + b * 256 : b * 4096;
#pragma unroll
  for (int i = 0; i < NV; ++i) {
    int slot = -1;
    if (u[i] > thresh) slot = (int)pg++;
    else if (u[i] == thresh) { if (pe < remaining) slot = (int)(totg + pe); pe++; }
    if (slot >= 0 && slot < KSEL) {
      const int tk = tokbase + tid * NV + i;
      rowtok[slot] = tk; rowgate[slot] = v[i];
      const int c = atomicAdd((int*)(p.ws + OFF_TOKCNT) + tk, 1);
      ((int*)(p.ws + OFF_TOKLIST))[tk * 16 + c] = e * 4096 * 0 + (is_ctx ? -(e * 256 + b * 32 + slot) - 1 : e * 4096 + b * 512 + slot);
    }
  }
}

DI void moe1_tile(const Params& p, int e, int tm, int tn, char* smem) {
  const int tid = opaque_tid(), lane = tid & 63, w = tid >> 6, wm = w >> 1, wn = w & 1, l31 = lane & 31, hh = lane >> 5;
  const bf16* XM = (const bf16*)(p.ws + OFF_Y);
  const bf16* Bt = (const bf16*)(p.ws + OFF_WGU) + (size_t)e * 2048 * 1024;
  const int* rowtok = (const int*)(p.ws + OFF_ROWTOK) + (size_t)e * MEMAX;
  const bf16* ap[4]; const bf16* bp[4];
#pragma unroll
  for (int j = 0; j < 4; ++j) {
    int r = 32 * (tid >> 6) + 8 * j + ((tid & 63) >> 3);
    ap[j] = XM + (size_t)rowtok[tm * 128 + r] * 1024;
    bp[j] = Bt + (size_t)(tn * 128 + r) * 1024;
  }
  f32x16 acc[2][2];
  gemm_core<false>(ap, bp, 1024, smem, 0.f, acc);
  bf16* T = (bf16*)smem;
  __syncthreads();
  {
    const int toff = (wm * 64 + 4 * hh) * 72 + wn * 32 + l31;
#pragma unroll
    for (int i = 0; i < 2; ++i)
#pragma unroll
      for (int r = 0; r < 16; ++r) {
        const int mo = i * 32 + 8 * (r >> 2) + (r & 3);
        float g = acc[i][0][r], u = acc[i][1][r];
        T[toff + mo * 72] = f2bf(silu_f(g) * u);
      }
  }
  __syncthreads();
  {
    bf16* hid = (bf16*)(p.ws + OFF_Z) + ((size_t)e * MEMAX + tm * 128) * 1024 + 64 * tn;
#pragma unroll
    for (int i = 0; i < 4; ++i) {
      const int id = tid + 256 * i, row = id >> 3, c = id & 7;
      *(u32x4*)(hid + (size_t)row * 1024 + c * 8) = *(const u32x4*)(T + row * 72 + c * 8);
    }
  }
}

DI void moe2_tile(const Params& p, int l, int e, int tm, int tn, char* smem, bf16* YEL, bf16* YEC) {
  const int tid = opaque_tid(), lane = tid & 63, w = tid >> 6, wm = w >> 1, wn = w & 1, l31 = lane & 31, hh = lane >> 5;
  const bf16* A = (const bf16*)(p.ws + OFF_Z) + (size_t)e * MEMAX * 1024;
  const bf16* Bt = (const bf16*)(p.ws + OFF_WD) + (size_t)e * 1024 * 1024;
  const int* rowtok = (const int*)(p.ws + OFF_ROWTOK) + (size_t)e * MEMAX;
  const float* rowgate = (const float*)(p.ws + OFF_ROWGATE) + (size_t)e * MEMAX;
  const bf16* ap[4]; const bf16* bp[4];
#pragma unroll
  for (int j = 0; j < 4; ++j) {
    int r = 32 * (tid >> 6) + 8 * j + ((tid & 63) >> 3);
    ap[j] = A + (size_t)(tm * 128 + r) * 1024;
    bp[j] = Bt + (size_t)(tn * 128 + r) * 1024;
  }
  f32x16 acc[2][2];
  gemm_core<false>(ap, bp, 1024, smem, 0.f, acc);
  const int arow = tm * 128 < 4096 ? (tm * 128) >> 9 : 8;
  const float* g2 = (const float*)(p.ws + OFF_ADA) + (size_t)(l * 9 + arow) * 6144 + 5 * 1024 + tn * 128 + wn * 64 + l31;
  const float g2v0 = g2[0], g2v1 = g2[32];
  bf16* T = (bf16*)smem;
  float* gs = (float*)(smem + GEMM_LDS);
  if (tid < 128) gs[tid] = rowgate[tm * 128 + tid];
  __syncthreads();
#pragma unroll
  for (int i = 0; i < 2; ++i)
#pragma unroll
    for (int r = 0; r < 16; ++r) {
      const int ml = wm * 64 + i * 32 + crow(r, hh);
      const float gt = gs[ml];
      T[ml * 136 + wn * 64 + l31] = f2bf(g2v0 * gt * acc[i][0][r]);
      T[ml * 136 + wn * 64 + 32 + l31] = f2bf(g2v1 * gt * acc[i][1][r]);
    }
  __syncthreads();
  {
    const int m0 = tm * 128;
    bf16* dst = (m0 < 4096 ? YEL + ((size_t)e * 4096 + m0) * 1024 : YEC + ((size_t)e * 256 + (m0 - 4096)) * 1024) + tn * 128;
#pragma unroll
    for (int i = 0; i < 8; ++i) {
      const int id = tid + 256 * i, row = id >> 4, c = id & 15;
      *(u32x4*)(dst + (size_t)row * 1024 + c * 8) = *(const u32x4*)(T + row * 136 + c * 8);
    }
  }
}

#define XB_TMO      128
#define XB_XCNT(j)  (256  + 64 * (j))
#define XB_XSUB(j)  (1280 + 64 * (j))
#define XB_XGEN(j)  (2304 + 64 * (j))
#define XB_TOP      3328
#define XB_TOPGEN   3392
#define XCD_BAR_WORDS 3456
#define XB_SPIN_CAP (1u << 22)
#define LAS __attribute__((address_space(3)))
DI unsigned xb_ld(unsigned* p) { return __hip_atomic_load(p, __ATOMIC_RELAXED, __HIP_MEMORY_SCOPE_AGENT); }
DI unsigned xb_add(unsigned* p, unsigned v) { return __hip_atomic_fetch_add(p, v, __ATOMIC_RELAXED, __HIP_MEMORY_SCOPE_AGENT); }
DI unsigned xb_xcc_id() { return (unsigned)__builtin_amdgcn_s_getreg((3 << 11) | 20) & 0xFu; }
#define XB_SPIN(cond, bar) do { unsigned _sp = 0; while (cond) { __builtin_amdgcn_s_sleep(1); \
    if ((++_sp & 255u) == 0u) { if (xb_ld(&(bar)[XB_TMO])) break; if (_sp > XB_SPIN_CAP) { atomicAdd(&(bar)[XB_TMO], 1u); break; } } } } while (0)
struct XcdBarrier { unsigned* bar; unsigned x; volatile LAS unsigned* st; };
DI XcdBarrier xcd_barrier_post(unsigned* bar, volatile LAS unsigned* st) {
  XcdBarrier b; b.bar = bar; b.x = (unsigned)__builtin_amdgcn_readfirstlane((int)xb_xcc_id()); b.st = st;
  if (threadIdx.x == 0) (void)xb_add(&bar[XB_XCNT(b.x)], 1u);
  return b;
}
DI void xcd_barrier_complete(unsigned* bar, unsigned x, unsigned& nloc, unsigned& nx) {
  const unsigned G = gridDim.x * gridDim.y * gridDim.z;
  unsigned sum, cnt, mine, sp = 0u;
  for (;;) {
    sum = 0u; cnt = 0u; mine = 0u;
#pragma unroll
    for (unsigned j = 0; j < 16; ++j) { const unsigned c = xb_ld(&bar[XB_XCNT(j)]); sum += c; cnt += (c > 0u) ? 1u : 0u; mine = (j == x) ? c : mine; }
    if (sum == G) break;
    __builtin_amdgcn_s_sleep(1);
    if ((++sp & 255u) == 0u) { if (xb_ld(&bar[XB_TMO])) break; if (sp > XB_SPIN_CAP) { atomicAdd(&bar[XB_TMO], 1u); break; } }
  }
  nloc = mine > 0u ? mine : 1u; nx = cnt > 0u ? cnt : 1u;
}
DI void xcd_barrier(const XcdBarrier& b) {
  asm volatile("s_waitcnt vmcnt(0)" ::: "memory");
  __syncthreads();
  if (threadIdx.x == 0) {
    unsigned* bar = b.bar;
    unsigned bx = b.x;
    asm volatile("" : "+s"(bx), "+s"(bar));
    __builtin_amdgcn_s_waitcnt(0);
    unsigned nloc = b.st[0], nx = b.st[1];
    if (nloc == 0u) { xcd_barrier_complete(bar, bx, nloc, nx); b.st[0] = nloc; b.st[1] = nx; }
    const unsigned old = xb_add(&bar[XB_XSUB(bx)], 1u);
    const unsigned gen = old / nloc;
    if (old + 1u == (gen + 1u) * nloc) {
      __builtin_amdgcn_fence(__ATOMIC_RELEASE, "agent");
      asm volatile("s_waitcnt vmcnt(0)" ::: "memory");
      const unsigned og = xb_add(&bar[XB_TOP], 1u);
      const unsigned tg = og / nx;
      if (og + 1u == (tg + 1u) * nx) xb_add(&bar[XB_TOPGEN], 1u);
      else XB_SPIN(xb_ld(&bar[XB_TOPGEN]) == tg, bar);
      __builtin_amdgcn_fence(__ATOMIC_ACQUIRE, "agent");
      xb_add(&bar[XB_XGEN(bx)], 1u);
      asm volatile("s_waitcnt vmcnt(0)" ::: "memory");
    } else {
      XB_SPIN(xb_ld(&bar[XB_XGEN(bx)]) == gen, bar);
      __builtin_amdgcn_fence(__ATOMIC_ACQUIRE, "agent");
      asm volatile("s_waitcnt vmcnt(0)" ::: "memory");
    }
  }
  __syncthreads();
}

__global__ void __launch_bounds__(NTHR, 2) hybrid_mega(Params p_in) {
  Params p = p_in;
  cg::grid_group grid = cg::this_grid();
  extern __shared__ __attribute__((aligned(16))) char smem[];
  const int tid = opaque_tid(), lane = tid & 63, w = tid >> 6;
  const int G = gridDim.x, bid = blockIdx.x;
  int nlb = G >> 3, vx = bid & 7, lb = (bid < 8 * nlb) ? (bid >> 3) : (1 << 28);
  __shared__ uint4 xb_words;
  __shared__ int xmap[2];
  if (tid == 0) xb_words = make_uint4(0u, 0u, 0u, 0u);
  __syncthreads();
  XcdBarrier xb = xcd_barrier_post((unsigned*)(p.ws + OFF_BAR), (volatile LAS unsigned*)&xb_words);
  if (p.ws == nullptr) grid.sync();
  if (tid == 0) xmap[0] = (int)xb_add((unsigned*)(p.ws + OFF_BAR) + 8 * xb.x, 1u);
  float* X2 = (float*)(p.ws + OFF_X2);
  bf16* XM = (bf16*)(p.ws + OFF_Y);
  const float* ADA = (const float*)(p.ws + OFF_ADA);

  PH(0) {
    const int n_ada = 384, n_w = 2 * NW_TILES, n_e = NE_TILES;
    const int total = n_ada + 1 + n_w + n_e;
    for (int it = bid; it < total; it += G) {
      if (it < n_ada) ada_item(p, it, (float*)smem);
      else if (it == n_ada) {
        for (int i = opaque_tid(); i < 512; i += NTHR) {
          int ap2 = i >> 3, j = i & 7;
          float inv = powf(10000.f, -(float)j * 2.0f / 16.0f);
          float ang = (float)ap2 * inv;
          ((float2*)(p.ws + OFF_ROPE))[i] = make_float2(cosf(ang), sinf(ang));
        }
      } else if (it < n_ada + 1 + n_w) {
        int k = it - n_ada - 1;
        convert_weight_item(p, k / NW_TILES, k % NW_TILES, (float*)smem);
      } else convert_expert_item(p, 0, it - n_ada - 1 - n_w, (float*)smem);
    }
  }
  xcd_barrier(xb);
  {
    if (tid == 0) {
      unsigned* bar = (unsigned*)(p.ws + OFF_BAR);
      int ok = (G & 7) == 0;
      for (int j = 0; j < 16; ++j) { unsigned c = xb_ld(&bar[XB_XCNT(j)]); if (c != (j < 8 ? (unsigned)(G >> 3) : 0u)) ok = 0; }
      xmap[1] = ok;
    }
    __syncthreads();
    if (__builtin_amdgcn_readfirstlane(xmap[1])) { vx = (int)xb.x; lb = __builtin_amdgcn_readfirstlane(xmap[0]); }
  }
  PH(1) for (int it = bid; it < NT / 4; it += G) {
    const int w = opaque_tid() >> 6;
    int tok = it * 4 + w;
    const float* row = tok < NTL ? p.in[I_X] + (size_t)tok * 1024 : p.in[I_CTX] + (size_t)(tok - NTL) * 1024;
    const float* ada = ADA + (size_t)ada_row(tok) * 6144;
    float v[16];
    row_load(row, v);
    row_norm(v);
    row_affine<1>(v, ada + 1024, ada);
    row_store_bf(XM + (size_t)tok * 1024, v);
  }
  xcd_barrier(xb);

  for (int l = 0; l < 2; ++l) {
    const bool upd = (l == 0);
    const int mt_q = upd ? 272 : 256;
    float* R = upd ? X2 : p.out;
    bf16* YEL = upd ? (bf16*)p.out : (bf16*)(p.ws + OFF_X2);
    bf16* YEC = (bf16*)(p.ws + OFF_KN);
    PH(2) for (int li = lb; li < 68 * 9; li += nlb) {
      int mi = li / 9, ntl = li - mi * 9;
      inproj_tile(p, l, (vx & 3) + 4 * mi, (vx >> 2) * 9 + ntl, smem);
    }
    xcd_barrier(xb);
    PH(3) {
      const int n_ml1 = 32 * 68, n_g = mt_q, n_kr = 272;
      if (P3MASK & 1) for (int li = lb; li < (mt_q / 8) * 6; li += nlb) { int mi = li / 6; uq_tile(p, l, vx + 8 * mi, li - mi * 6, smem); }
      if (P3MASK & 2) for (int li = lb; li < 34 * 8; li += nlb) ukv_tile(p, l, vx + 8 * (li >> 3), li & 7, smem);
      const int total = n_ml1 + n_g + n_kr;
      for (int it = bid; it < total; it += G) {
        int k = it;
        if (k < n_ml1) { int c = k % 68, bh = k / 68; if (P3MASK & 4) ml1_item(p, l, bh >> 2, bh & 3, c, smem); continue; }
        k -= n_ml1;
        if (k < n_g) { if (P3MASK & 8) gmlp_item(p, l, k, smem); continue; }
        k -= n_g;
        if (P3MASK & 16) krope_item(p, k);
      }
    }
    xcd_barrier(xb);
    PH(4) {
      const int n_ml2 = 64 * 4, n_ac = upd ? 8 * 8 * 2 : 0;
      for (int it = bid; it < n_ml2; it += G) ml2_item(p, it, smem);
      for (int li = lb; li < 8 * 16; li += nlb) {
        int bh = vx + 8 * (li >> 4), qt = li & 15;
        int b = bh >> 3, h = bh & 7;
        attn_item(p, b, h, qt * 256, 0, 68, b * 4096 + qt * 256, smem);
      }
      if (upd) for (int k = bid; k < 64; k += G) {
        int b = k >> 3, h = k & 7;
        attn_item(p, b, h, 4096, 4096, 4, NTL + b * 256, smem);
      }
    }
    xcd_barrier(xb);
    PH(5) {
      const int ncl = 32 * 64, ncc = upd ? 32 * 4 : 0;
      for (int it = bid; it < ncl + ncc; it += G) {
        if (it < ncl) { int c = it & 63, bh = it >> 6; ml3_item(p, l, bh >> 2, bh & 3, c, smem); }
        else { int k = it - ncl; int c = 64 + (k & 3), bh = k >> 2; ml3_item(p, l, bh >> 2, bh & 3, c, smem); }
      }
    }
    xcd_barrier(xb);
    PH(6) {
      const float* XL = upd ? p.in[I_X] : X2;
      const float* XC = upd ? p.in[I_CTX] : (X2 + (size_t)NTL * 1024);
      for (int li = lb; li < (mt_q / 8) * 8; li += nlb) outproj_tile(p, l, vx + 8 * (li >> 3), li & 7, smem, R, XL, XC);
    }
    xcd_barrier(xb);
    PH(7) {
      float wr[16][4];
      {
        const int t2 = opaque_tid(); const int lane = t2 & 63, w = t2 >> 6;
        const float* W = p.in[I_WROUTER] + (size_t)l * 1024 * 16;
#pragma unroll
        for (int i = 0; i < 4; ++i)
#pragma unroll
          for (int c = 0; c < 4; ++c) {
            int k = 4 * lane + 256 * i + c;
            float4 t = *(const float4*)(W + (size_t)k * 16 + w * 4);
            wr[4 * i + c][0] = t.x; wr[4 * i + c][1] = t.y; wr[4 * i + c][2] = t.z; wr[4 * i + c][3] = t.w;
          }
      }
      const int nrows = upd ? NT : NTL;
      for (int it = bid; it < nrows / 4; it += G) ln1_router_item(p, l, it, smem, R, wr);
    }
    xcd_barrier(xb);
    PH(8) {
      const int me = upd ? 4352 : 4096;
      const int total = upd ? 256 : 128;
      for (int it = bid; it < total; it += G) {
        if (it < 128) topk_item<16>(p, it, false, me, smem);
        else topk_item<1>(p, it - 128, true, me, smem);
      }
    }
    xcd_barrier(xb);
    PH(9) {
      const int mtiles = upd ? 34 : 32;
      const int per_e = mtiles * 16, per_h = mtiles * 8;
      for (int li = lb; li < 2 * per_e; li += nlb) {
        int ei = li / per_e, rem = li - ei * per_e;
        int half = rem / per_h, rem2 = rem - half * per_h;
        moe1_tile(p, 2 * vx + ei, rem2 >> 3, half * 8 + (rem2 & 7), smem);
      }
    }
    xcd_barrier(xb);
    PH(10) {
      const int mtiles = upd ? 34 : 32;
      const int per_e = mtiles * 8;
      for (int li = lb; li < 2 * per_e; li += nlb) {
        int ei = li / per_e, rem = li - ei * per_e;
        moe2_tile(p, l, 2 * vx + ei, rem >> 3, rem & 7, smem, YEL, YEC);
      }
    }
    xcd_barrier(xb);
    PH(11) {
      const int nrows = upd ? NT : NTL;
      const int n_r = nrows / 4;
      const int total = n_r + (upd ? NE_TILES : 0);
      for (int it = bid; it < total; it += G) {
        if (it < n_r) {
          const int w = opaque_tid() >> 6;
          int tok = it * 4 + w;
          float v[16];
          float* row = R + (size_t)tok * 1024;
          row_load(row, v);
          {
            const int ln = opaque_tid() & 63;
            const int cnt = ((const int*)(p.ws + OFF_TOKCNT))[tok];
            const int* lst = (const int*)(p.ws + OFF_TOKLIST) + (size_t)tok * 16;
            for (int c = 0; c < cnt; ++c) {
              const int code = lst[c];
              const bf16* yr = code >= 0 ? YEL + (size_t)code * 1024 : YEC + (size_t)(-code - 1) * 1024;
#pragma unroll
              for (int i = 0; i < 4; ++i) {
                uint2 u = *(const uint2*)(yr + 4 * ln + 256 * i);
                v[4 * i] += bflo(u.x); v[4 * i + 1] += bfhi(u.x); v[4 * i + 2] += bflo(u.y); v[4 * i + 3] += bfhi(u.y);
              }
            }
          }
          row_norm(v);
          row_affine<0>(v, p.in[I_LN2G] + l * 1024, p.in[I_LN2B] + l * 1024);
          row_store(row, v);
          if (upd) {
            const float* ada = ADA + (size_t)(9 + ada_row(tok)) * 6144;
            row_norm(v);
            row_affine<1>(v, ada + 1024, ada);
            row_store_bf(XM + (size_t)tok * 1024, v);
          }
        } else convert_expert_item(p, 1, it - n_r, (float*)smem);
      }
    }
    if (l == 0) xcd_barrier(xb);
  }
}

extern "C" void kernel_launch(void* const* d_in, const int* in_sizes, int n_in, void* d_out, int out_size, void* d_ws, size_t ws_size,
                              hipStream_t stream) {
  static int grid_blocks = 0;
  if (!grid_blocks) {
    int dev = 0, cus = 0, per_cu = 0;
    hipGetDevice(&dev);
    hipDeviceGetAttribute(&cus, hipDeviceAttributeMultiprocessorCount, dev);
    hipFuncSetAttribute((const void*)hybrid_mega, hipFuncAttributeMaxDynamicSharedMemorySize, SMEM_BYTES);
    hipOccupancyMaxActiveBlocksPerMultiprocessor(&per_cu, hybrid_mega, NTHR, SMEM_BYTES);
    if (per_cu > 2) per_cu = 2;
    if (per_cu < 1) per_cu = 1;
    grid_blocks = cus * per_cu;
  }
  if (ws_size < WS_END) fprintf(stderr, "workspace too small: %zu < %zu\n", ws_size, (size_t)WS_END);
  hipMemsetAsync((char*)d_ws + OFF_BAR, 0, XCD_BAR_WORDS * 4, stream);
  Params p{};
  for (int i = 0; i < 29; ++i) p.in[i] = (const float*)d_in[i];
  p.out = (float*)d_out;
  p.ws = (char*)d_ws;
  void* args[] = {&p};
  hipError_t e = hipLaunchCooperativeKernel((void*)hybrid_mega, dim3(grid_blocks), dim3(NTHR), args, SMEM_BYTES, stream);
  if (e != hipSuccess) fprintf(stderr, "cooperative launch failed: %s (grid %d)\n", hipGetErrorString(e), grid_blocks);
}
```
